# Optimizing an MI355X kernel written in HIP

```python
import math
import jax, jax.numpy as jnp
from jax import lax
import numpy as np

D_MODEL = 1024
BATCH = 4
SEQ = 8192
DEPTH = 2

N_A_LAYERS = DEPTH // 2
N_B_LAYERS = DEPTH - N_A_LAYERS
GLA_HEADS = 4
GLA_DK = D_MODEL // 2 // GLA_HEADS
GLA_DV = D_MODEL // GLA_HEADS
GLA_GATE_RANK = 16
GLA_GATE_TAU = 16.0
GLA_CHUNK = 64
GLA_IN = 2 * GLA_HEADS * GLA_DK + 2 * GLA_HEADS * GLA_DV + GLA_GATE_RANK
DIFF_HEADS = 8
DIFF_HD = D_MODEL // (2 * DIFF_HEADS)
DIFF_VD = 2 * DIFF_HD
Q_BLOCK = 128
ROPE_THETA = 10000.0
N_EXPERTS = 32
TOP_K = 4
D_FF = D_MODEL
SWIGLU_LIMIT = 7.0
SWIGLU_ALPHA = 1.702
EXPERT_BLOCK = 128
LN_EPS = 1e-5
RMS_EPS = 1e-5
DEEPNORM_ALPHA = (2.0 * DEPTH) ** 0.25
DEEPNORM_BETA = (8.0 * DEPTH) ** -0.25

kernel_name = "yoco_gla_diffattn_moe_deepnorm"


def layer_norm(x, g, b):
    xf = x.astype(jnp.float32)
    mu = jnp.mean(xf, axis=-1, keepdims=True)
    var = jnp.mean(jnp.square(xf - mu), axis=-1, keepdims=True)
    y = (xf - mu) * lax.rsqrt(var + LN_EPS)
    return (y * g.astype(jnp.float32) + b.astype(jnp.float32)).astype(x.dtype)


def rms_norm(x, w):
    xf = x.astype(jnp.float32)
    y = xf * lax.rsqrt(jnp.mean(jnp.square(xf), axis=-1, keepdims=True) + RMS_EPS)
    return (y * w.astype(jnp.float32)).astype(x.dtype)


def rope(t, positions):
    hd = t.shape[-1]
    half = hd // 2
    inv = ROPE_THETA ** (-jnp.arange(half, dtype=jnp.float32) * 2.0 / hd)
    ang = positions.astype(jnp.float32)[..., None] * inv
    cos = jnp.cos(ang)[:, :, None, :]
    sin = jnp.sin(ang)[:, :, None, :]
    t1 = t[..., :half].astype(jnp.float32)
    t2 = t[..., half:].astype(jnp.float32)
    return jnp.concatenate([t1 * cos - t2 * sin, t2 * cos + t1 * sin], axis=-1).astype(t.dtype)


def gla_mixer(x, w_in, w_gk2, b_gk, norm_w, w_out):
    B, S, D = x.shape
    H, DK, DV, C = GLA_HEADS, GLA_DK, GLA_DV, GLA_CHUNK
    N = S // C
    proj = x @ w_in
    q, k, v, r, gk_low = jnp.split(
        proj, [H * DK, 2 * H * DK, 2 * H * DK + H * DV, 2 * H * DK + 2 * H * DV], axis=-1)
    log_g = jax.nn.log_sigmoid((gk_low @ w_gk2 + b_gk).astype(jnp.float32)) / GLA_GATE_TAU

    def to_chunks(t, d):
        return t.astype(jnp.float32).reshape(B, N, C, H, d).transpose(0, 3, 1, 2, 4)

    qc = to_chunks(q, DK) * (DK ** -0.5)
    kc = to_chunks(k, DK)
    vc = to_chunks(v, DV)
    G = jnp.cumsum(to_chunks(log_g, DK), axis=3)
    G_last = G[:, :, :, -1:, :]
    q_in = qc * jnp.exp(G)
    k_in = kc * jnp.exp(-G)
    causal = jnp.tril(jnp.ones((C, C), dtype=bool))
    scores = jnp.where(causal, jnp.einsum('bhnid,bhnjd->bhnij', q_in, k_in), 0.0)
    o_intra = jnp.einsum('bhnij,bhnjv->bhniv', scores, vc)
    k_state = kc * jnp.exp(G_last - G)
    decay = jnp.exp(G_last[:, :, :, 0, :])

    def step(state, inp):
        q_c, k_c, v_c, d_c = inp
        o = jnp.einsum('bhcd,bhdv->bhcv', q_c, state)
        state = state * d_c[..., None] + jnp.einsum('bhcd,bhcv->bhdv', k_c, v_c)
        return state, o

    xs = (q_in.transpose(2, 0, 1, 3, 4), k_state.transpose(2, 0, 1, 3, 4),
          vc.transpose(2, 0, 1, 3, 4), decay.transpose(2, 0, 1, 3))
    state0 = jnp.zeros((B, H, DK, DV), jnp.float32)
    _, o_inter = lax.scan(step, state0, xs)
    o = o_intra + o_inter.transpose(1, 2, 0, 3, 4)
    o = o.transpose(0, 2, 3, 1, 4).reshape(B, S, H, DV).astype(x.dtype)
    o = rms_norm(o, norm_w) * jax.nn.silu(r.reshape(B, S, H, DV))
    return o.reshape(B, S, H * DV) @ w_out


def shared_kv(x, kv_w, positions):
    B, S, D = x.shape
    H, HD, VD = DIFF_HEADS, DIFF_HD, DIFF_VD
    kv = x @ kv_w
    k, v = jnp.split(kv, [2 * H * HD], axis=-1)
    k = rope(k.reshape(B, S, 2 * H, HD), positions).reshape(B, S, H, 2, HD)
    v = v.reshape(B, S, H, VD)
    return k, v


def diff_mixer(x, positions, k_sh, v_sh, w_q, lam, subln_w, w_out, lambda_init):
    B, S, D = x.shape
    H, HD, VD = DIFF_HEADS, DIFF_HD, DIFF_VD
    q = rope((x @ w_q).reshape(B, S, 2 * H, HD), positions).reshape(B, S, H, 2, HD) * (HD ** -0.5)
    lamf = lam.astype(jnp.float32)
    lam_full = (jnp.exp(jnp.sum(lamf[0] * lamf[1])) - jnp.exp(jnp.sum(lamf[2] * lamf[3]))
                + lambda_init)
    n_blk = S // Q_BLOCK
    q_blocks = q.reshape(B, n_blk, Q_BLOCK, H, 2, HD).transpose(1, 0, 2, 3, 4, 5)
    key_pos = jnp.arange(S, dtype=jnp.int32)

    def attend(args):
        q_b, blk = args
        s = jnp.einsum('bqhcd,bkhcd->bhcqk', q_b, k_sh).astype(jnp.float32)
        q_pos = blk * Q_BLOCK + jnp.arange(Q_BLOCK, dtype=jnp.int32)
        mask = key_pos[None, :] <= q_pos[:, None]
        p = jax.nn.softmax(jnp.where(mask, s, -jnp.inf), axis=-1)
        a = p[:, :, 0] - lam_full * p[:, :, 1]
        return jnp.einsum('bhqk,bkhv->bqhv', a.astype(v_sh.dtype), v_sh)

    o = lax.map(attend, (q_blocks, jnp.arange(n_blk, dtype=jnp.int32)))
    o = o.transpose(1, 0, 2, 3, 4).reshape(B, S, H, VD)
    o = rms_norm(o, subln_w) * (1.0 - lambda_init)
    return o.reshape(B, S, H * VD) @ w_out


def moe_ffn(x, router_w, router_b, w_gu, b_gu, w_down, b_down):
    B, S, D = x.shape
    T = B * S
    F = D_FF
    xt = x.reshape(T, D)
    logits = (xt @ router_w + router_b).astype(jnp.float32)
    top_vals, top_idx = lax.top_k(logits, TOP_K)
    gates = jax.nn.softmax(top_vals, axis=-1)
    n_assign = T * TOP_K
    flat_e = top_idx.reshape(n_assign).astype(jnp.int32)
    flat_tok = jnp.repeat(jnp.arange(T, dtype=jnp.int32), TOP_K)
    flat_g = gates.reshape(n_assign)
    order = jnp.argsort(flat_e, stable=True)
    se, stok, sg = flat_e[order], flat_tok[order], flat_g[order]
    counts = jnp.bincount(flat_e, length=N_EXPERTS).astype(jnp.int32)
    padded = (counts + EXPERT_BLOCK - 1) // EXPERT_BLOCK * EXPERT_BLOCK
    start = jnp.cumsum(counts) - counts
    pad_end = jnp.cumsum(padded)
    pad_start = pad_end - padded
    dest = pad_start[se] + jnp.arange(n_assign, dtype=jnp.int32) - start[se]
    n_blocks = -(-n_assign // EXPERT_BLOCK) + N_EXPERTS
    n_pad = n_blocks * EXPERT_BLOCK
    buf_tok = jnp.zeros((n_pad,), jnp.int32).at[dest].set(stok)
    buf_g = jnp.zeros((n_pad,), jnp.float32).at[dest].set(sg)
    blk_start = jnp.arange(n_blocks, dtype=jnp.int32) * EXPERT_BLOCK
    blk_e = jnp.minimum(jnp.searchsorted(pad_end, blk_start, side='right'), N_EXPERTS - 1)
    xb = xt[buf_tok].reshape(n_blocks, EXPERT_BLOCK, D)

    def expert_block(args):
        xblk, e = args
        h = xblk @ w_gu[e] + b_gu[e]
        x_glu = jnp.minimum(h[:, :F], SWIGLU_LIMIT)
        x_lin = jnp.clip(h[:, F:], -SWIGLU_LIMIT, SWIGLU_LIMIT)
        act = x_glu * jax.nn.sigmoid(SWIGLU_ALPHA * x_glu) * (x_lin + 1.0)
        return act @ w_down[e] + b_down[e]

    yb = lax.map(expert_block, (xb, blk_e))
    contrib = (yb.reshape(n_pad, D) * buf_g[:, None]).astype(x.dtype)
    y = jnp.zeros((T, D), x.dtype).at[buf_tok].add(contrib)
    return y.reshape(B, S, D)


def setup_inputs(seed: int = 0) -> dict:
    key = jax.random.key(seed)
    ks = jax.random.split(key, 32)
    D, H, DK, DV = D_MODEL, GLA_HEADS, GLA_DK, GLA_DV
    HB, HD, VD = DIFF_HEADS, DIFF_HD, DIFF_VD
    E, F = N_EXPERTS, D_FF
    beta = DEEPNORM_BETA
    nrm = jax.random.normal
    x = nrm(ks[0], (BATCH, SEQ, D), jnp.float32)
    offset = jax.random.randint(ks[1], (BATCH, 1), 0, 1024, dtype=jnp.int32)
    positions = (jnp.arange(SEQ, dtype=jnp.int32)[None, :] + offset).astype(jnp.int32)
    sD = D ** -0.5
    a_qk = nrm(ks[2], (N_A_LAYERS, D, 2 * H * DK), jnp.float32) * sD
    a_v = nrm(ks[3], (N_A_LAYERS, D, H * DV), jnp.float32) * sD * beta
    a_rg = nrm(ks[4], (N_A_LAYERS, D, H * DV + GLA_GATE_RANK), jnp.float32) * sD
    a_w_in = jnp.concatenate([a_qk, a_v, a_rg], axis=-1)
    a_w_gk2 = nrm(ks[5], (N_A_LAYERS, GLA_GATE_RANK, H * DK), jnp.float32) * GLA_GATE_RANK ** -0.5
    a_b_gk = 0.1 * nrm(ks[6], (N_A_LAYERS, H * DK), jnp.float32)
    a_norm_w = 1.0 + 0.02 * nrm(ks[7], (N_A_LAYERS, DV), jnp.float32)
    a_w_out = nrm(ks[8], (N_A_LAYERS, H * DV, D), jnp.float32) * (H * DV) ** -0.5 * beta
    kv_k = nrm(ks[9], (D, 2 * HB * HD), jnp.float32) * sD
    kv_v = nrm(ks[10], (D, HB * VD), jnp.float32) * sD * beta
    kv_w = jnp.concatenate([kv_k, kv_v], axis=-1)
    b_w_q = nrm(ks[11], (N_B_LAYERS, D, 2 * HB * HD), jnp.float32) * sD
    b_lambda = 0.1 * nrm(ks[12], (N_B_LAYERS, 4, HD), jnp.float32)
    b_subln_w = 1.0 + 0.02 * nrm(ks[13], (N_B_LAYERS, VD), jnp.float32)
    b_w_out = nrm(ks[14], (N_B_LAYERS, HB * VD, D), jnp.float32) * (HB * VD) ** -0.5 * beta
    ln1_g = 1.0 + 0.02 * nrm(ks[15], (DEPTH, D), jnp.float32)
    ln1_b = 0.02 * nrm(ks[16], (DEPTH, D), jnp.float32)
    ln2_g = 1.0 + 0.02 * nrm(ks[17], (DEPTH, D), jnp.float32)
    ln2_b = 0.02 * nrm(ks[18], (DEPTH, D), jnp.float32)
    router_w = nrm(ks[19], (DEPTH, D, E), jnp.float32) * sD
    router_b = 0.01 * nrm(ks[20], (DEPTH, E), jnp.float32)
    moe_w_gu = nrm(ks[21], (DEPTH, E, D, 2 * F), jnp.float32) * sD
    moe_b_gu = 0.01 * nrm(ks[22], (DEPTH, E, 2 * F), jnp.float32)
    moe_w_down = nrm(ks[23], (DEPTH, E, F, D), jnp.float32) * F ** -0.5 * beta
    moe_b_down = 0.01 * nrm(ks[24], (DEPTH, E, D), jnp.float32)
    return {"x": x, "positions": positions,
            "a_w_in": a_w_in, "a_w_gk2": a_w_gk2, "a_b_gk": a_b_gk, "a_norm_w": a_norm_w, "a_w_out": a_w_out,
            "kv_w": kv_w, "b_w_q": b_w_q, "b_lambda": b_lambda, "b_subln_w": b_subln_w, "b_w_out": b_w_out,
            "ln1_g": ln1_g, "ln1_b": ln1_b, "ln2_g": ln2_g, "ln2_b": ln2_b,
            "router_w": router_w, "router_b": router_b,
            "moe_w_gu": moe_w_gu, "moe_b_gu": moe_b_gu, "moe_w_down": moe_w_down, "moe_b_down": moe_b_down}


def reference(x, positions, a_w_in, a_w_gk2, a_b_gk, a_norm_w, a_w_out, kv_w, b_w_q, b_lambda, b_subln_w,
              b_w_out, ln1_g, ln1_b, ln2_g, ln2_b, router_w, router_b, moe_w_gu, moe_b_gu, moe_w_down,
              moe_b_down):
    k_sh, v_sh = None, None
    if N_A_LAYERS == 0:
        k_sh, v_sh = shared_kv(x, kv_w, positions)
    for l in range(DEPTH):
        if l < N_A_LAYERS:
            h = gla_mixer(x, a_w_in[l], a_w_gk2[l], a_b_gk[l], a_norm_w[l], a_w_out[l])
        else:
            j = l - N_A_LAYERS
            lambda_init = 0.8 - 0.6 * math.exp(-0.3 * l)
            h = diff_mixer(x, positions, k_sh, v_sh, b_w_q[j], b_lambda[j], b_subln_w[j], b_w_out[j],
                           lambda_init)
        x = layer_norm(DEEPNORM_ALPHA * x + h, ln1_g[l], ln1_b[l])
        m = moe_ffn(x, router_w[l], router_b[l], moe_w_gu[l], moe_b_gu[l], moe_w_down[l], moe_b_down[l])
        x = layer_norm(DEEPNORM_ALPHA * x + m, ln2_g[l], ln2_b[l])
        if l == N_A_LAYERS - 1:
            k_sh, v_sh = shared_kv(x, kv_w, positions)
    return x
```

```cpp
#include <hip/hip_runtime.h>
#include <hip/hip_bf16.h>
#include <cstdio>
#include <cstdint>
#include <cmath>
namespace pg8 {
#define PG8_LAS __attribute__((address_space(3)))
typedef unsigned short bf16_t;
typedef short bf16x8 __attribute__((ext_vector_type(8)));
typedef float f32x4 __attribute__((ext_vector_type(4)));
typedef unsigned u32x4 __attribute__((ext_vector_type(4)));
constexpr int BM = 256, BK = 64, HALF = 128, HTB = HALF * BK * 2  , STAGE_BYTES = 8 * HTB, NXCD = 8, WGM = 8;

__host__ __device__ __forceinline__ int lds_byte(int r, int c) { const int st = (r >> 4) * 2 + (c >> 5), rr = r & 15, cc = c & 31, ob = rr * 64 + cc * 2; return st * 1024 + (ob ^ (((ob >> 9) & 1) << 5)); }
__host__ __device__ __forceinline__ void stage_rc(int b, int& R, int& C) { const int st = b / 1024, sb = b % 1024, swz = sb ^ (((sb >> 9) & 1) << 5); R = (st >> 1) * 16 + swz / 64; C = (st & 1) * 32 + (swz % 64) / 2; }
__host__ __device__ __forceinline__ int perm32(int rho) { const int n = rho >> 4, i = rho & 15; return 8 * (i >> 2) + 4 * n + (i & 3); }

struct Unit { int pm, pn, pb; };
struct Gemm { const bf16_t* A; const bf16_t* Bt; int M, N, K; };

struct StaticOrder {
    int nM, nN, nwg, G, c;
    __host__ __device__ void init(int M, int N, int G_, int c_) { nM = M / BM; nN = N / BM; nwg = nM * nN; G = G_; c = c_; }
    __host__ __device__ bool next(int i, Unit& u) const {
        const long L = (long)i * G + c; if (L >= nwg) return false;
        int wgid = (int)L; { const int q = nwg / NXCD, r = nwg % NXCD, xcd = wgid % NXCD, off = wgid / NXCD; wgid = (xcd < r ? xcd * (q + 1) : r * (q + 1) + (xcd - r) * q) + off; }
        const int nig = WGM * nN, gid = wgid / nig, fm = gid * WGM, gsz = (nM - fm) < WGM ? (nM - fm) : WGM;
        u.pm = fm + ((wgid % nig) % gsz); u.pn = (wgid % nig) / gsz; u.pb = u.pn; return true;
    }
    __device__ __forceinline__ void a_ready(const Unit&) const {}
    __device__ __forceinline__ void done(const Unit&) const {}
};
struct MoeOrder {
    const int* pexp; int npan, NT, G, c;
    __device__ __forceinline__ bool next(int i, Unit& u) const {
        int pm, pn;
        if ((G & 7) == 0) { const int x = c & 7, j = c >> 3, U = i * (G >> 3) + j; pn = U % NT; pm = (U / NT) * 8 + x; }
        else { const int L = i * G + c; pn = L % NT; pm = L / NT; }
        if (pm >= npan) return false;
        const int e = __hip_atomic_load(pexp + pm, __ATOMIC_RELAXED, __HIP_MEMORY_SCOPE_AGENT);
        u.pm = pm; u.pn = pn; u.pb = e * NT + pn; return true;
    }
    __device__ __forceinline__ void a_ready(const Unit&) const {}
    __device__ __forceinline__ void done(const Unit&) const {}
};

typedef float f32x2v __attribute__((ext_vector_type(2))); typedef unsigned u32x2v __attribute__((ext_vector_type(2))); typedef __bf16 bf16x2v __attribute__((ext_vector_type(2)));
__device__ __forceinline__ unsigned cvt_pk_bf16(float lo, float hi) { f32x2v v = {lo, hi}; bf16x2v b = __builtin_convertvector(v, bf16x2v); return __builtin_bit_cast(unsigned, b); }
__device__ __forceinline__ u32x4 pack8(const f32x4 v0, const f32x4 v1) { u32x4 w; w.x = cvt_pk_bf16(v0[0], v0[1]); w.y = cvt_pk_bf16(v0[2], v0[3]); w.z = cvt_pk_bf16(v1[0], v1[1]); w.w = cvt_pk_bf16(v1[2], v1[3]); return w; }

struct EpiStore {
    static constexpr bool PERM = true, AFTER_DRAIN = false;
    bf16_t* O; int ldc;
    __device__ __forceinline__ void operator()(const f32x4 (&acc)[2][2][4][2], const Unit& u, int wr, int wc, int fr, int fq) const {
        const int row0 = u.pm * BM + wr * 64 + fr, col0 = u.pn * BM + wc * 32 + 8 * fq;
#pragma unroll
        for (int ai = 0; ai < 2; ++ai)
#pragma unroll
            for (int m = 0; m < 4; ++m) { bf16_t* rowp = O + (size_t)(row0 + ai * HALF + m * 16) * ldc + col0;
#pragma unroll
                for (int bj = 0; bj < 2; ++bj) *(u32x4*)(rowp + bj * HALF) = pack8(acc[ai][bj][m][0], acc[ai][bj][m][1]); }
    }
};
struct EpiResF32 {
    static constexpr bool PERM = true, AFTER_DRAIN = false;
    const float* R; float* Y; int ldc; float alpha;
    __device__ __forceinline__ void operator()(const f32x4 (&acc)[2][2][4][2], const Unit& u, int wr, int wc, int fr, int fq) const {
        const int row0 = u.pm * BM + wr * 64 + fr, col0 = u.pn * BM + wc * 32 + 8 * fq;
#pragma unroll
        for (int ai = 0; ai < 2; ++ai)
#pragma unroll
            for (int m = 0; m < 4; ++m) { const size_t p = (size_t)(row0 + ai * HALF + m * 16) * ldc + col0;
#pragma unroll
                for (int bj = 0; bj < 2; ++bj) { const f32x4 r0 = *(const f32x4*)(R + p + bj * HALF), r1 = *(const f32x4*)(R + p + bj * HALF + 4);
                    *(f32x4*)(Y + p + bj * HALF) = r0 * alpha + acc[ai][bj][m][0]; *(f32x4*)(Y + p + bj * HALF + 4) = r1 * alpha + acc[ai][bj][m][1]; } }
    }
};
struct EpiSwiglu {
    static constexpr bool PERM = true, AFTER_DRAIN = false;
    const float* bgu; bf16_t* O;
    __device__ __forceinline__ void operator()(const f32x4 (&acc)[2][2][4][2], const Unit& u, int wr, int wc, int fr, int fq) const {
        const int e = u.pb >> 3, row0 = u.pm * BM + wr * 64 + fr, colh = u.pn * HALF + wc * 32 + 8 * fq;
        const float* bb = bgu + (size_t)e * 2048 + colh;
        f32x4 bg[2], bl[2];
#pragma unroll
        for (int n = 0; n < 2; ++n) { bg[n] = *(const f32x4*)(bb + 4 * n); bl[n] = *(const f32x4*)(bb + 1024 + 4 * n); }
#pragma unroll
        for (int ai = 0; ai < 2; ++ai)
#pragma unroll
            for (int m = 0; m < 4; ++m) { f32x4 a[2];
#pragma unroll
                for (int n = 0; n < 2; ++n) { const f32x4 g = acc[ai][0][m][n] + bg[n], l = acc[ai][1][m][n] + bl[n];
#pragma unroll
                    for (int j = 0; j < 4; ++j) { const float xg = fminf(g[j], 7.0f), xl = fminf(fmaxf(l[j], -7.0f), 7.0f);
                        a[n][j] = xg * __builtin_amdgcn_rcpf(1.0f + __expf(-1.702f * xg)) * (xl + 1.0f); } }
                *(u32x4*)(O + (size_t)(row0 + ai * HALF + m * 16) * 1024 + colh) = pack8(a[0], a[1]); }
    }
};
struct EpiDown {
    static constexpr bool PERM = true, AFTER_DRAIN = false;
    const float* bd; bf16_t* O;
    __device__ __forceinline__ void operator()(const f32x4 (&acc)[2][2][4][2], const Unit& u, int wr, int wc, int fr, int fq) const {
        const int e = u.pb >> 2, row0 = u.pm * BM + wr * 64 + fr, col0 = u.pn * BM + wc * 32 + 8 * fq;
        const float* bb = bd + (size_t)e * 1024 + col0;
        f32x4 bv[2][2];
#pragma unroll
        for (int bj = 0; bj < 2; ++bj)
#pragma unroll
            for (int n = 0; n < 2; ++n) bv[bj][n] = *(const f32x4*)(bb + bj * HALF + 4 * n);
#pragma unroll
        for (int ai = 0; ai < 2; ++ai)
#pragma unroll
            for (int m = 0; m < 4; ++m) { bf16_t* rowp = O + (size_t)(row0 + ai * HALF + m * 16) * 1024 + col0;
#pragma unroll
                for (int bj = 0; bj < 2; ++bj) *(u32x4*)(rowp + bj * HALF) = pack8(acc[ai][bj][m][0] + bv[bj][0], acc[ai][bj][m][1] + bv[bj][1]); }
    }
};
struct EpiRope {
    static constexpr bool PERM = true, AFTER_DRAIN = false;
    bf16_t* KVQ; size_t kind_stride; const float *cosT, *sinT; float qscale;
    __device__ __forceinline__ void operator()(const f32x4 (&acc)[2][2][4][2], const Unit& u, int wr, int wc, int fr, int fq) const {
        const int kind = u.pn >> 2, pl = u.pn & 3, row0 = u.pm * BM + wr * 64 + fr, col0 = pl * 256 + wc * 64 + 8 * fq;
        bf16_t* base = KVQ + (size_t)kind * kind_stride;
        const float sc = kind == 2 ? qscale : 1.0f;
#pragma unroll
        for (int ai = 0; ai < 2; ++ai)
#pragma unroll
            for (int m = 0; m < 4; ++m) { const int row = row0 + ai * HALF + m * 16;
                bf16_t* rowp = base + (size_t)row * 1024 + col0;
#pragma unroll
                for (int n = 0; n < 2; ++n) { const f32x4 t1 = acc[ai][0][m][n], t2 = acc[ai][1][m][n]; f32x4 o1, o2;
                    if (kind != 1) { const f32x4 c = *(const f32x4*)(cosT + (size_t)row * 32 + 8 * fq + 4 * n), s = *(const f32x4*)(sinT + (size_t)row * 32 + 8 * fq + 4 * n);
                        o1 = (t1 * c - t2 * s) * sc; o2 = (t2 * c + t1 * s) * sc; }
                    else { o1 = t1; o2 = t2; }
                    u32x2v w1, w2; w1.x = cvt_pk_bf16(o1[0], o1[1]); w1.y = cvt_pk_bf16(o1[2], o1[3]); w2.x = cvt_pk_bf16(o2[0], o2[1]); w2.y = cvt_pk_bf16(o2[2], o2[3]);
                    *(u32x2v*)(rowp + 4 * n) = w1; *(u32x2v*)(rowp + 32 + 4 * n) = w2;
                    asm volatile("" ::: "memory"); } }
    }
};

template <class Epi, class Sched, bool ALIGN_EPI = false, bool SP2 = false>
__device__ __forceinline__ void gemm_phase(PG8_LAS unsigned char* lds, const Gemm g, const Sched& S, const Epi& E) {
    const int tid = threadIdx.x, wid = __builtin_amdgcn_readfirstlane(tid >> 6), lane = tid & 63, wr = wid >> 2, wc = wid & 3, fr = lane & 15, fq = lane >> 4;
    const int K = g.K, nt = K / BK;
    unsigned voffA[2], voffB[2];
#pragma unroll
    for (int i = 0; i < 2; ++i) { int R, C; stage_rc(tid * 16 + i * 8192, R, C); const int Rb = Epi::PERM ? ((R & ~31) + perm32(R & 31)) : R;
        voffA[i] = (unsigned)(R * K + C) * 2u; voffB[i] = (unsigned)(Rb * K + C) * 2u; }
    const size_t kstep = (size_t)(BK * 2);
    const size_t hstep = (size_t)HALF * K * 2;
    const size_t tstep = 2 * hstep;
    const unsigned ldsw = (unsigned)wid * 1024u;
    const int aoff = lds_byte(wr * 64 + fr, fq * 8), boff = lds_byte(wc * 32 + fr, fq * 8);
#define PG8_SA(b, h) (((b) * 2 + (h)) * HTB)
#define PG8_SB(b, h) ((4 + (b) * 2 + (h)) * HTB)
#define PG8_STAGE(bufoff, gbase, voff) do { _Pragma("unroll") for (int _i = 0; _i < 2; ++_i) \
        __builtin_amdgcn_global_load_lds((const unsigned*)((const char*)(gbase) + (voff)[_i]), (PG8_LAS unsigned*)(lds + (bufoff) + ldsw + _i * 8192), 16, 0, 0); } while (0)
#define PG8_LDA(dst, b, h) do { _Pragma("unroll") for (int m = 0; m < 4; ++m) _Pragma("unroll") for (int k = 0; k < 2; ++k) dst[m][k] = *(const PG8_LAS bf16x8*)(lds + PG8_SA(b, h) + aoff + m * 2048 + k * 1024); } while (0)
#define PG8_LDB(dst, b, h) do { _Pragma("unroll") for (int n = 0; n < 2; ++n) _Pragma("unroll") for (int k = 0; k < 2; ++k) dst[n][k] = *(const PG8_LAS bf16x8*)(lds + PG8_SB(b, h) + boff + n * 2048 + k * 1024); } while (0)
#define PG8_MMA(ai, bj, At, Bt) do { __builtin_amdgcn_s_setprio(1); _Pragma("unroll") for (int m = 0; m < 4; ++m) _Pragma("unroll") for (int n = 0; n < 2; ++n) _Pragma("unroll") for (int k = 0; k < 2; ++k) \
        acc[ai][bj][m][n] = __builtin_amdgcn_mfma_f32_16x16x32_bf16(Bt[n][k], At[m][k], acc[ai][bj][m][n], 0, 0, 0); __builtin_amdgcn_s_setprio(0); } while (0)
#define PG8_WAIT_V(n) asm volatile("s_waitcnt vmcnt(" #n ")" ::: "memory")
#define PG8_WAIT_L(n) asm volatile("s_waitcnt lgkmcnt(" #n ")" ::: "memory")
#define PG8_BAR __builtin_amdgcn_s_barrier()
#define PG8_SCHED __builtin_amdgcn_sched_barrier(0)
    Unit cur, nxt; int ui = 0;
    if (!S.next(0, cur)) return;
    f32x4 acc[2][2][4][2];
#pragma unroll
    for (int a = 0; a < 2; ++a)
#pragma unroll
        for (int b = 0; b < 2; ++b)
#pragma unroll
            for (int m = 0; m < 4; ++m)
#pragma unroll
                for (int n = 0; n < 2; ++n) acc[a][b][m][n] = (f32x4){0.f, 0.f, 0.f, 0.f};
    bf16x8 At[4][2], B0[2][2], B1[2][2];
    const char* cA = (const char*)g.A + (size_t)cur.pm * tstep; const char* cB = (const char*)g.Bt + (size_t)cur.pb * tstep;
    S.a_ready(cur);
    if constexpr (SP2) {
        PG8_STAGE(PG8_SB(0, 0), cB, voffB); PG8_STAGE(PG8_SB(0, 1), cB + hstep, voffB); PG8_STAGE(PG8_SA(0, 0), cA, voffA); PG8_STAGE(PG8_SA(0, 1), cA + hstep, voffA);
        if (wr == 1) PG8_BAR;
        PG8_WAIT_V(2); PG8_BAR;
        PG8_STAGE(PG8_SB(1, 0), cB + kstep, voffB); PG8_STAGE(PG8_SA(1, 0), cA + kstep, voffA); PG8_STAGE(PG8_SB(1, 1), cB + hstep + kstep, voffB);
        PG8_WAIT_V(6); PG8_BAR;
    } else {
        PG8_STAGE(PG8_SB(0, 0), cB, voffB); PG8_STAGE(PG8_SA(0, 0), cA, voffA); PG8_STAGE(PG8_SB(0, 1), cB + hstep, voffB); PG8_STAGE(PG8_SA(0, 1), cA + hstep, voffA);
        if (wr == 1) PG8_BAR;
        PG8_WAIT_V(4); PG8_BAR;
        PG8_STAGE(PG8_SB(1, 0), cB + kstep, voffB); PG8_STAGE(PG8_SA(1, 0), cA + kstep, voffA); PG8_STAGE(PG8_SB(1, 1), cB + hstep + kstep, voffB);
        PG8_WAIT_V(6); PG8_BAR;
    }
    for (;;) {
        const bool has_next = S.next(ui + 1, nxt);
        const char* nA = has_next ? (const char*)g.A + (size_t)nxt.pm * tstep : cA; const char* nB = has_next ? (const char*)g.Bt + (size_t)nxt.pb * tstep : cB;
        for (int t = 0; t < nt; t += 2) {
            const bool last = (t == nt - 2);
            const char* a1 = cA + (size_t)(t + 1) * kstep;
            const char* a2 = last ? nA : cA + (size_t)(t + 2) * kstep; const char* b2 = last ? nB : cB + (size_t)(t + 2) * kstep;
            const char* a3 = a2 + kstep; const char* b3 = b2 + kstep;
            if (last && has_next) S.a_ready(nxt);
            if constexpr (SP2) {
            PG8_LDB(B0, 0, 0); PG8_LDB(B1, 0, 1); PG8_SCHED; PG8_LDA(At, 0, 0); PG8_STAGE(PG8_SA(1, 1), a1 + hstep, voffA);
            PG8_WAIT_V(8); PG8_WAIT_L(0); PG8_BAR; PG8_MMA(0, 0, At, B0); PG8_MMA(0, 1, At, B1); PG8_BAR; PG8_SCHED;
            PG8_LDA(At, 0, 1); PG8_STAGE(PG8_SB(0, 0), b2, voffB); PG8_STAGE(PG8_SB(0, 1), b2 + hstep, voffB); PG8_STAGE(PG8_SA(0, 0), a2, voffA);
            PG8_WAIT_V(8); PG8_WAIT_L(0); PG8_BAR; PG8_MMA(1, 0, At, B0); PG8_MMA(1, 1, At, B1); PG8_BAR; PG8_SCHED;
            PG8_LDB(B0, 1, 0); PG8_LDB(B1, 1, 1); PG8_SCHED; PG8_LDA(At, 1, 0); PG8_STAGE(PG8_SA(0, 1), a2 + hstep, voffA);
            PG8_WAIT_V(8); PG8_WAIT_L(0); PG8_BAR; PG8_MMA(0, 0, At, B0); PG8_MMA(0, 1, At, B1); PG8_BAR; PG8_SCHED;
            PG8_LDA(At, 1, 1); PG8_STAGE(PG8_SB(1, 0), b3, voffB); PG8_STAGE(PG8_SB(1, 1), b3 + hstep, voffB); PG8_STAGE(PG8_SA(1, 0), a3, voffA);
            PG8_WAIT_V(8); PG8_WAIT_L(0); PG8_BAR; PG8_MMA(1, 0, At, B0); PG8_MMA(1, 1, At, B1); PG8_BAR; PG8_SCHED;
            } else {
            PG8_LDB(B0, 0, 0); PG8_SCHED; PG8_LDA(At, 0, 0); PG8_STAGE(PG8_SA(1, 1), a1 + hstep, voffA);
            PG8_WAIT_L(8); PG8_BAR; PG8_WAIT_L(0); PG8_MMA(0, 0, At, B0); PG8_BAR; PG8_SCHED;
            PG8_LDB(B1, 0, 1); PG8_STAGE(PG8_SB(0, 0), b2, voffB);
            PG8_BAR; PG8_WAIT_L(0); PG8_MMA(0, 1, At, B1); PG8_BAR;
            PG8_LDA(At, 0, 1); PG8_STAGE(PG8_SA(0, 0), a2, voffA);
            PG8_BAR; PG8_WAIT_L(0); PG8_MMA(1, 0, At, B0); PG8_BAR; PG8_SCHED;
            PG8_STAGE(PG8_SB(0, 1), b2 + hstep, voffB);
            PG8_WAIT_V(6); PG8_BAR; PG8_MMA(1, 1, At, B1); PG8_BAR;
            PG8_LDB(B0, 1, 0); PG8_SCHED; PG8_LDA(At, 1, 0); PG8_STAGE(PG8_SA(0, 1), a2 + hstep, voffA);
            PG8_WAIT_L(8); PG8_BAR; PG8_WAIT_L(0); PG8_MMA(0, 0, At, B0); PG8_BAR; PG8_SCHED;
            PG8_LDB(B1, 1, 1); PG8_STAGE(PG8_SB(1, 0), b3, voffB);
            PG8_BAR; PG8_WAIT_L(0); PG8_MMA(0, 1, At, B1); PG8_BAR;
            PG8_LDA(At, 1, 1); PG8_STAGE(PG8_SA(1, 0), a3, voffA);
            PG8_BAR; PG8_WAIT_L(0); PG8_MMA(1, 0, At, B0); PG8_BAR; PG8_SCHED;
            PG8_STAGE(PG8_SB(1, 1), b3 + hstep, voffB);
            PG8_WAIT_V(6); PG8_BAR; PG8_MMA(1, 1, At, B1); PG8_BAR;
            }
        }
        if constexpr (ALIGN_EPI) { if (wr == 0) PG8_BAR; }
        if constexpr (!Epi::AFTER_DRAIN) { E(acc, cur, wr, wc, fr, fq); S.done(cur); }
        if (!has_next) break;
#pragma unroll
        for (int a = 0; a < 2; ++a)
#pragma unroll
            for (int b = 0; b < 2; ++b)
#pragma unroll
                for (int m = 0; m < 4; ++m)
#pragma unroll
                    for (int n = 0; n < 2; ++n) acc[a][b][m][n] = (f32x4){0.f, 0.f, 0.f, 0.f};
        cur = nxt; cA = nA; cB = nB; ++ui;
        if constexpr (ALIGN_EPI) { if (wr == 1) PG8_BAR; }
    }
    PG8_WAIT_V(0);
    if constexpr (!ALIGN_EPI) { if (wr == 0) PG8_BAR; }
    PG8_BAR;
    if constexpr (Epi::AFTER_DRAIN) { E.fused(acc, cur, wr, wc, fr, fq, lds, wid, lane); S.done(cur); }
#undef PG8_SA
#undef PG8_SB
#undef PG8_STAGE
#undef PG8_LDA
#undef PG8_LDB
#undef PG8_MMA
#undef PG8_WAIT_V
#undef PG8_WAIT_L
#undef PG8_BAR
#undef PG8_SCHED
}
}
#include <hip/hip_bf16.h>
#include <cmath>
namespace attn_body {
using bf16=__hip_bfloat16;
using bf16x8=__attribute__((ext_vector_type(8)))short;
using s16x4=__attribute__((ext_vector_type(4)))short;
using f32x16=__attribute__((ext_vector_type(16)))float;
using u32x4=__attribute__((ext_vector_type(4)))unsigned;
constexpr int BATCH=4,NHEAD=16,SEQ=8192,D=64,DM=NHEAD*D;
constexpr int NW=8,QBLK=32,QB=QBLK*NW,KVBLK=64,NQB=SEQ/QB;
constexpr int ATTN_PITCH=DM, ATTN_UNIT_ROWS=QB;
__device__ __forceinline__ int crow(int r,int hi){return (r&3)+8*(r>>2)+4*hi;}
#define SBAR() __builtin_amdgcn_sched_barrier(0)
__device__ __forceinline__ void cmask(f32x16&p0,f32x16&p1,int jb,int qrel,int hi){
  const float NEG=-INFINITY; int kb=64*jb+4*hi;
  #pragma unroll
  for(int r=0;r<16;++r){int kv=kb+(r&3)+8*(r>>2); if(kv>qrel)p0[r]=NEG; if(kv+32>qrel)p1[r]=NEG;}
}

constexpr int NSLOT=3, SLOTB=8192;
constexpr int LDS_K=0, LDS_V=NSLOT*SLOTB, LDS_WS=2*NSLOT*SLOTB, LDS_OST=LDS_WS+NW*64*4, LDS_BYTES=LDS_OST+NW*4096;
constexpr float C2=0.125f*1.4426950408889634f;
__device__ __forceinline__ void glds16(const void*gsrc,unsigned lds_dst){unsigned keep;
  asm volatile("s_mov_b32 %0, m0\n\ts_mov_b32 m0, %2\n\ts_nop 0\n\tglobal_load_lds_dwordx4 %1, off\n\ts_mov_b32 m0, %0":"=&s"(keep):"v"(gsrc),"s"(lds_dst):"memory");}
__device__ __forceinline__ float max3f(float a,float b,float c){float r;asm("v_max3_f32 %0, %1, %2, %3":"=v"(r):"v"(a),"v"(b),"v"(c));return r;}
__device__ __forceinline__ float max2f(float a,float b){float r;asm("v_max_f32_e32 %0, %1, %2":"=v"(r):"v"(a),"v"(b));return r;}
__device__ __forceinline__ float fadd_s(float a,float b){float r;asm("v_add_f32_e32 %0, %1, %2":"=v"(r):"v"(a),"v"(b));return r;}
__device__ __forceinline__ float fsub_s(float a,float b){float r;asm("v_sub_f32_e32 %0, %1, %2":"=v"(r):"v"(a),"v"(b));return r;}
typedef float f32x2_t __attribute__((ext_vector_type(2))); typedef __bf16 bf16x2_t __attribute__((ext_vector_type(2)));
__device__ __forceinline__ unsigned cvtpk_s(float lo,float hi){f32x2_t v={lo,hi};bf16x2_t b=__builtin_convertvector(v,bf16x2_t);return __builtin_bit_cast(unsigned,b);}
#define WAIT_BAR(N) asm volatile("s_waitcnt vmcnt(" #N ") lgkmcnt(0)\n\ts_barrier":::"memory")

__device__ __forceinline__ void qkt(f32x16&p0,f32x16&p1,const char*Kslot,const bf16x8*qr,const f32x16&negm,int r32,int hi){
  const char*kb=Kslot+hi*1024+r32*16;
  #pragma unroll
  for(int d0=0;d0<4;++d0){
    const bf16x8 b0=*reinterpret_cast<const bf16x8*>(kb+d0*2048);
    const bf16x8 b1=*reinterpret_cast<const bf16x8*>(kb+d0*2048+512);
    if(d0==0){p0=__builtin_amdgcn_mfma_f32_32x32x16_bf16(b0,qr[0],negm,0,0,0);p1=__builtin_amdgcn_mfma_f32_32x32x16_bf16(b1,qr[0],negm,0,0,0);}
    else{p0=__builtin_amdgcn_mfma_f32_32x32x16_bf16(b0,qr[d0],p0,0,0,0);p1=__builtin_amdgcn_mfma_f32_32x32x16_bf16(b1,qr[d0],p1,0,0,0);}}
}
typedef __attribute__((address_space(3))) const char* lds_cptr;
typedef short v4i16_t __attribute__((ext_vector_type(4)));
__device__ __forceinline__ void kload8(bf16x8*kf,lds_cptr kp){
  kf[0]=*(const __attribute__((address_space(3))) bf16x8*)(kp);      kf[1]=*(const __attribute__((address_space(3))) bf16x8*)(kp+512);
  kf[2]=*(const __attribute__((address_space(3))) bf16x8*)(kp+2048); kf[3]=*(const __attribute__((address_space(3))) bf16x8*)(kp+2560);
  kf[4]=*(const __attribute__((address_space(3))) bf16x8*)(kp+4096); kf[5]=*(const __attribute__((address_space(3))) bf16x8*)(kp+4608);
  kf[6]=*(const __attribute__((address_space(3))) bf16x8*)(kp+6144); kf[7]=*(const __attribute__((address_space(3))) bf16x8*)(kp+6656);
}
__device__ __forceinline__ void kload2(bf16x8*kf,lds_cptr kp,int j){ kf[2*j]=*(const __attribute__((address_space(3))) bf16x8*)(kp+j*2048); kf[2*j+1]=*(const __attribute__((address_space(3))) bf16x8*)(kp+j*2048+512); }
__device__ __forceinline__ s16x4 vtr(lds_cptr p){ return __builtin_bit_cast(s16x4,__builtin_amdgcn_ds_read_tr16_b64_v4i16((__attribute__((address_space(3))) v4i16_t*)p)); }
__device__ __forceinline__ float rowmax(const f32x16&p0,const f32x16&p1){
  float a=max3f(p0[0],p0[1],p1[0]),b=max3f(p0[2],p0[3],p1[1]);a=max3f(a,p1[2],p1[3]);
  #pragma unroll
  for(int r=4;r<16;r+=4){a=max3f(a,p0[r],p0[r+1]);b=max3f(b,p0[r+2],p0[r+3]);a=max3f(a,p1[r],p1[r+1]);b=max3f(b,p1[r+2],p1[r+3]);}
  const float m=max2f(a,b);
  auto rr=__builtin_amdgcn_permlane32_swap(__float_as_uint(m),__float_as_uint(m),false,false);
  return max2f(__uint_as_float(rr[0]),__uint_as_float(rr[1]));
}
__device__ __forceinline__ void pv(f32x16*o,int vb,bf16x8 pa0,bf16x8 pa1,bf16x8 pa2,bf16x8 pa3){
  #pragma unroll
  for(int d0=0;d0<2;++d0){s16x4 lo[4],hi[4];
    #pragma unroll
    for(int ks=0;ks<4;++ks){
      asm volatile("ds_read_b64_tr_b16 %0,%1 offset:%c2":"=&v"(lo[ks]):"v"(vb),"i"(d0*4096+ks*1024):"memory");
      asm volatile("ds_read_b64_tr_b16 %0,%1 offset:%c2":"=&v"(hi[ks]):"v"(vb),"i"(d0*4096+ks*1024+512):"memory");}
    asm volatile("s_waitcnt lgkmcnt(0)":::"memory");SBAR();
    #define PK(k) (bf16x8){lo[k][0],lo[k][1],lo[k][2],lo[k][3],hi[k][0],hi[k][1],hi[k][2],hi[k][3]}
    o[d0]=__builtin_amdgcn_mfma_f32_32x32x16_bf16(pa0,PK(0),o[d0],0,0,0);
    o[d0]=__builtin_amdgcn_mfma_f32_32x32x16_bf16(pa1,PK(1),o[d0],0,0,0);
    o[d0]=__builtin_amdgcn_mfma_f32_32x32x16_bf16(pa2,PK(2),o[d0],0,0,0);
    o[d0]=__builtin_amdgcn_mfma_f32_32x32x16_bf16(pa3,PK(3),o[d0],0,0,0);
    #undef PK
  }
}

#ifndef ATTN_STORE16
#define ATTN_STORE16(p,v) (*(u32x4*)(p)=(v))
#endif
template<int THRL> __device__ __forceinline__ void attn_unit(int b,int hq,int hv,int qb,const bf16*Q,const bf16*__restrict__ K,const bf16*__restrict__ V,bf16*O,char*shm){
  int tid_=threadIdx.x; asm volatile("":"+v"(tid_)); const int tid=tid_,lane=tid&63,r32=lane&31,hi=lane>>5; const int wid=__builtin_amdgcn_readfirstlane(tid>>6);
  const long rowbase=(long)b*SEQ; const int q0=qb*QB;
  const bf16*Qw=Q+(rowbase+q0+wid*QBLK)*DM+hq*D;
  const bf16*Kh=K+rowbase*DM+hq*D,*Vh=V+rowbase*DM+hv*D;
  const unsigned lds0=(unsigned)(uintptr_t)shm;
  float*wsf=(float*)(shm+LDS_WS)+wid*64;
  const bf16*ksrc=Kh+(long)lane*DM+wid*8;
  const bf16*vsrc=Vh+(long)(16*(wid&3)+(lane>>2))*DM+(wid>>2)*32+(lane&3)*8;
  const unsigned kdst=lds0+LDS_K+wid*1024, vdst=lds0+LDS_V+wid*1024;
  #define DMA_K(t,slot) glds16(ksrc+(long)(t)*KVBLK*DM,(unsigned)__builtin_amdgcn_readfirstlane(kdst+(slot)))
  #define DMA_V(t,slot) glds16(vsrc+(long)(t)*KVBLK*DM,(unsigned)__builtin_amdgcn_readfirstlane(vdst+(slot)))
  const int vb0=(int)(lds0+LDS_V)+((lane>>4)&1)*32+(lane&3)*8+(4*hi+((lane&15)>>2))*64;
  const char*Kbase=shm+LDS_K; bf16x8 kf[8];
  const lds_cptr shm3=(lds_cptr)shm; const lds_cptr kp0=shm3+LDS_K+hi*1024+r32*16; const lds_cptr vp0=shm3+LDS_V+((lane>>4)&1)*32+(lane&3)*8+(4*hi+((lane&15)>>2))*64;
  const int NT=(q0+QB)/KVBLK;
  DMA_K(0,0);DMA_V(0,0);DMA_K(1,SLOTB);
  bf16x8 qr[4];
  #pragma unroll
  for(int d0=0;d0<4;++d0)qr[d0]=*reinterpret_cast<const bf16x8*>(&Qw[(long)r32*DM+d0*16+hi*8]);
  float mhat=0.f,l_reg=0.f;f32x16 o[2];o[0]=f32x16{};o[1]=f32x16{};f32x16 negm=f32x16{};asm volatile("":"+v"(negm));
  const int qrel=wid*QBLK+r32;
  #define CMASK(P0,P1,t) do{int jb_=(t)-(NT-4); if(jb_>=0)cmask(P0,P1,jb_,qrel,hi);}while(0)
  bool resc=false;
  #define START(P0,P1) do{ const float rm=rowmax(P0,P1); resc=false; \
    { const float dl=rm; mhat=fadd_s(mhat,dl); \
      _Pragma("unroll") for(int r=0;r<16;++r){P0[r]=fsub_s(P0[r],dl);P1[r]=fsub_s(P1[r],dl);} \
      _Pragma("unroll") for(int r=0;r<16;++r)negm[r]=-mhat; asm volatile("":"+v"(negm)); } \
    _Pragma("unroll") for(int r=0;r<16;++r)P0[r]=__builtin_amdgcn_exp2f(P0[r]); }while(0)
  #define RESC() do{ if(resc){ asm volatile("s_waitcnt lgkmcnt(0)":::"memory"); \
      _Pragma("unroll") for(int d_=0;d_<2;++d_) _Pragma("unroll") for(int r=0;r<16;++r)o[d_][r]*=wsf[crow(r,hi)]; } }while(0)
  f32x16 pA0,pA1,pB0,pB1;
  int sl_prev=0,sl_cur=0,sl_next=SLOTB;
  #define ROT() do{sl_prev=sl_cur;sl_cur=sl_next;sl_next=(sl_next==(NSLOT-1)*SLOTB)?0:sl_next+SLOTB;}while(0)
  DMA_K(2,2*SLOTB);
  WAIT_BAR(3);
  qkt(pA0,pA1,Kbase,qr,negm,r32,hi);asm volatile("s_nop 15\n\ts_nop 7":"+v"(pA0),"+v"(pA1));CMASK(pA0,pA1,0);
  START(pA0,pA1);
  _Pragma("unroll") for(int r=0;r<16;++r)pA1[r]=__builtin_amdgcn_exp2f(pA1[r]);
  WAIT_BAR(0);
  DMA_K(3,0);DMA_V(1,SLOTB);
  ROT();
  kload8(kf,kp0+sl_cur);
  WAIT_BAR(2);
  s16x4 vlo[8],vhi[8]; u32x4 pw0,pw1,pw2,pw3;
  #define PKW(P,B) cvtpk_s(P[B],P[B+1])
  #define PAF(k) __builtin_bit_cast(bf16x8,pw##k)
  #define VFR(i) (bf16x8){vlo[i][0],vlo[i][1],vlo[i][2],vlo[i][3],vhi[i][0],vhi[i][1],vhi[i][2],vhi[i][3]}
  #define PIN(x) asm volatile("":"+v"(x))
  #define MX3(a,b,c) __builtin_fmaxf(__builtin_fmaxf((a),(b)),(c))
  #define GAPA(MF,A0,A1,A2,A3,W0,W1,PW) do{ MF; sacc+=A0; sacc+=A1; sacc+=A2; sacc+=A3; PIN(sacc); W0; W1; PIN(PW); SBAR(); }while(0)
  #define EX(v) __builtin_amdgcn_exp2f(v)
  #define GAPB(MF,X,B) do{ MF; X[B]=EX(X[B]); X[B+1]=EX(X[B+1]); X[B+2]=EX(X[B+2]); X[B+3]=EX(X[B+3]); PIN(X); SBAR(); }while(0)
  #define VRD(i) do{ vlo[i]=vtr(vp_+(((i)>>2)*4096+((i)&3)*1024)); vhi[i]=vtr(vp_+(((i)>>2)*4096+((i)&3)*1024+512)); }while(0)
  #define KRD(G,j) do{ if(G){ kload2(kf,kp0+sl_next,j); SBAR(); } }while(0)
  #define STEP(C0,C1,P0,P1,t,GK,GV,GL) do{ SBAR(); \
    const lds_cptr vp_=vp0+sl_prev; \
    VRD(0); SBAR(); float sacc=(P0[0]+P0[1]); \
    GAPA(C0=__builtin_amdgcn_mfma_f32_32x32x16_bf16(kf[0],qr[0],negm,0,0,0), P0[2],P0[3],P0[4],P0[5],     pw0[0]=PKW(P0,0), pw0[1]=PKW(P0,2), pw0); \
    VRD(4); SBAR(); GAPA(C1=__builtin_amdgcn_mfma_f32_32x32x16_bf16(kf[1],qr[0],negm,0,0,0), P0[6],P0[7],P0[8],P0[9],     pw0[2]=PKW(P0,4), pw0[3]=PKW(P0,6), pw0); \
    VRD(1); SBAR(); GAPA(C0=__builtin_amdgcn_mfma_f32_32x32x16_bf16(kf[2],qr[1],C0,0,0,0),   P0[10],P0[11],P0[12],P0[13], pw1[0]=PKW(P0,8), pw1[1]=PKW(P0,10), pw1); \
    VRD(5); SBAR(); GAPA(C1=__builtin_amdgcn_mfma_f32_32x32x16_bf16(kf[3],qr[1],C1,0,0,0),   P0[14],P0[15],P1[0],P1[1],   pw1[2]=PKW(P0,12),pw1[3]=PKW(P0,14), pw1); \
    VRD(2); SBAR(); GAPA(C0=__builtin_amdgcn_mfma_f32_32x32x16_bf16(kf[4],qr[2],C0,0,0,0),   P1[2],P1[3],P1[4],P1[5],     pw2[0]=PKW(P1,0), pw2[1]=PKW(P1,2), pw2); \
    VRD(6); SBAR(); GAPA(C1=__builtin_amdgcn_mfma_f32_32x32x16_bf16(kf[5],qr[2],C1,0,0,0),   P1[6],P1[7],P1[8],P1[9],     pw2[2]=PKW(P1,4), pw2[3]=PKW(P1,6), pw2); \
    VRD(3); SBAR(); GAPA(C0=__builtin_amdgcn_mfma_f32_32x32x16_bf16(kf[6],qr[3],C0,0,0,0),   P1[10],P1[11],P1[12],P1[13], pw3[0]=PKW(P1,8), pw3[1]=PKW(P1,10), pw3); \
    VRD(7); SBAR(); GAPA(C1=__builtin_amdgcn_mfma_f32_32x32x16_bf16(kf[7],qr[3],C1,0,0,0),   P1[14],P1[15],0.f,0.f,       pw3[2]=PKW(P1,12),pw3[3]=PKW(P1,14), pw3); \
    l_reg+=sacc; \
    if(GK){DMA_K((t)+3,sl_cur);} if(GV){DMA_V((t)+1,sl_next);} \
    CMASK(C0,C1,t); \
    { float a=MX3(C0[0],C0[1],C1[0]),b=MX3(C0[2],C0[3],C1[1]); a=MX3(a,C1[2],C1[3]); \
      _Pragma("unroll") for(int r=4;r<16;r+=4){a=MX3(a,C0[r],C0[r+1]);b=MX3(b,C0[r+2],C0[r+3]);a=MX3(a,C1[r],C1[r+1]);b=MX3(b,C1[r+2],C1[r+3]);} \
      float rm=__builtin_fmaxf(a,b); { auto rr=__builtin_amdgcn_permlane32_swap(__float_as_uint(rm),__float_as_uint(rm),false,false); rm=__builtin_fmaxf(__uint_as_float(rr[0]),__uint_as_float(rr[1])); } \
      resc=false; \
      if(__builtin_expect(__any(rm>(float)THRL),0)){ const float dl=__builtin_fmaxf(rm,0.f); mhat+=dl; \
        _Pragma("unroll") for(int r=0;r<16;++r){C0[r]-=dl;C1[r]-=dl;} \
        _Pragma("unroll") for(int r=0;r<16;++r)negm[r]=-mhat; asm volatile("":"+v"(negm)); \
        const float f=__builtin_amdgcn_exp2f(-dl); l_reg*=f; if(hi==0)wsf[r32]=f; resc=true; } } \
    SBAR(); \
    GAPB(o[0]=__builtin_amdgcn_mfma_f32_32x32x16_bf16(PAF(0),VFR(0),o[0],0,0,0), C0,0); \
    GAPB(o[1]=__builtin_amdgcn_mfma_f32_32x32x16_bf16(PAF(0),VFR(4),o[1],0,0,0), C0,4); \
    KRD(GL,0); GAPB(o[0]=__builtin_amdgcn_mfma_f32_32x32x16_bf16(PAF(1),VFR(1),o[0],0,0,0), C0,8); \
    KRD(GL,1); GAPB(o[1]=__builtin_amdgcn_mfma_f32_32x32x16_bf16(PAF(1),VFR(5),o[1],0,0,0), C0,12); \
    KRD(GL,2); GAPB(o[0]=__builtin_amdgcn_mfma_f32_32x32x16_bf16(PAF(2),VFR(2),o[0],0,0,0), C1,0); \
    KRD(GL,3); GAPB(o[1]=__builtin_amdgcn_mfma_f32_32x32x16_bf16(PAF(2),VFR(6),o[1],0,0,0), C1,4); \
    GAPB(o[0]=__builtin_amdgcn_mfma_f32_32x32x16_bf16(PAF(3),VFR(3),o[0],0,0,0), C1,8); \
    GAPB(o[1]=__builtin_amdgcn_mfma_f32_32x32x16_bf16(PAF(3),VFR(7),o[1],0,0,0), C1,12); \
    }while(0)
  int t=1;
  #undef CMASK
  #define CMASK(P0,P1,t) do{}while(0)
  for(;t+5<NT;t+=2){
    STEP(pB0,pB1,pA0,pA1,t,true,true,true);     WAIT_BAR(2); RESC(); ROT();
    STEP(pA0,pA1,pB0,pB1,t+1,true,true,true);   WAIT_BAR(2); RESC(); ROT();
  }
  #undef CMASK
  #define CMASK(P0,P1,t) do{int jb_=(t)-(NT-4); if(jb_>=0)cmask(P0,P1,jb_,qrel,hi);}while(0)
  #define ENDW(tt) do{ if((tt)+3<NT){WAIT_BAR(2);} else if((tt)+2<NT){WAIT_BAR(1);} else {WAIT_BAR(0);} }while(0)
  for(;t+1<NT;t+=2){
    STEP(pB0,pB1,pA0,pA1,t,(t+3<NT),(t+1<NT),(t+1<NT));       ENDW(t);   RESC(); ROT();
    STEP(pA0,pA1,pB0,pB1,t+1,(t+4<NT),(t+2<NT),(t+2<NT));     ENDW(t+1); RESC(); ROT();
  }
  STEP(pB0,pB1,pA0,pA1,NT-1,false,false,false); RESC();
  { float sacc=pB0[0]+pB0[1]; _Pragma("unroll") for(int r=2;r<16;++r)sacc+=pB0[r]; _Pragma("unroll") for(int r=0;r<16;++r)sacc+=pB1[r]; l_reg+=sacc;
    pw0=(u32x4){PKW(pB0,0),PKW(pB0,2),PKW(pB0,4),PKW(pB0,6)};pw1=(u32x4){PKW(pB0,8),PKW(pB0,10),PKW(pB0,12),PKW(pB0,14)};pw2=(u32x4){PKW(pB1,0),PKW(pB1,2),PKW(pB1,4),PKW(pB1,6)};pw3=(u32x4){PKW(pB1,8),PKW(pB1,10),PKW(pB1,12),PKW(pB1,14)};
    SBAR(); pv(o,vb0+sl_cur,PAF(0),PAF(1),PAF(2),PAF(3)); }
  #undef PKW
  #undef PAF
  #undef VFR
  #undef PIN
  #undef MX3
  #undef GAPA
  #undef GAPB
  #undef EX
  #undef VRD
  #undef KRD
  #undef STEP
  #undef ENDW
  {auto rr=__builtin_amdgcn_permlane32_swap(__float_as_uint(l_reg),__float_as_uint(l_reg),false,false);l_reg=__uint_as_float(rr[0])+__uint_as_float(rr[1]);}
  if(hi==0)wsf[32+r32]=l_reg;asm volatile("s_waitcnt lgkmcnt(0)":::"memory");
  float rli[16];
  #pragma unroll
  for(int r=0;r<16;++r)rli[r]=__builtin_amdgcn_rcpf(wsf[32+crow(r,hi)]);
  bf16*Ow=O+(rowbase+q0+wid*QBLK)*DM+hv*D;
  { bf16*stg=(bf16*)(shm+LDS_OST)+wid*2048;
    #pragma unroll
    for(int r=0;r<16;++r){const int orow=crow(r,hi);
      #pragma unroll
      for(int d0=0;d0<2;++d0)stg[orow*64+d0*32+r32]=__float2bfloat16(o[d0][r]*rli[r]);}
    asm volatile("s_waitcnt lgkmcnt(0)":::"memory");
    #pragma unroll
    for(int i=0;i<4;++i){const int row=i*8+(lane>>3),ch=lane&7; const u32x4 v=*(const u32x4*)(stg+row*64+ch*8); ATTN_STORE16(Ow+(long)row*DM+ch*8,v);} }
  asm volatile("s_waitcnt lgkmcnt(0)\n\ts_barrier":::"memory");
  #undef DMA_K
  #undef DMA_V
  #undef CMASK
  #undef START
  #undef RESC
  #undef ROT
}
constexpr int ATTN_LDS_BYTES=LDS_BYTES;
struct DiffTensors { const bf16* Q; const bf16* K; const bf16* V; bf16* O0; bf16* O1; };
template<int THRL=8> __device__ __forceinline__ void diff_attn_phase(char*lds,const DiffTensors&T,int vcu,int G){
  for(int pr=vcu>>1; pr<BATCH*32; pr+=(G>>1)){
    const int s=vcu&1, b=pr>>5, h=(pr>>2)&7, c=(pr>>1)&1, vh=pr&1;
    for(int j=15;j>=0;--j){ const int qb=2*j+((j&1)?1-s:s);
      attn_unit<THRL>(b,2*h+c,2*h+vh,qb,T.Q,T.K,T.V,c?T.O1:T.O0,lds); } }
}
#undef SBAR
#undef WAIT_BAR
}

constexpr int NB = 4, SEQ = 8192, T = NB * SEQ, D = 1024;
constexpr int NE = 32, TOPK = 4;
constexpr int GLA_H = 4, GLA_DK = 128, GLA_DV = 256, GLA_C = 64, GLA_RUN = 8, GLA_NRUN = SEQ / (GLA_C * GLA_RUN), GLA_UNITS = NB * GLA_H * GLA_NRUN;
constexpr int NQKVR = 3072, LDW_IN = 3088;
constexpr float LN_EPS = 1e-5f, RMS_EPS = 1e-5f, DN_ALPHA = 1.4142135623730951f;
constexpr float LAMBDA_INIT = 0.35550906759096926f;
constexpr int NPAN_MAX = 544, NPAD_MAX = NPAN_MAX * 256;
constexpr int NWAVES = 8, NTHR = 512;
constexpr int NPHASE = 20;
#ifndef MK_N_LAUNCHES
#define MK_N_LAUNCHES 20
#endif
constexpr int N_LAUNCHES = MK_N_LAUNCHES;

constexpr size_t MiB = 1u << 20;
constexpr size_t WS_CTL = 0, CTL_ZERO_BYTES = 1 * MiB;
constexpr size_t WS_META = 2 * MiB;
constexpr size_t WS_TOPI = WS_META, WS_TOPG = WS_META + MiB / 2, WS_LRANK = WS_META + MiB, WS_SLOT = WS_META + 3 * MiB / 2, WS_CNT = WS_META + 2 * MiB, WS_PEXP = WS_META + 2 * MiB + MiB / 4;
constexpr size_t WS_GKLOW = WS_META + 3 * MiB, WS_COS = WS_META + 5 * MiB, WS_SIN = WS_META + 9 * MiB;
constexpr size_t WS_WIN = 16 * MiB, WS_WAO = 22 * MiB, WS_WKVQ = 24 * MiB, WS_WBO = 30 * MiB, WS_WGU = 32 * MiB, WS_WD = 288 * MiB;
constexpr size_t WS_XB = 416 * MiB;
constexpr size_t WS_Y = 480 * MiB;
constexpr size_t WS_X1 = 608 * MiB;
constexpr size_t WS_X1B = 736 * MiB;
constexpr size_t WS_X2 = 800 * MiB;
constexpr size_t WS_X2B = 928 * MiB;
constexpr size_t WS_M = 992 * MiB;
constexpr size_t WS_XG = WS_M, WS_ACT = WS_M + 272 * MiB, WS_YB = WS_M + 544 * MiB;
constexpr size_t WS_QKVR = WS_M, WS_OLOC = WS_M + 192 * MiB, WS_QDEC = WS_M + 320 * MiB, WS_SEND = WS_M + 352 * MiB, WS_SINIT = WS_M + 384 * MiB, WS_GSUM = WS_M + 400 * MiB, WS_OG = WS_M + 408 * MiB;
constexpr size_t WS_KB = WS_M, WS_VB = WS_M + 64 * MiB, WS_QB = WS_M + 128 * MiB, WS_O0 = WS_M + 192 * MiB, WS_O1 = WS_M + 256 * MiB, WS_OB = WS_M + 320 * MiB;
constexpr size_t WS_END = 1808 * MiB;
constexpr int CW_BAR = 4096;

constexpr int PHASE_LDS = 155648;
constexpr int MISC_OFF = PHASE_LDS, LDS_BYTES = PHASE_LDS + 512;
#define GAS __attribute__((address_space(1)))
#define LAS __attribute__((address_space(3)))
typedef unsigned short bf16;
typedef unsigned v4u __attribute__((ext_vector_type(4)));
typedef float f32x4 __attribute__((ext_vector_type(4)));
typedef short bf16x8 __attribute__((ext_vector_type(8)));
typedef GAS unsigned gu32;
typedef GAS unsigned long long gu64;
#define RLX_AGENT __ATOMIC_RELAXED, __HIP_MEMORY_SCOPE_AGENT
#define LDS_WAIT() asm volatile("s_waitcnt lgkmcnt(0)" ::: "memory")
#define VM_WAIT() asm volatile("s_waitcnt vmcnt(0)" ::: "memory")
__device__ __forceinline__ unsigned long long rt() { return __builtin_amdgcn_s_memrealtime(); }
__device__ __forceinline__ unsigned f2bf(float f) { unsigned u = __builtin_bit_cast(unsigned, f); return (u + 0x7fffu + ((u >> 16) & 1u)) >> 16; }
__device__ __forceinline__ unsigned pk2(float lo, float hi) { return f2bf(lo) | (f2bf(hi) << 16); }

#define XB_TMO      128
#define XB_XCNT(j)  (256  + 64 * (j))
#define XB_XSUB(j)  (1280 + 64 * (j))
#define XB_XGEN(j)  (2304 + 64 * (j))
#define XB_TOP      3328
#define XB_TOPGEN   3392
#define XCD_BAR_WORDS 3456
#define XB_SPIN_CAP (1u << 18)

__device__ __forceinline__ unsigned xb_ld(unsigned* p)              { return __hip_atomic_load(p, __ATOMIC_RELAXED, __HIP_MEMORY_SCOPE_AGENT); }
__device__ __forceinline__ unsigned xb_add(unsigned* p, unsigned v) { return __hip_atomic_fetch_add(p, v, __ATOMIC_RELAXED, __HIP_MEMORY_SCOPE_AGENT); }
__device__ __forceinline__ unsigned xb_xcc_id() { return (unsigned)__builtin_amdgcn_s_getreg((3 << 11) | 20) & 0xFu; }
#define XB_SPIN(cond, bar) do { unsigned _sp = 0; while (cond) { __builtin_amdgcn_s_sleep(1); \
    if ((++_sp & 255u) == 0u) { if (xb_ld(&(bar)[XB_TMO])) break; if (_sp > XB_SPIN_CAP) { atomicAdd(&(bar)[XB_TMO], 1u); break; } } } } while (0)

struct XcdBarrier {
    unsigned* bar; unsigned x;
    volatile LAS unsigned* st;
};

__device__ __forceinline__ XcdBarrier xcd_barrier_post(unsigned* bar, volatile LAS unsigned* st) {
    XcdBarrier b; b.bar = bar; b.x = xb_xcc_id(); b.st = st;
    if (threadIdx.x == 0) (void)xb_add(&bar[XB_XCNT(b.x)], 1u);
    return b;
}
__device__ __forceinline__ void xcd_barrier_complete(unsigned* bar, unsigned x, unsigned& nloc, unsigned& nx) {
    const unsigned G = gridDim.x * gridDim.y * gridDim.z;
    unsigned sum, cnt, mine, sp = 0u;
    for (;;) {
        sum = 0u; cnt = 0u; mine = 0u;
#pragma unroll
        for (unsigned j = 0; j < 16; ++j) { const unsigned c = xb_ld(&bar[XB_XCNT(j)]); sum += c; cnt += (c > 0u) ? 1u : 0u; mine = (j == x) ? c : mine; }
        if (sum == G) break;
        __builtin_amdgcn_s_sleep(1);
        if ((++sp & 255u) == 0u) { if (xb_ld(&bar[XB_TMO])) break; if (sp > XB_SPIN_CAP) { atomicAdd(&bar[XB_TMO], 1u); break; } }
    }
    nloc = mine > 0u ? mine : 1u; nx = cnt > 0u ? cnt : 1u;
}

__device__ __forceinline__ void xcd_barrier(const XcdBarrier& b) {
    asm volatile("s_waitcnt vmcnt(0)" ::: "memory");
    __syncthreads();
    if (threadIdx.x == 0) {
        unsigned* bar = b.bar;
        __builtin_amdgcn_s_waitcnt(0);
        unsigned nloc = b.st[0], nx = b.st[1];
        if (nloc == 0u) { xcd_barrier_complete(bar, b.x, nloc, nx); b.st[0] = nloc; b.st[1] = nx; }
        const unsigned old = xb_add(&bar[XB_XSUB(b.x)], 1u);
        const unsigned gen = old / nloc;
        if (old + 1u == (gen + 1u) * nloc) {
            __builtin_amdgcn_fence(__ATOMIC_RELEASE, "agent");
            asm volatile("s_waitcnt vmcnt(0)" ::: "memory");
            const unsigned og = xb_add(&bar[XB_TOP], 1u);
            const unsigned tg = og / nx;
            if (og + 1u == (tg + 1u) * nx) xb_add(&bar[XB_TOPGEN], 1u);
            else XB_SPIN(xb_ld(&bar[XB_TOPGEN]) == tg, bar);
            __builtin_amdgcn_fence(__ATOMIC_ACQUIRE, "agent");
            xb_add(&bar[XB_XGEN(b.x)], 1u);
            asm volatile("s_waitcnt vmcnt(0)" ::: "memory");
        } else {
            XB_SPIN(xb_ld(&bar[XB_XGEN(b.x)]) == gen, bar);
            __builtin_amdgcn_fence(__ATOMIC_ACQUIRE, "agent");
            asm volatile("s_waitcnt vmcnt(0)" ::: "memory");
        }
    }
    __syncthreads();
}

typedef float f32x16 __attribute__((ext_vector_type(16)));
typedef float f32x2 __attribute__((ext_vector_type(2)));
typedef __bf16 bf16x2_t __attribute__((ext_vector_type(2)));
typedef unsigned u32x2 __attribute__((ext_vector_type(2)));
__device__ __forceinline__ unsigned cvtpk(float lo, float hi) { f32x2 v = {lo, hi}; bf16x2_t b = __builtin_convertvector(v, bf16x2_t); return __builtin_bit_cast(unsigned, b); }
__device__ __forceinline__ float bf_lo(unsigned w) { return __builtin_bit_cast(float, w << 16); }
__device__ __forceinline__ float bf_hi(unsigned w) { return __builtin_bit_cast(float, w & 0xffff0000u); }
__device__ __forceinline__ float bf2f(unsigned short u) { return __builtin_bit_cast(float, (unsigned)u << 16); }
__device__ __forceinline__ int crow(int r, int hi) { return (r & 3) + 8 * (r >> 2) + 4 * hi; }
#define MFMA32(a, b, c) __builtin_amdgcn_mfma_f32_32x32x16_bf16((a), (b), (c), 0, 0, 0)
__device__ __forceinline__ bf16x8 pack_step(const f32x16& x, int s) {
    v4u p; p.x = cvtpk(x[8 * s], x[8 * s + 1]); p.y = cvtpk(x[8 * s + 2], x[8 * s + 3]); p.z = cvtpk(x[8 * s + 4], x[8 * s + 5]); p.w = cvtpk(x[8 * s + 6], x[8 * s + 7]);
    return __builtin_bit_cast(bf16x8, p);
}
__device__ __forceinline__ bf16x8 lds_frag2(const LAS unsigned char* p) {
    const u32x2 a = *(const LAS u32x2*)p, b = *(const LAS u32x2*)(p + 16); v4u w = {a.x, a.y, b.x, b.y}; return __builtin_bit_cast(bf16x8, w);
}
__device__ __forceinline__ float wave_sum(float v) {
#pragma unroll
    for (int o = 1; o < 64; o <<= 1) v += __shfl_xor(v, o);
    return v;
}
__device__ __forceinline__ float wave_max(float v) {
#pragma unroll
    for (int o = 1; o < 64; o <<= 1) v = fmaxf(v, __shfl_xor(v, o));
    return v;
}
__device__ __forceinline__ int wave_min_i(int v) {
#pragma unroll
    for (int o = 1; o < 64; o <<= 1) { const int t = __shfl_xor(v, o); v = t < v ? t : v; }
    return v;
}
template <int N> __device__ __forceinline__ float treduce(float (&p)[N], int lane) {
    int mask = 32;
#pragma unroll
    for (int W = N; W > 1; W >>= 1, mask >>= 1) {
        const bool up = (lane & mask) != 0; const int half = W >> 1;
#pragma unroll
        for (int i = 0; i < half; ++i) { const float send = up ? p[i] : p[half + i], keep = up ? p[half + i] : p[i]; p[i] = keep + __shfl_xor(send, mask); }
    }
    float r = p[0];
    for (; mask >= 1; mask >>= 1) r += __shfl_xor(r, mask);
    return r;
}

struct Frame {
    LAS unsigned char* lds;
    volatile LAS unsigned* MISC;
    gu32* ctl;
    unsigned char* ws;
    const void* const* in;
    float* out;
    int tid, lane, wave, vcu, G;
};
#define WSP(type, off) ((type*)(F.ws + (off)))

__device__ __forceinline__ int map_row(int mode, int n) {
    if (mode == 1) return ((n & 1023) >> 7) * 256 + (n >> 10) * 128 + (n & 127);
    if (mode == 2) return (n & ~255) + ((n >> 5) & 1) * 128 + ((n >> 6) & 3) * 32 + (n & 31);
    return n;
}
__device__ __forceinline__ void p0_transpose_item(const float* W, int K, int ldw, int ncols, bf16* WT, int col_off, int mode, LAS float* scr, int item, int lane) {
    const int nblk = ncols / 32, kb = item / nblk, nb = item % nblk, k0 = 64 * kb, n0 = 32 * nb;
#pragma unroll 8
    for (int i = 0; i < 32; ++i) { const int kk = 2 * i + (lane >> 5); scr[kk * 33 + (lane & 31)] = W[(size_t)(k0 + kk) * ldw + n0 + (lane & 31)]; }
    LDS_WAIT(); asm volatile("" ::: "memory");
    const int c = lane & 7, rbase = map_row(mode, col_off + n0);
#pragma unroll
    for (int j = 0; j < 4; ++j) { const int n = (lane >> 3) + 8 * j; const LAS float* s = scr + (8 * c) * 33 + n;
        v4u o; o.x = pk2(s[0 * 33], s[1 * 33]); o.y = pk2(s[2 * 33], s[3 * 33]); o.z = pk2(s[4 * 33], s[5 * 33]); o.w = pk2(s[6 * 33], s[7 * 33]);
        *(GAS v4u*)(WT + (size_t)(rbase + n) * K + k0 + 8 * c) = o; }
    LDS_WAIT(); asm volatile("" ::: "memory");
}
__device__ __forceinline__ void p0_prologue(Frame& F) {
    const int gw = F.vcu * NWAVES + F.wave, NGW = F.G * NWAVES;
    {
        LAS float* scr = (LAS float*)(F.lds + F.wave * 8448);
        const float* a_w_in = (const float*)F.in[2]; const float* a_w_out = (const float*)F.in[6]; const float* kv_w = (const float*)F.in[7]; const float* b_w_q = (const float*)F.in[8];
        const float* b_w_out = (const float*)F.in[11]; const float* w_gu = (const float*)F.in[18]; const float* w_dn = (const float*)F.in[20];
        constexpr int I_IN = 16 * 96, I_SQ = 16 * 32, I_KV = 16 * 64, I_GU = 16 * 64, I_DN = 16 * 32;
        constexpr int NITEMS = I_IN + I_SQ + I_KV + I_SQ + I_SQ + 64 * I_GU + 64 * I_DN;
        for (int it = gw; it < NITEMS; it += NGW) {
            int r = it;
            if (r < I_IN) { p0_transpose_item(a_w_in, D, LDW_IN, NQKVR, WSP(bf16, WS_WIN), 0, 0, scr, r, F.lane); continue; } r -= I_IN;
            if (r < I_SQ) { p0_transpose_item(a_w_out, D, D, D, WSP(bf16, WS_WAO), 0, 0, scr, r, F.lane); continue; } r -= I_SQ;
            if (r < I_KV) { p0_transpose_item(kv_w, D, 2048, 2048, WSP(bf16, WS_WKVQ), 0, 2, scr, r, F.lane); continue; } r -= I_KV;
            if (r < I_SQ) { p0_transpose_item(b_w_q, D, D, D, WSP(bf16, WS_WKVQ), 2048, 2, scr, r, F.lane); continue; } r -= I_SQ;
            if (r < I_SQ) { p0_transpose_item(b_w_out, D, D, D, WSP(bf16, WS_WBO), 0, 0, scr, r, F.lane); continue; } r -= I_SQ;
            if (r < 64 * I_GU) { const int m = r / I_GU; p0_transpose_item(w_gu + (size_t)m * 1024 * 2048, D, 2048, 2048, WSP(bf16, WS_WGU) + (size_t)m * 2048 * 1024, 0, 1, scr, r % I_GU, F.lane); continue; } r -= 64 * I_GU;
            { const int m = r / I_DN; p0_transpose_item(w_dn + (size_t)m * 1024 * 1024, D, D, D, WSP(bf16, WS_WD) + (size_t)m * 1024 * 1024, 0, 0, scr, r % I_DN, F.lane); }
        }
    }
    __syncthreads();
    {
        const float* a_w_in = (const float*)F.in[2]; const float* x = (const float*)F.in[0];
        LAS float* Wgl = (LAS float*)F.lds;
        for (int idx = F.tid; idx < 1024 * 16; idx += NTHR) { const int k = idx >> 4, c = idx & 15, l = (k & 255) >> 2, jc = (k >> 8) * 4 + (k & 3);
            Wgl[(jc * 64 + l) * 20 + c] = a_w_in[(size_t)k * LDW_IN + NQKVR + c]; }
        __syncthreads();
        bf16* XB = WSP(bf16, WS_XB); float* GK = WSP(float, WS_GKLOW);
        for (int m = gw; m < T; m += NGW) {
            asm volatile("" ::: "memory");
            const GAS f32x4* xr = (const GAS f32x4*)(x + (size_t)m * D) + F.lane;
            f32x4 v[4];
#pragma unroll
            for (int j = 0; j < 4; ++j) v[j] = xr[64 * j];
            GAS unsigned long long* o8 = (GAS unsigned long long*)(XB + (size_t)m * D) + F.lane;
#pragma unroll
            for (int j = 0; j < 4; ++j) o8[64 * j] = (unsigned long long)pk2(v[j].x, v[j].y) | ((unsigned long long)pk2(v[j].z, v[j].w) << 32);
            float p[16];
#pragma unroll
            for (int c = 0; c < 16; ++c) p[c] = 0.f;
#pragma unroll
            for (int j = 0; j < 4; ++j)
#pragma unroll
                for (int cc = 0; cc < 4; ++cc) { const float xv = v[j][cc]; const LAS f32x4* wp = (const LAS f32x4*)(Wgl + ((j * 4 + cc) * 64 + F.lane) * 20);
#pragma unroll
                    for (int q = 0; q < 4; ++q) { const f32x4 w = wp[q]; p[4 * q] += xv * w.x; p[4 * q + 1] += xv * w.y; p[4 * q + 2] += xv * w.z; p[4 * q + 3] += xv * w.w; } }
            const float r = treduce<16>(p, F.lane);
            if ((F.lane & 3) == 0) GK[(size_t)m * 16 + (F.lane >> 2)] = r;
        }
    }
    {
        const int* pos = (const int*)F.in[1]; float* CT = WSP(float, WS_COS); float* ST = WSP(float, WS_SIN);
        for (int idx = F.vcu * NTHR + F.tid; idx < T * 32; idx += F.G * NTHR) { const int row = idx >> 5, i = idx & 31;
            const float inv = exp2f(-(float)i * 0.41524101186092029f); const float ang = (float)pos[row] * inv;
            const double rev = (double)ang * 0.15915494309189535; const float fr = (float)(rev - floor(rev));
            CT[idx] = __builtin_amdgcn_cosf(fr); ST[idx] = __builtin_amdgcn_sinf(fr); }
    }
    __syncthreads();
}

constexpr int G1_QIN = 0, G1_KIN = 17408, G1_KST = 34816, G1_VT = 53248, G1_GK = 90112, G1_SEG = 94208, G1_DEC = 96256;
constexpr int QROW = 272, TROW = 144;
__device__ __forceinline__ void gla_stage1(Frame& F) {
    const float* w_gk2 = (const float*)F.in[3]; const float* b_gk = (const float*)F.in[4];
    const bf16* QKVR = WSP(bf16, WS_QKVR); const float* GKL = WSP(float, WS_GKLOW);
    float* OLOC = WSP(float, WS_OLOC); bf16* QDEC = WSP(bf16, WS_QDEC); float* SEND = WSP(float, WS_SEND); float* GSUM = WSP(float, WS_GSUM);
    LAS unsigned char* L = F.lds;
    const int tid = F.tid, lane = F.lane, w = F.wave, r = lane & 31, hh = lane >> 5;
    const int d = tid & 127, seg = tid >> 7;
    const int vcol = tid & 255, jh = tid >> 8;
    for (int u = blockIdx.x; u < GLA_UNITS; u += F.G) {
        const int b = u >> 6, h = (u >> 4) & 3, run = u & 15; const size_t t0 = (size_t)b * SEQ + (size_t)run * (GLA_C * GLA_RUN);
        float w2[16];
#pragma unroll
        for (int k = 0; k < 16; ++k) w2[k] = w_gk2[k * 512 + h * 128 + d];
        const float bgk = b_gk[h * 128 + d];
        float cum = 0.f;
        f32x16 S[4];
#pragma unroll
        for (int t = 0; t < 4; ++t) S[t] = f32x16{};
        for (int c = 0; c < GLA_RUN; ++c) {
            const size_t r0 = t0 + (size_t)c * GLA_C;
            if (tid < 256) { const int row = tid >> 2, part = tid & 3; *(LAS f32x4*)(L + G1_GK + (row * 16 + part * 4) * 4) = *(const f32x4*)(GKL + (r0 + row) * 16 + part * 4); }
            {
                const bf16* vp = QKVR + (r0 + 32 * jh) * NQKVR + 1024 + h * 256 + vcol;
                unsigned pk[16];
#pragma unroll
                for (int jj = 0; jj < 16; ++jj) { const unsigned lo = vp[(size_t)(2 * jj) * NQKVR], hi = vp[(size_t)(2 * jj + 1) * NQKVR]; pk[jj] = lo | (hi << 16); }
#pragma unroll
                for (int q = 0; q < 4; ++q) *(LAS v4u*)(L + G1_VT + vcol * TROW + jh * 64 + q * 16) = (v4u){pk[4 * q], pk[4 * q + 1], pk[4 * q + 2], pk[4 * q + 3]};
            }
            __syncthreads();
            float Gl[16]; float rs = 0.f;
#pragma unroll
            for (int ii = 0; ii < 16; ++ii) { const LAS f32x4* gp = (const LAS f32x4*)(L + G1_GK + (16 * seg + ii) * 64);
                float z = bgk;
#pragma unroll
                for (int q = 0; q < 4; ++q) { const f32x4 g = gp[q]; z += g.x * w2[4 * q] + g.y * w2[4 * q + 1] + g.z * w2[4 * q + 2] + g.w * w2[4 * q + 3]; }
                const float ls = fminf(z, 0.f) - __logf(1.0f + __expf(-fabsf(z)));
                rs += ls * (1.0f / 16.0f); Gl[ii] = rs; }
            *(LAS float*)(L + G1_SEG + (seg * 128 + d) * 4) = rs;
            __syncthreads();
            float off = 0.f, glast = 0.f;
#pragma unroll
            for (int s = 0; s < 4; ++s) { const float sv = *(const LAS float*)(L + G1_SEG + (s * 128 + d) * 4); glast += sv; if (s < seg) off += sv; }
            const float ecum = __expf(cum);
            unsigned kst[8];
#pragma unroll
            for (int ii = 0; ii < 16; ii += 2) {
                float ks2[2];
#pragma unroll
                for (int e = 0; e < 2; ++e) { const int i = 16 * seg + ii + e; const size_t row = r0 + i;
                    const float qv = bf2f(QKVR[row * NQKVR + h * 128 + d]), kv = bf2f(QKVR[row * NQKVR + 512 + h * 128 + d]);
                    const float G = Gl[ii + e] + off; const float qin = qv * 0.08838834764831845f * __expf(G);
                    *(LAS unsigned short*)(L + G1_QIN + i * QROW + d * 2) = (unsigned short)f2bf(qin);
                    *(LAS unsigned short*)(L + G1_KIN + i * QROW + d * 2) = (unsigned short)f2bf(kv * __expf(-G));
                    QDEC[row * 512 + h * 128 + d] = (bf16)f2bf(qin * ecum);
                    ks2[e] = kv * __expf(glast - G); }
                kst[ii >> 1] = pk2(ks2[0], ks2[1]);
            }
            *(LAS v4u*)(L + G1_KST + d * TROW + seg * 32) = (v4u){kst[0], kst[1], kst[2], kst[3]};
            *(LAS v4u*)(L + G1_KST + d * TROW + seg * 32 + 16) = (v4u){kst[4], kst[5], kst[6], kst[7]};
            if (seg == 0) *(LAS float*)(L + G1_DEC + d * 4) = __expf(glast);
            cum += glast;
            __syncthreads();
            f32x16 X00 = f32x16{}, X01 = f32x16{}, X11 = f32x16{};
#pragma unroll
            for (int s = 0; s < 8; ++s) { const int ko = (16 * s + 8 * hh) * 2;
                const bf16x8 aK0 = *(const LAS bf16x8*)(L + G1_KIN + r * QROW + ko), aK1 = *(const LAS bf16x8*)(L + G1_KIN + (32 + r) * QROW + ko);
                const bf16x8 bQ0 = *(const LAS bf16x8*)(L + G1_QIN + r * QROW + ko), bQ1 = *(const LAS bf16x8*)(L + G1_QIN + (32 + r) * QROW + ko);
                X00 = MFMA32(aK0, bQ0, X00); X01 = MFMA32(aK0, bQ1, X01); X11 = MFMA32(aK1, bQ1, X11); }
#pragma unroll
            for (int q = 0; q < 16; ++q) { const bool keep = crow(q, hh) <= r; X00[q] = keep ? X00[q] : 0.f; X11[q] = keep ? X11[q] : 0.f; }
            f32x16 o0 = f32x16{}, o1 = f32x16{};
            const LAS unsigned char* vrow = L + G1_VT + (32 * w + r) * TROW;
#pragma unroll
            for (int s = 0; s < 2; ++s) { const bf16x8 v0 = lds_frag2(vrow + (16 * s + 4 * hh) * 2), v1 = lds_frag2(vrow + (32 + 16 * s + 4 * hh) * 2);
                o0 = MFMA32(pack_step(X00, s), v0, o0); o1 = MFMA32(pack_step(X01, s), v0, o1); o1 = MFMA32(pack_step(X11, s), v1, o1); }
#pragma unroll
            for (int t = 0; t < 4; ++t)
#pragma unroll
                for (int s = 0; s < 2; ++s) { const bf16x8 xs = pack_step(S[t], s); const int doff = (32 * t + 16 * s + 4 * hh) * 2;
                    o0 = MFMA32(lds_frag2(L + G1_QIN + r * QROW + doff), xs, o0); o1 = MFMA32(lds_frag2(L + G1_QIN + (32 + r) * QROW + doff), xs, o1); }
            {   float* op = OLOC + (r0 + 4 * hh) * D + h * 256 + 32 * w + r;
#pragma unroll
                for (int q = 0; q < 16; ++q) { const int rr = (q & 3) + 8 * (q >> 2); op[(size_t)rr * D] = o0[q]; op[(size_t)(32 + rr) * D] = o1[q]; } }
#pragma unroll
            for (int t = 0; t < 4; ++t) {
#pragma unroll
                for (int g = 0; g < 4; ++g) { const f32x4 dv = *(const LAS f32x4*)(L + G1_DEC + (32 * t + 8 * g + 4 * hh) * 4);
                    S[t][4 * g] *= dv.x; S[t][4 * g + 1] *= dv.y; S[t][4 * g + 2] *= dv.z; S[t][4 * g + 3] *= dv.w; }
#pragma unroll
                for (int s = 0; s < 4; ++s) { const int jo = (16 * s + 8 * hh) * 2;
                    S[t] = MFMA32(*(const LAS bf16x8*)(L + G1_KST + (32 * t + r) * TROW + jo), *(const LAS bf16x8*)(L + G1_VT + (32 * w + r) * TROW + jo), S[t]); }
            }
            __syncthreads();
        }
        {   float* sp = SEND + ((size_t)u * 256 + 32 * w + r) * 128 + 4 * hh;
#pragma unroll
            for (int t = 0; t < 4; ++t)
#pragma unroll
                for (int g = 0; g < 4; ++g) *(f32x4*)(sp + 32 * t + 8 * g) = (f32x4){S[t][4 * g], S[t][4 * g + 1], S[t][4 * g + 2], S[t][4 * g + 3]}; }
        if (seg == 0) GSUM[u * 128 + d] = cum;
    }
}
__device__ __forceinline__ void gla_stage2(Frame& F) {
    const float* SEND = WSP(float, WS_SEND); const float* GSUM = WSP(float, WS_GSUM); bf16* SINIT = WSP(bf16, WS_SINIT);
    for (int gid = F.vcu * NTHR + F.tid; gid < NB * GLA_H * 8192; gid += F.G * NTHR) {
        const int bh = gid >> 13, e4 = gid & 8191, d4 = (e4 & 31) * 4; const size_t eo = (size_t)(e4 >> 5) * 128 + d4;
        f32x4 S = {0.f, 0.f, 0.f, 0.f};
        for (int run = 0; run < GLA_NRUN; ++run) { const int u = bh * GLA_NRUN + run;
            *(u32x2*)(SINIT + (size_t)u * 32768 + eo) = (u32x2){pk2(S.x, S.y), pk2(S.z, S.w)};
            const f32x4 g = *(const f32x4*)(GSUM + u * 128 + d4), e = *(const f32x4*)(SEND + (size_t)u * 32768 + eo);
            S.x = S.x * __expf(g.x) + e.x; S.y = S.y * __expf(g.y) + e.y; S.z = S.z * __expf(g.z) + e.z; S.w = S.w * __expf(g.w) + e.w; }
    }
}
constexpr int G3_SL = 0, G3_QD = 69632, G3_OT = 87040, OTROW = 260;
__device__ __forceinline__ void gla_stage3(Frame& F) {
    const float* norm_w = (const float*)F.in[5];
    const bf16* QKVR = WSP(bf16, WS_QKVR); const float* OLOC = WSP(float, WS_OLOC); const bf16* QDEC = WSP(bf16, WS_QDEC); const bf16* SINIT = WSP(bf16, WS_SINIT); bf16* OG = WSP(bf16, WS_OG);
    LAS unsigned char* L = F.lds;
    const int tid = F.tid, lane = F.lane, w = F.wave, r = lane & 31, hh = lane >> 5;
    const int nrow = tid >> 3, part = tid & 7;
    for (int u = blockIdx.x; u < GLA_UNITS; u += F.G) {
        const int b = u >> 6, h = (u >> 4) & 3, run = u & 15; const size_t t0 = (size_t)b * SEQ + (size_t)run * (GLA_C * GLA_RUN);
        __syncthreads();
#pragma unroll
        for (int q = 0; q < 8; ++q) { const int idx = tid + NTHR * q, row = idx >> 4, ch = idx & 15;
            *(LAS v4u*)(L + G3_SL + row * QROW + ch * 16) = *(const v4u*)(SINIT + (size_t)u * 32768 + row * 128 + ch * 8); }
        f32x4 nw[8];
#pragma unroll
        for (int q = 0; q < 8; ++q) nw[q] = *(const f32x4*)(norm_w + part * 32 + 4 * q);
        for (int c = 0; c < GLA_RUN; ++c) {
            const size_t r0 = t0 + (size_t)c * GLA_C;
#pragma unroll
            for (int q = 0; q < 2; ++q) { const int idx = tid + NTHR * q, row = idx >> 4, ch = idx & 15;
                *(LAS v4u*)(L + G3_QD + row * QROW + ch * 16) = *(const v4u*)(QDEC + (r0 + row) * 512 + h * 128 + ch * 8); }
            __syncthreads();
            f32x16 o0 = f32x16{}, o1 = f32x16{};
#pragma unroll
            for (int s = 0; s < 8; ++s) { const int ko = (16 * s + 8 * hh) * 2;
                const bf16x8 bS = *(const LAS bf16x8*)(L + G3_SL + (32 * w + r) * QROW + ko);
                o0 = MFMA32(*(const LAS bf16x8*)(L + G3_QD + r * QROW + ko), bS, o0); o1 = MFMA32(*(const LAS bf16x8*)(L + G3_QD + (32 + r) * QROW + ko), bS, o1); }
            {   const float* op = OLOC + (r0 + 4 * hh) * D + h * 256 + 32 * w + r; LAS float* ot = (LAS float*)(L + G3_OT) + (4 * hh) * OTROW + 32 * w + r;
#pragma unroll
                for (int q = 0; q < 16; ++q) { const int rr = (q & 3) + 8 * (q >> 2); ot[rr * OTROW] = o0[q] + op[(size_t)rr * D]; ot[(32 + rr) * OTROW] = o1[q] + op[(size_t)(32 + rr) * D]; } }
            __syncthreads();
            {   const LAS f32x4* orow = (const LAS f32x4*)((LAS float*)(L + G3_OT) + nrow * OTROW + part * 32);
                f32x4 x[8]; float ss = 0.f;
#pragma unroll
                for (int q = 0; q < 8; ++q) { x[q] = orow[q]; ss += (x[q].x * x[q].x + x[q].y * x[q].y) + (x[q].z * x[q].z + x[q].w * x[q].w); }
                ss += __shfl_xor(ss, 1); ss += __shfl_xor(ss, 2); ss += __shfl_xor(ss, 4);
                const float rstd = 1.0f / sqrtf(ss * (1.0f / 256.0f) + RMS_EPS);
                const v4u* rp = (const v4u*)(QKVR + (r0 + nrow) * NQKVR + 2048 + h * 256 + part * 32); v4u* gp = (v4u*)(OG + (r0 + nrow) * D + h * 256 + part * 32);
#pragma unroll
                for (int q = 0; q < 4; ++q) { const v4u rv = rp[q]; float rg[8] = {bf_lo(rv.x), bf_hi(rv.x), bf_lo(rv.y), bf_hi(rv.y), bf_lo(rv.z), bf_hi(rv.z), bf_lo(rv.w), bf_hi(rv.w)}; float ov[8];
#pragma unroll
                    for (int e = 0; e < 8; ++e) { const float xv = x[2 * q + (e >> 2)][e & 3], nv = nw[2 * q + (e >> 2)][e & 3]; ov[e] = xv * rstd * nv * (rg[e] * __builtin_amdgcn_rcpf(1.0f + __expf(-rg[e]))); }
                    gp[q] = (v4u){pk2(ov[0], ov[1]), pk2(ov[2], ov[3]), pk2(ov[4], ov[5]), pk2(ov[6], ov[7])}; }
            }
            __syncthreads();
        }
    }
}

constexpr int WL_STRIDE = 36;
__device__ __forceinline__ void moe_router(Frame& F, int layer) {
    const float* Y = WSP(float, WS_Y); float* X1 = WSP(float, WS_X1); bf16* X1B = WSP(bf16, WS_X1B);
    const float* lg = (const float*)F.in[12] + layer * D; const float* lb = (const float*)F.in[13] + layer * D;
    const float* Wr = (const float*)F.in[16] + (size_t)layer * D * NE; const float* br = (const float*)F.in[17] + layer * NE;
    int* TOPI = WSP(int, WS_TOPI); float* TOPG = WSP(float, WS_TOPG); int* LRANK = WSP(int, WS_LRANK); int* CNT = WSP(int, WS_CNT);
    LAS float* Wl = (LAS float*)F.lds; LAS int* lcnt = (LAS int*)(F.lds + 147456);
    const int lane = F.lane;
    for (int idx = F.tid; idx < D * NE; idx += NTHR) { const int k = idx >> 5, e = idx & 31, l = (k & 255) >> 2, jc = (k >> 8) * 4 + (k & 3); Wl[(jc * 64 + l) * WL_STRIDE + e] = Wr[idx]; }
    if (F.tid < NE) lcnt[F.tid] = 0;
    __syncthreads();
    const int TPW = (T + F.G - 1) / F.G, wg = blockIdx.x;
    const float brl = br[lane >> 1];
    for (int tl = F.wave; tl < TPW; tl += NWAVES) {
        const int m = wg * TPW + tl; if (m >= T) break;
        asm volatile("" ::: "memory");
        const GAS f32x4* yr = (const GAS f32x4*)(Y + (size_t)m * D) + lane;
        f32x4 v[4]; float s = 0.f;
#pragma unroll
        for (int j = 0; j < 4; ++j) { v[j] = yr[64 * j]; s += (v[j].x + v[j].y) + (v[j].z + v[j].w); }
        const float mean = wave_sum(s) * (1.f / D); float s2 = 0.f;
#pragma unroll
        for (int j = 0; j < 4; ++j) { v[j] = v[j] - mean; s2 += (v[j].x * v[j].x + v[j].y * v[j].y) + (v[j].z * v[j].z + v[j].w * v[j].w); }
        const float rstd = 1.f / sqrtf(wave_sum(s2) * (1.f / D) + LN_EPS);
        GAS f32x4* xo = (GAS f32x4*)(X1 + (size_t)m * D) + lane; GAS unsigned long long* o8 = (GAS unsigned long long*)(X1B + (size_t)m * D) + lane;
#pragma unroll
        for (int j = 0; j < 4; ++j) { v[j] = v[j] * rstd * *((const f32x4*)lg + lane + 64 * j) + *((const f32x4*)lb + lane + 64 * j); xo[64 * j] = v[j]; o8[64 * j] = (unsigned long long)pk2(v[j].x, v[j].y) | ((unsigned long long)pk2(v[j].z, v[j].w) << 32); }
        float p[32];
#pragma unroll
        for (int e = 0; e < 32; ++e) p[e] = 0.f;
#pragma unroll
        for (int j = 0; j < 4; ++j)
#pragma unroll
            for (int cc = 0; cc < 4; ++cc) { const float xv = v[j][cc]; const LAS f32x4* wp = (const LAS f32x4*)(Wl + ((j * 4 + cc) * 64 + lane) * WL_STRIDE);
#pragma unroll
                for (int q = 0; q < 8; ++q) { const f32x4 w = wp[q]; p[4 * q] += xv * w.x; p[4 * q + 1] += xv * w.y; p[4 * q + 2] += xv * w.z; p[4 * q + 3] += xv * w.w; } }
        float val = treduce<32>(p, lane) + brl;
        const int e = lane >> 1;
        float sv[4]; int si[4];
#pragma unroll
        for (int k = 0; k < 4; ++k) { const float mx = wave_max(val); const int ix = wave_min_i(val == mx ? e : 64); sv[k] = mx; si[k] = ix; if (e == ix) val = -INFINITY; }
        float ex[4], den = 0.f;
#pragma unroll
        for (int k = 0; k < 4; ++k) { ex[k] = __expf(sv[k] - sv[0]); den += ex[k]; }
        if (lane == 0) {
#pragma unroll
            for (int k = 0; k < 4; ++k) { const int rk = __hip_atomic_fetch_add(&lcnt[si[k]], 1, __ATOMIC_RELAXED, __HIP_MEMORY_SCOPE_WORKGROUP); TOPI[m * 4 + k] = si[k]; TOPG[m * 4 + k] = ex[k] / den; LRANK[m * 4 + k] = rk; }
        }
    }
    __syncthreads();
    if (F.tid < NE) CNT[wg * NE + F.tid] = lcnt[F.tid];
}
__device__ __forceinline__ void moe_scatter(Frame& F) {
    const int* TOPI = WSP(int, WS_TOPI); const int* LRANK = WSP(int, WS_LRANK); const int* CNT = WSP(int, WS_CNT); int* SLOT = WSP(int, WS_SLOT); int* PEXP = WSP(int, WS_PEXP);
    const bf16* X1B = WSP(bf16, WS_X1B); bf16* XG = WSP(bf16, WS_XG);
    LAS int* red = (LAS int*)F.lds;
    LAS int* basev = red + 1024; LAS int* slots = red + 2048;
    const int wg = blockIdx.x, G = F.G, TPW = (T + G - 1) / G;
    {   const int e = F.tid & 31, part = F.tid >> 5, per = (G + 15) / 16; int tot = 0, pre = 0;
        for (int w2 = part * per; w2 < (part + 1) * per && w2 < G; ++w2) { const int c = CNT[w2 * NE + e]; tot += c; if (w2 < wg) pre += c; }
        red[part * 32 + e] = tot; red[512 + part * 32 + e] = pre; }
    __syncthreads();
    if (F.tid < NE) { int tot = 0, pre = 0;
        for (int p = 0; p < 16; ++p) { tot += red[p * 32 + F.tid]; pre += red[512 + p * 32 + F.tid]; }
        red[F.tid] = (tot + 255) & ~255; red[512 + F.tid] = pre; }
    __syncthreads();
    if (F.tid < NE) { int ps = 0; for (int e2 = 0; e2 < F.tid; ++e2) ps += red[e2]; basev[F.tid] = ps + red[512 + F.tid];
        if (wg == 0) { const int p0 = ps >> 8, p1 = (ps + red[F.tid]) >> 8; for (int p = p0; p < p1; ++p) PEXP[16 + p] = F.tid; if (F.tid == NE - 1) PEXP[0] = p1; } }
    __syncthreads();
    for (int a = F.tid; a < TPW * 4; a += NTHR) { const int m = wg * TPW + (a >> 2); if (m < T) { const int sl = basev[TOPI[m * 4 + (a & 3)]] + LRANK[m * 4 + (a & 3)]; slots[a] = sl; SLOT[m * 4 + (a & 3)] = sl; } }
    __syncthreads();
    for (int tl = F.wave; tl < TPW; tl += NWAVES) { const int m = wg * TPW + tl; if (m >= T) break;
        const GAS v4u* src = (const GAS v4u*)(X1B + (size_t)m * D) + F.lane; const v4u a = src[0], b = src[64];
#pragma unroll
        for (int k = 0; k < 4; ++k) { GAS v4u* dst = (GAS v4u*)(XG + (size_t)slots[tl * 4 + k] * D) + F.lane; dst[0] = a; dst[64] = b; } }
}
__device__ __forceinline__ void moe_combine(Frame& F, int layer, float* OUT, bf16* OB) {
    const float* X1 = WSP(float, WS_X1); const bf16* YB = WSP(bf16, WS_YB); const int* SLOT = WSP(int, WS_SLOT); const float* TOPG = WSP(float, WS_TOPG);
    const float* lg = (const float*)F.in[14] + layer * D; const float* lb = (const float*)F.in[15] + layer * D;
    const int lane = F.lane, gw = F.vcu * NWAVES + F.wave, NGW = F.G * NWAVES;
    f32x4 gv[4], bv[4];
#pragma unroll
    for (int q = 0; q < 4; ++q) { const int col = (q >> 1) * 512 + 8 * lane + (q & 1) * 4; gv[q] = *(const f32x4*)(lg + col); bv[q] = *(const f32x4*)(lb + col); }
    for (int m = gw; m < T; m += NGW) {
        f32x4 v[4];
#pragma unroll
        for (int q = 0; q < 4; ++q) { const int col = (q >> 1) * 512 + 8 * lane + (q & 1) * 4; v[q] = *(const f32x4*)(X1 + (size_t)m * D + col) * DN_ALPHA; }
#pragma unroll
        for (int k = 0; k < 4; ++k) { const int sl = SLOT[m * 4 + k]; const float g = TOPG[m * 4 + k];
            const GAS v4u* yp = (const GAS v4u*)(YB + (size_t)sl * D) + lane; const v4u a = yp[0], b = yp[64];
            v[0] += (f32x4){bf_lo(a.x), bf_hi(a.x), bf_lo(a.y), bf_hi(a.y)} * g; v[1] += (f32x4){bf_lo(a.z), bf_hi(a.z), bf_lo(a.w), bf_hi(a.w)} * g;
            v[2] += (f32x4){bf_lo(b.x), bf_hi(b.x), bf_lo(b.y), bf_hi(b.y)} * g; v[3] += (f32x4){bf_lo(b.z), bf_hi(b.z), bf_lo(b.w), bf_hi(b.w)} * g; }
        float s = 0.f;
#pragma unroll
        for (int q = 0; q < 4; ++q) s += (v[q].x + v[q].y) + (v[q].z + v[q].w);
        const float mean = wave_sum(s) * (1.f / D); float s2 = 0.f;
#pragma unroll
        for (int q = 0; q < 4; ++q) { v[q] = v[q] - mean; s2 += (v[q].x * v[q].x + v[q].y * v[q].y) + (v[q].z * v[q].z + v[q].w * v[q].w); }
        const float rstd = 1.f / sqrtf(wave_sum(s2) * (1.f / D) + LN_EPS);
#pragma unroll
        for (int q = 0; q < 4; ++q) { const int col = (q >> 1) * 512 + 8 * lane + (q & 1) * 4; v[q] = v[q] * rstd * gv[q] + bv[q]; *(f32x4*)(OUT + (size_t)m * D + col) = v[q]; }
        if (OB) { GAS v4u* ob = (GAS v4u*)(OB + (size_t)m * D) + lane;
            ob[0] = (v4u){pk2(v[0].x, v[0].y), pk2(v[0].z, v[0].w), pk2(v[1].x, v[1].y), pk2(v[1].z, v[1].w)}; ob[64] = (v4u){pk2(v[2].x, v[2].y), pk2(v[2].z, v[2].w), pk2(v[3].x, v[3].y), pk2(v[3].z, v[3].w)}; }
    }
}
__device__ __forceinline__ void diff_subln(Frame& F) {
    const bf16* O0 = WSP(bf16, WS_O0); const bf16* O1 = WSP(bf16, WS_O1); bf16* OB = WSP(bf16, WS_OB);
    const float* lam = (const float*)F.in[9]; const float* sw = (const float*)F.in[10];
    const int lane = F.lane, gw = F.vcu * NWAVES + F.wave, NGW = F.G * NWAVES;
    const float l1 = wave_sum(lam[lane] * lam[64 + lane]), l2 = wave_sum(lam[128 + lane] * lam[192 + lane]);
    const float lam_full = expf(l1) - expf(l2) + LAMBDA_INIT;
    f32x4 wv[2];
#pragma unroll
    for (int q = 0; q < 2; ++q) wv[q] = *(const f32x4*)(sw + ((8 * lane) & 127) + 4 * q) * (1.0f - LAMBDA_INIT);
    for (int m = gw; m < T; m += NGW) {
        const GAS v4u* p0 = (const GAS v4u*)(O0 + (size_t)m * D) + lane; const GAS v4u* p1 = (const GAS v4u*)(O1 + (size_t)m * D) + lane; GAS v4u* po = (GAS v4u*)(OB + (size_t)m * D) + lane;
#pragma unroll
        for (int hf = 0; hf < 2; ++hf) { const v4u a = p0[64 * hf], b = p1[64 * hf];
            float o[8] = {bf_lo(a.x) - lam_full * bf_lo(b.x), bf_hi(a.x) - lam_full * bf_hi(b.x), bf_lo(a.y) - lam_full * bf_lo(b.y), bf_hi(a.y) - lam_full * bf_hi(b.y),
                          bf_lo(a.z) - lam_full * bf_lo(b.z), bf_hi(a.z) - lam_full * bf_hi(b.z), bf_lo(a.w) - lam_full * bf_lo(b.w), bf_hi(a.w) - lam_full * bf_hi(b.w)};
            float ss = 0.f;
#pragma unroll
            for (int e = 0; e < 8; ++e) ss += o[e] * o[e];
            ss += __shfl_xor(ss, 1); ss += __shfl_xor(ss, 2); ss += __shfl_xor(ss, 4); ss += __shfl_xor(ss, 8);
            const float rstd = 1.0f / sqrtf(ss * (1.0f / 128.0f) + RMS_EPS);
            po[64 * hf] = (v4u){pk2(o[0] * rstd * wv[0].x, o[1] * rstd * wv[0].y), pk2(o[2] * rstd * wv[0].z, o[3] * rstd * wv[0].w), pk2(o[4] * rstd * wv[1].x, o[5] * rstd * wv[1].y), pk2(o[6] * rstd * wv[1].z, o[7] * rstd * wv[1].w)}; }
    }
}

struct Args { const void* in[22]; float* out; unsigned char* ws; int ph_lo, ph_hi; };
__global__ void __launch_bounds__(NTHR, 2) yoco_fwd(Args args) {
    extern __shared__ __attribute__((aligned(16))) unsigned char lds[];
    Frame F;
    F.lds = (LAS unsigned char*)lds;
    F.MISC = (volatile LAS unsigned*)(F.lds + MISC_OFF);
    F.tid = threadIdx.x; F.lane = F.tid & 63; F.wave = __builtin_amdgcn_readfirstlane(F.tid >> 6);
    F.G = gridDim.x; { const int bx = blockIdx.x; F.vcu = (F.G % 8 == 0) ? (bx % 8) * (F.G / 8) + bx / 8 : bx; }
    F.ws = args.ws; F.ctl = (gu32*)(args.ws + WS_CTL); F.in = args.in; F.out = args.out;
    for (int u = F.tid; u < (LDS_BYTES - MISC_OFF) / 4; u += NTHR) ((LAS unsigned*)(F.lds + MISC_OFF))[u] = 0u;
    __syncthreads();
    XcdBarrier bar; bar.bar = (unsigned*)(F.ctl + CW_BAR); bar.x = 0; bar.st = nullptr;
    if (N_LAUNCHES == 1) bar = xcd_barrier_post((unsigned*)(F.ctl + CW_BAR), F.MISC + 8);
    const int lo = args.ph_lo, hi = args.ph_hi;
#ifndef DBG_MASK
#define DBG_MASK 0xFFFFFu
#endif
#define IN(k) (lo <= (k) && (k) < hi && ((DBG_MASK >> (k)) & 1u))
#define SEAM(k) do { if (IN(k) && IN((k) + 1)) xcd_barrier(bar); } while (0)
    LAS unsigned char* ring = F.lds;

    if (IN(0)) { p0_prologue(F); } SEAM(0);
    if (IN(1)) { pg8::Gemm g{WSP(bf16, WS_XB), WSP(bf16, WS_WIN), T, NQKVR, D}; pg8::StaticOrder S; S.init(T, NQKVR, F.G, (int)blockIdx.x);
        pg8::EpiStore E{WSP(bf16, WS_QKVR), NQKVR};
        pg8::gemm_phase<pg8::EpiStore, pg8::StaticOrder, true, true>(ring, g, S, E); } SEAM(1);
    if (IN(2)) { gla_stage1(F); } SEAM(2);
    if (IN(3)) { gla_stage2(F); } SEAM(3);
    if (IN(4)) { gla_stage3(F); } SEAM(4);
    if (IN(5)) { pg8::Gemm g{WSP(bf16, WS_OG), WSP(bf16, WS_WAO), T, D, D}; pg8::StaticOrder S; S.init(T, D, F.G, (int)blockIdx.x);
        pg8::EpiResF32 E{(const float*)F.in[0], WSP(float, WS_Y), D, DN_ALPHA};
        pg8::gemm_phase<pg8::EpiResF32, pg8::StaticOrder, true, true>(ring, g, S, E); } SEAM(5);
    if (IN(6)) { moe_router(F, 0); } SEAM(6);
    if (IN(7)) { moe_scatter(F); } SEAM(7);
    if (IN(8)) { const int* pexp = WSP(int, WS_PEXP); const int npan = __hip_atomic_load(pexp, __ATOMIC_RELAXED, __HIP_MEMORY_SCOPE_AGENT);
        pg8::Gemm g{WSP(bf16, WS_XG), WSP(bf16, WS_WGU), NPAD_MAX, 2048, D}; pg8::MoeOrder S{pexp + 16, npan, 8, F.G, (int)blockIdx.x};
        pg8::EpiSwiglu E{(const float*)F.in[19], WSP(bf16, WS_ACT)};
        pg8::gemm_phase<pg8::EpiSwiglu, pg8::MoeOrder, true, true>(ring, g, S, E); } SEAM(8);
    if (IN(9)) { const int* pexp = WSP(int, WS_PEXP); const int npan = __hip_atomic_load(pexp, __ATOMIC_RELAXED, __HIP_MEMORY_SCOPE_AGENT);
        pg8::Gemm g{WSP(bf16, WS_ACT), WSP(bf16, WS_WD), NPAD_MAX, D, D}; pg8::MoeOrder S{pexp + 16, npan, 4, F.G, (int)blockIdx.x};
        pg8::EpiDown E{(const float*)F.in[21], WSP(bf16, WS_YB)};
        pg8::gemm_phase<pg8::EpiDown, pg8::MoeOrder, true, true>(ring, g, S, E); } SEAM(9);
    if (IN(10)) { moe_combine(F, 0, WSP(float, WS_X2), WSP(bf16, WS_X2B)); } SEAM(10);
    if (IN(11)) { pg8::Gemm g{WSP(bf16, WS_X2B), WSP(bf16, WS_WKVQ), T, 3072, D}; pg8::StaticOrder S; S.init(T, 3072, F.G, (int)blockIdx.x);
        pg8::EpiRope E{WSP(bf16, WS_KB), (size_t)(WS_VB - WS_KB) / 2, WSP(float, WS_COS), WSP(float, WS_SIN), attn_body::C2};
        static_assert(WS_QB - WS_VB == WS_VB - WS_KB, "K | V | Q equally spaced");
        pg8::gemm_phase<pg8::EpiRope, pg8::StaticOrder, true, true>(ring, g, S, E); } SEAM(11);
    if (IN(12)) { const attn_body::DiffTensors AT{(const attn_body::bf16*)WSP(bf16, WS_QB), (const attn_body::bf16*)WSP(bf16, WS_KB), (const attn_body::bf16*)WSP(bf16, WS_VB), (attn_body::bf16*)WSP(bf16, WS_O0), (attn_body::bf16*)WSP(bf16, WS_O1)};
        attn_body::diff_attn_phase<8>((char*)lds, AT, F.vcu, F.G); } SEAM(12);
    if (IN(13)) { diff_subln(F); } SEAM(13);
    if (IN(14)) { pg8::Gemm g{WSP(bf16, WS_OB), WSP(bf16, WS_WBO), T, D, D}; pg8::StaticOrder S; S.init(T, D, F.G, (int)blockIdx.x);
        pg8::EpiResF32 E{WSP(float, WS_X2), WSP(float, WS_Y), D, DN_ALPHA};
        pg8::gemm_phase<pg8::EpiResF32, pg8::StaticOrder, true, true>(ring, g, S, E); } SEAM(14);
    if (IN(15)) { moe_router(F, 1); } SEAM(15);
    if (IN(16)) { moe_scatter(F); } SEAM(16);
    if (IN(17)) { const int* pexp = WSP(int, WS_PEXP); const int npan = __hip_atomic_load(pexp, __ATOMIC_RELAXED, __HIP_MEMORY_SCOPE_AGENT);
        pg8::Gemm g{WSP(bf16, WS_XG), WSP(bf16, WS_WGU) + (size_t)NE * 2048 * 1024, NPAD_MAX, 2048, D}; pg8::MoeOrder S{pexp + 16, npan, 8, F.G, (int)blockIdx.x};
        pg8::EpiSwiglu E{(const float*)F.in[19] + NE * 2048, WSP(bf16, WS_ACT)};
        pg8::gemm_phase<pg8::EpiSwiglu, pg8::MoeOrder, true, true>(ring, g, S, E); } SEAM(17);
    if (IN(18)) { const int* pexp = WSP(int, WS_PEXP); const int npan = __hip_atomic_load(pexp, __ATOMIC_RELAXED, __HIP_MEMORY_SCOPE_AGENT);
        pg8::Gemm g{WSP(bf16, WS_ACT), WSP(bf16, WS_WD) + (size_t)NE * 1024 * 1024, NPAD_MAX, D, D}; pg8::MoeOrder S{pexp + 16, npan, 4, F.G, (int)blockIdx.x};
        pg8::EpiDown E{(const float*)F.in[21] + NE * 1024, WSP(bf16, WS_YB)};
        pg8::gemm_phase<pg8::EpiDown, pg8::MoeOrder, true, true>(ring, g, S, E); } SEAM(18);
    if (IN(19)) { moe_combine(F, 1, F.out, (bf16*)nullptr); }
#undef IN
#undef SEAM
}

extern "C" void kernel_launch(void* const* d_in, const int* in_sizes, int n_in, void* d_out, int out_size, void* d_ws, size_t ws_size, hipStream_t stream) {
    static int grid = 0;
    if (grid == 0) {
        if (n_in != 22 || in_sizes[0] != T * D || out_size != T * D || ws_size < WS_END) { fprintf(stderr, "kernel_launch: unexpected problem (n_in %d, in0 %d, out %d, ws %zu); nothing launched\n", n_in, n_in > 0 ? in_sizes[0] : -1, out_size, ws_size); grid = -1; return; }
        int dev = 0, cus = 0, per_cu = 0;
        if (hipGetDevice(&dev) != hipSuccess || hipDeviceGetAttribute(&cus, hipDeviceAttributeMultiprocessorCount, dev) != hipSuccess) { grid = -1; return; }
        if (hipFuncSetAttribute((const void*)yoco_fwd, hipFuncAttributeMaxDynamicSharedMemorySize, LDS_BYTES) != hipSuccess) { fprintf(stderr, "kernel_launch: hipFuncSetAttribute failed\n"); grid = -1; return; }
        if (hipOccupancyMaxActiveBlocksPerMultiprocessor(&per_cu, (const void*)yoco_fwd, NTHR, LDS_BYTES) != hipSuccess || per_cu < 1) fprintf(stderr, "kernel_launch: note: occupancy query reports %d workgroups per CU\n", per_cu);
        (void)hipGetLastError();
        grid = cus < 256 ? (cus & ~7) : 256;
        if (grid < 8) grid = 8;
    }
    if (grid < 0) return;
    if (hipMemsetAsync((char*)d_ws + WS_CTL, 0, CTL_ZERO_BYTES, stream) != hipSuccess) return;
    Args a{};
    for (int i = 0; i < 22; ++i) a.in[i] = d_in[i];
    a.out = (float*)d_out; a.ws = (unsigned char*)d_ws;
    for (int li = 0; li < N_LAUNCHES; ++li) {
        a.ph_lo = (N_LAUNCHES == 1) ? 0 : li; a.ph_hi = (N_LAUNCHES == 1) ? NPHASE : li + 1;
        hipLaunchKernelGGL(yoco_fwd, dim3(grid), dim3(NTHR), LDS_BYTES, stream, a);
        if (hipPeekAtLastError() != hipSuccess) { fprintf(stderr, "kernel_launch: launch %d failed\n", li); break; }
    }
}
```

```cpp
#include <hip/hip_runtime.h>
#include <hip/hip_bf16.h>
#include <cstdio>
#include <cstdint>
#include <cmath>
#include <type_traits>
__device__ __forceinline__ unsigned pack4_i8(float a, float b, float c, float d) {
    unsigned p = 0u;
    p = __builtin_amdgcn_cvt_pk_u8_f32(__builtin_rintf(a) + 128.0f, 0, p); p = __builtin_amdgcn_cvt_pk_u8_f32(__builtin_rintf(b) + 128.0f, 1, p);
    p = __builtin_amdgcn_cvt_pk_u8_f32(__builtin_rintf(c) + 128.0f, 2, p); p = __builtin_amdgcn_cvt_pk_u8_f32(__builtin_rintf(d) + 128.0f, 3, p);
    return p ^ 0x80808080u;
}
namespace pg8 {
#define PG8_LAS __attribute__((address_space(3)))
typedef unsigned short bf16_t;
typedef short bf16x8 __attribute__((ext_vector_type(8)));
typedef float f32x4 __attribute__((ext_vector_type(4)));
typedef unsigned u32x4 __attribute__((ext_vector_type(4)));
typedef int i32x4 __attribute__((ext_vector_type(4)));
constexpr int BM = 256, BK = 64, HALF = 128, HTB = HALF * BK * 2  , STAGE_BYTES = 8 * HTB, NXCD = 8, WGM = 8;

__host__ __device__ __forceinline__ int lds_byte(int r, int c) { const int st = (r >> 4) * 2 + (c >> 5), rr = r & 15, cc = c & 31, ob = rr * 64 + cc * 2; return st * 1024 + (ob ^ (((ob >> 9) & 1) << 5)); }
__host__ __device__ __forceinline__ void stage_rc(int b, int& R, int& C) { const int st = b / 1024, sb = b % 1024, swz = sb ^ (((sb >> 9) & 1) << 5); R = (st >> 1) * 16 + swz / 64; C = (st & 1) * 32 + (swz % 64) / 2; }
__host__ __device__ __forceinline__ int perm32(int rho) { const int n = rho >> 4, i = rho & 15; return 8 * (i >> 2) + 4 * n + (i & 3); }

struct Unit { int pm, pn, pb; };
struct Gemm { const bf16_t* A; const bf16_t* Bt; int M, N, K; };

struct StaticOrder {
    int nM, nN, nwg, G, c;
    __host__ __device__ void init(int M, int N, int G_, int c_) { nM = M / BM; nN = N / BM; nwg = nM * nN; G = G_; c = c_; }
    __host__ __device__ bool next(int i, Unit& u) const {
        const long L = (long)i * G + c; if (L >= nwg) return false;
        int wgid = (int)L; { const int q = nwg / NXCD, r = nwg % NXCD, xcd = wgid % NXCD, off = wgid / NXCD; wgid = (xcd < r ? xcd * (q + 1) : r * (q + 1) + (xcd - r) * q) + off; }
        const int nig = WGM * nN, gid = wgid / nig, fm = gid * WGM, gsz = (nM - fm) < WGM ? (nM - fm) : WGM;
        u.pm = fm + ((wgid % nig) % gsz); u.pn = (wgid % nig) / gsz; u.pb = u.pn; return true;
    }
    __device__ __forceinline__ void a_ready(const Unit&) const {}
    __device__ __forceinline__ void done(const Unit&) const {}
};
constexpr int MOE_MAX_UNITS = 24;
struct MoeOrder {
    const PG8_LAS int* utab;
    __device__ __forceinline__ bool next(int i, Unit& u) const {
        if (i >= MOE_MAX_UNITS) return false;
        const int v = __builtin_amdgcn_readfirstlane(utab[4 * i + 3]); if (!v) return false;
        u.pm = __builtin_amdgcn_readfirstlane(utab[4 * i]); u.pn = __builtin_amdgcn_readfirstlane(utab[4 * i + 1]); u.pb = __builtin_amdgcn_readfirstlane(utab[4 * i + 2]); return true;
    }
    __device__ __forceinline__ void a_ready(const Unit&) const {}
    __device__ __forceinline__ void done(const Unit&) const {}
};

typedef float f32x2v __attribute__((ext_vector_type(2))); typedef unsigned u32x2v __attribute__((ext_vector_type(2))); typedef __bf16 bf16x2v __attribute__((ext_vector_type(2)));
__device__ __forceinline__ unsigned cvt_pk_bf16(float lo, float hi) { f32x2v v = {lo, hi}; bf16x2v b = __builtin_convertvector(v, bf16x2v); return __builtin_bit_cast(unsigned, b); }
__device__ __forceinline__ u32x4 pack8(const f32x4 v0, const f32x4 v1) { u32x4 w; w.x = cvt_pk_bf16(v0[0], v0[1]); w.y = cvt_pk_bf16(v0[2], v0[3]); w.z = cvt_pk_bf16(v1[0], v1[1]); w.w = cvt_pk_bf16(v1[2], v1[3]); return w; }

struct EpiStore {
    static constexpr bool PERM = true, AFTER_DRAIN = false;
    bf16_t* O; int ldc;
    __device__ __forceinline__ void operator()(const f32x4 (&acc)[2][2][4][2], const Unit& u, int wr, int wc, int fr, int fq) const {
        const int row0 = u.pm * BM + wr * 64 + fr, col0 = u.pn * BM + wc * 32 + 8 * fq;
#pragma unroll
        for (int ai = 0; ai < 2; ++ai)
#pragma unroll
            for (int m = 0; m < 4; ++m) { bf16_t* rowp = O + (size_t)(row0 + ai * HALF + m * 16) * ldc + col0;
#pragma unroll
                for (int bj = 0; bj < 2; ++bj) *(u32x4*)(rowp + bj * HALF) = pack8(acc[ai][bj][m][0], acc[ai][bj][m][1]); }
    }
};
struct EpiStoreI8 {
    static constexpr bool PERM = true, AFTER_DRAIN = false;
    bf16_t* O; int ldc; const float* sx; const float* sw;
    __device__ __forceinline__ void operator()(const i32x4 (&acc)[2][2][4][2], const Unit& u, int wr, int wc, int fr, int fq) const {
        const int row0 = u.pm * BM + wr * 64 + fr, col0 = u.pn * BM + wc * 32 + 8 * fq; const float swt = sw[u.pn];
#pragma unroll
        for (int ai = 0; ai < 2; ++ai)
#pragma unroll
            for (int m = 0; m < 4; ++m) { const int row = row0 + ai * HALF + m * 16; bf16_t* rowp = O + (size_t)row * ldc + col0; const float sc = sx[row] * swt;
#pragma unroll
                for (int bj = 0; bj < 2; ++bj) { f32x4 v0, v1;
#pragma unroll
                    for (int j = 0; j < 4; ++j) { v0[j] = (float)acc[ai][bj][m][0][j] * sc; v1[j] = (float)acc[ai][bj][m][1][j] * sc; }
                    *(u32x4*)(rowp + bj * HALF) = pack8(v0, v1); } }
    }
};
template <bool RBF> struct EpiRes {
    static constexpr bool PERM = true, AFTER_DRAIN = false;
    const void* R; bf16_t* Y; int ldc; float alpha;
    __device__ __forceinline__ void operator()(const f32x4 (&acc)[2][2][4][2], const Unit& u, int wr, int wc, int fr, int fq) const {
        const int row0 = u.pm * BM + wr * 64 + fr, col0 = u.pn * BM + wc * 32 + 8 * fq;
#pragma unroll
        for (int ai = 0; ai < 2; ++ai)
#pragma unroll
            for (int m = 0; m < 4; ++m) { const size_t p = (size_t)(row0 + ai * HALF + m * 16) * ldc + col0;
#pragma unroll
                for (int bj = 0; bj < 2; ++bj) { f32x4 r0, r1;
                    if constexpr (RBF) { const u32x4 w = *(const u32x4*)((const bf16_t*)R + p + bj * HALF);
                        r0 = (f32x4){__builtin_bit_cast(float, w.x << 16), __builtin_bit_cast(float, w.x & 0xffff0000u), __builtin_bit_cast(float, w.y << 16), __builtin_bit_cast(float, w.y & 0xffff0000u)};
                        r1 = (f32x4){__builtin_bit_cast(float, w.z << 16), __builtin_bit_cast(float, w.z & 0xffff0000u), __builtin_bit_cast(float, w.w << 16), __builtin_bit_cast(float, w.w & 0xffff0000u)}; }
                    else { r0 = *(const f32x4*)((const float*)R + p + bj * HALF); r1 = *(const f32x4*)((const float*)R + p + bj * HALF + 4); }
                    *(u32x4*)(Y + p + bj * HALF) = pack8(r0 * alpha + acc[ai][bj][m][0], r1 * alpha + acc[ai][bj][m][1]); } }
    }
};
struct EpiResI8 {
    static constexpr bool PERM = true, AFTER_DRAIN = false;
    const bf16_t* R; bf16_t* Y; int ldc; float alpha; float sa; const float* sw;
    __device__ __forceinline__ void operator()(const i32x4 (&acc)[2][2][4][2], const Unit& u, int wr, int wc, int fr, int fq) const {
        const int row0 = u.pm * BM + wr * 64 + fr, col0 = u.pn * BM + wc * 32 + 8 * fq; const float sc = sa * sw[u.pn];
#pragma unroll
        for (int ai = 0; ai < 2; ++ai)
#pragma unroll
            for (int m = 0; m < 4; ++m) { const size_t p = (size_t)(row0 + ai * HALF + m * 16) * ldc + col0;
#pragma unroll
                for (int bj = 0; bj < 2; ++bj) { const u32x4 w = *(const u32x4*)(R + p + bj * HALF);
                    const f32x4 r0 = (f32x4){__builtin_bit_cast(float, w.x << 16), __builtin_bit_cast(float, w.x & 0xffff0000u), __builtin_bit_cast(float, w.y << 16), __builtin_bit_cast(float, w.y & 0xffff0000u)};
                    const f32x4 r1 = (f32x4){__builtin_bit_cast(float, w.z << 16), __builtin_bit_cast(float, w.z & 0xffff0000u), __builtin_bit_cast(float, w.w << 16), __builtin_bit_cast(float, w.w & 0xffff0000u)};
                    f32x4 v0, v1;
#pragma unroll
                    for (int j = 0; j < 4; ++j) { v0[j] = (float)acc[ai][bj][m][0][j] * sc; v1[j] = (float)acc[ai][bj][m][1][j] * sc; }
                    *(u32x4*)(Y + p + bj * HALF) = pack8(r0 * alpha + v0, r1 * alpha + v1); } }
    }
};
struct EpiSwiglu {
    static constexpr bool PERM = true, AFTER_DRAIN = false;
    const float* bgu; bf16_t* O;
    __device__ __forceinline__ void operator()(const f32x4 (&acc)[2][2][4][2], const Unit& u, int wr, int wc, int fr, int fq) const {
        const int e = u.pb >> 3, row0 = u.pm * BM + wr * 64 + fr, colh = u.pn * HALF + wc * 32 + 8 * fq;
        const float* bb = bgu + (size_t)e * 2048 + colh;
        f32x4 bg[2], bl[2];
#pragma unroll
        for (int n = 0; n < 2; ++n) { bg[n] = *(const f32x4*)(bb + 4 * n); bl[n] = *(const f32x4*)(bb + 1024 + 4 * n); }
#pragma unroll
        for (int ai = 0; ai < 2; ++ai)
#pragma unroll
            for (int m = 0; m < 4; ++m) { f32x4 a[2];
#pragma unroll
                for (int n = 0; n < 2; ++n) { const f32x4 g = acc[ai][0][m][n] + bg[n], l = acc[ai][1][m][n] + bl[n];
#pragma unroll
                    for (int j = 0; j < 4; ++j) { const float xg = fminf(g[j], 7.0f), xl = fminf(fmaxf(l[j], -7.0f), 7.0f);
                        a[n][j] = xg * __builtin_amdgcn_rcpf(1.0f + __expf(-1.702f * xg)) * (xl + 1.0f); } }
                *(u32x4*)(O + (size_t)(row0 + ai * HALF + m * 16) * 1024 + colh) = pack8(a[0], a[1]); }
    }
};
struct EpiSwigluI8 {
    static constexpr bool PERM = true, AFTER_DRAIN = false;
    const float* bgu; bf16_t* O; const float* sxs; const float* swq; const float* sact;
    __device__ __forceinline__ void operator()(const i32x4 (&acc)[2][2][4][2], const Unit& u, int wr, int wc, int fr, int fq) const {
        const int e = u.pb >> 3, row0 = u.pm * BM + wr * 64 + fr, colh = u.pn * HALF + wc * 32 + 8 * fq;
        const float* bb = bgu + (size_t)e * 2048 + colh; const float sw = swq[e], qa = 1.0f / sact[e];
        f32x4 bg[2], bl[2];
#pragma unroll
        for (int n = 0; n < 2; ++n) { bg[n] = *(const f32x4*)(bb + 4 * n); bl[n] = *(const f32x4*)(bb + 1024 + 4 * n); }
#pragma unroll
        for (int ai = 0; ai < 2; ++ai)
#pragma unroll
            for (int m = 0; m < 4; ++m) { f32x4 a[2]; const int row = row0 + ai * HALF + m * 16; const float sc = sxs[row] * sw;
#pragma unroll
                for (int n = 0; n < 2; ++n) { const i32x4 gi = acc[ai][0][m][n], li = acc[ai][1][m][n];
#pragma unroll
                    for (int j = 0; j < 4; ++j) { const float g = (float)gi[j] * sc + bg[n][j], l = (float)li[j] * sc + bl[n][j];
                        const float xg = fminf(g, 7.0f), xl = fminf(fmaxf(l, -7.0f), 7.0f);
                        a[n][j] = xg * __builtin_amdgcn_rcpf(1.0f + __expf(-1.702f * xg)) * (xl + 1.0f) * qa; } }
                u32x2v w; w.x = pack4_i8(a[0][0], a[0][1], a[0][2], a[0][3]); w.y = pack4_i8(a[1][0], a[1][1], a[1][2], a[1][3]);
                *(u32x2v*)((signed char*)O + (size_t)row * 1024 + colh) = w; }
    }
};
struct EpiDown {
    static constexpr bool PERM = true, AFTER_DRAIN = false;
    const float* bd; bf16_t* O;
    __device__ __forceinline__ void operator()(const f32x4 (&acc)[2][2][4][2], const Unit& u, int wr, int wc, int fr, int fq) const {
        const int e = u.pb >> 2, row0 = u.pm * BM + wr * 64 + fr, col0 = u.pn * BM + wc * 32 + 8 * fq;
        const float* bb = bd + (size_t)e * 1024 + col0;
        f32x4 bv[2][2];
#pragma unroll
        for (int bj = 0; bj < 2; ++bj)
#pragma unroll
            for (int n = 0; n < 2; ++n) bv[bj][n] = *(const f32x4*)(bb + bj * HALF + 4 * n);
#pragma unroll
        for (int ai = 0; ai < 2; ++ai)
#pragma unroll
            for (int m = 0; m < 4; ++m) { bf16_t* rowp = O + (size_t)(row0 + ai * HALF + m * 16) * 1024 + col0;
#pragma unroll
                for (int bj = 0; bj < 2; ++bj) *(u32x4*)(rowp + bj * HALF) = pack8(acc[ai][bj][m][0] + bv[bj][0], acc[ai][bj][m][1] + bv[bj][1]); }
    }
};
struct EpiDownI8 {
    static constexpr bool PERM = true, AFTER_DRAIN = false;
    const float* bd; bf16_t* O; const float* sact; const float* swd;
    __device__ __forceinline__ void operator()(const i32x4 (&acc)[2][2][4][2], const Unit& u, int wr, int wc, int fr, int fq) const {
        const int e = u.pb >> 2, row0 = u.pm * BM + wr * 64 + fr, col0 = u.pn * BM + wc * 32 + 8 * fq;
        const float* bb = bd + (size_t)e * 1024 + col0; const float sc = sact[e] * swd[e];
        f32x4 bv[2][2];
#pragma unroll
        for (int bj = 0; bj < 2; ++bj)
#pragma unroll
            for (int n = 0; n < 2; ++n) bv[bj][n] = *(const f32x4*)(bb + bj * HALF + 4 * n);
#pragma unroll
        for (int ai = 0; ai < 2; ++ai)
#pragma unroll
            for (int m = 0; m < 4; ++m) { unsigned char* rowp = (unsigned char*)O + (size_t)(row0 + ai * HALF + m * 16) * 1024 + col0;
#pragma unroll
                for (int bj = 0; bj < 2; ++bj) { f32x4 v0, v1;
#pragma unroll
                    for (int j = 0; j < 4; ++j) { v0[j] = ((float)acc[ai][bj][m][0][j] * sc + bv[bj][0][j]) * 16.0f; v1[j] = ((float)acc[ai][bj][m][1][j] * sc + bv[bj][1][j]) * 16.0f; }
                    int w0 = __builtin_amdgcn_cvt_pk_fp8_f32(v0[0], v0[1], 0, false); w0 = __builtin_amdgcn_cvt_pk_fp8_f32(v0[2], v0[3], w0, true);
                    int w1 = __builtin_amdgcn_cvt_pk_fp8_f32(v1[0], v1[1], 0, false); w1 = __builtin_amdgcn_cvt_pk_fp8_f32(v1[2], v1[3], w1, true);
                    *(u32x2v*)(rowp + bj * HALF) = (u32x2v){(unsigned)w0, (unsigned)w1}; } }
    }
};
struct EpiRopeI8 {
    static constexpr bool PERM = true, AFTER_DRAIN = false;
    bf16_t* KVQ; size_t kind_stride; const float *cosT, *sinT; float qscale; const float* sx; const float* sw;
    __device__ __forceinline__ void operator()(const i32x4 (&acc)[2][2][4][2], const Unit& u, int wr, int wc, int fr, int fq) const {
        const int kind = u.pn >> 2, pl = u.pn & 3, row0 = u.pm * BM + wr * 64 + fr, col0 = pl * 256 + wc * 64 + 8 * fq;
        bf16_t* base = KVQ + (size_t)kind * kind_stride;
        const float sc = kind == 2 ? qscale : 1.0f, swt = sw[u.pn];
#pragma unroll
        for (int ai = 0; ai < 2; ++ai)
#pragma unroll
            for (int m = 0; m < 4; ++m) { const int row = row0 + ai * HALF + m * 16; const float scq = sx[row] * swt;
                bf16_t* rowp = base + (size_t)row * 1024 + col0;
#pragma unroll
                for (int n = 0; n < 2; ++n) { f32x4 t1, t2, o1, o2;
#pragma unroll
                    for (int j = 0; j < 4; ++j) { t1[j] = (float)acc[ai][0][m][n][j] * scq; t2[j] = (float)acc[ai][1][m][n][j] * scq; }
                    if (kind != 1) { const f32x4 c = *(const f32x4*)(cosT + (size_t)row * 32 + 8 * fq + 4 * n), s = *(const f32x4*)(sinT + (size_t)row * 32 + 8 * fq + 4 * n);
                        o1 = (t1 * c - t2 * s) * sc; o2 = (t2 * c + t1 * s) * sc; }
                    else { o1 = t1; o2 = t2; }
                    u32x2v w1, w2; w1.x = cvt_pk_bf16(o1[0], o1[1]); w1.y = cvt_pk_bf16(o1[2], o1[3]); w2.x = cvt_pk_bf16(o2[0], o2[1]); w2.y = cvt_pk_bf16(o2[2], o2[3]);
                    *(u32x2v*)(rowp + 4 * n) = w1; *(u32x2v*)(rowp + 32 + 4 * n) = w2;
                    asm volatile("" ::: "memory"); } }
    }
};

template <class Epi, class Sched, bool ALIGN_EPI = false, bool SP2 = false, bool GATHER = false, bool I8 = false>
__device__ __forceinline__ void gemm_phase(PG8_LAS unsigned char* lds, const Gemm g, const Sched& S, const Epi& E, const PG8_LAS int* gidx = nullptr) {
    static_assert(!GATHER || SP2, "the gather variant is written for the SP2 loop");
    const int tid = threadIdx.x, wid = __builtin_amdgcn_readfirstlane(tid >> 6), lane = tid & 63, wr = wid >> 2, wc = wid & 3, fr = lane & 15, fq = lane >> 4;
    const int K = g.K, nt = K / BK;
    unsigned voffA[2], voffB[2];
#pragma unroll
    for (int i = 0; i < 2; ++i) { int R, C; stage_rc(tid * 16 + i * 8192, R, C); const int Rb = Epi::PERM ? ((R & ~31) + perm32(R & 31)) : R;
        voffA[i] = (unsigned)(R * K + C) * 2u; voffB[i] = (unsigned)(Rb * K + C) * 2u; }
    unsigned vC[2][2], vN[2][2];
#define PG8_GIDX(dst, uix) do { _Pragma("unroll") for (int _h = 0; _h < 2; ++_h) _Pragma("unroll") for (int _i = 0; _i < 2; ++_i) { int R_, C_; stage_rc(tid * 16 + _i * 8192, R_, C_); \
        dst[_h][_i] = (unsigned)gidx[(uix) * BM + _h * HALF + R_] * (unsigned)(K * 2) + (unsigned)(C_ * 2); } } while (0)
    const size_t kstep = (size_t)(BK * 2);
    const size_t hstep = (size_t)HALF * K * 2;
    const size_t tstep = 2 * hstep;
    const unsigned ldsw = (unsigned)wid * 1024u;
    const int aoff = lds_byte(wr * 64 + fr, fq * 8), boff = lds_byte(wc * 32 + fr, fq * 8);
#define PG8_SA(b, h) (((b) * 2 + (h)) * HTB)
#define PG8_SB(b, h) ((4 + (b) * 2 + (h)) * HTB)
#define PG8_STAGE(bufoff, gbase, voff) do { _Pragma("unroll") for (int _i = 0; _i < 2; ++_i) \
        __builtin_amdgcn_global_load_lds((const unsigned*)((const char*)(gbase) + (voff)[_i]), (PG8_LAS unsigned*)(lds + (bufoff) + ldsw + _i * 8192), 16, 0, 0); } while (0)
#define PG8_STAGE_A(bufoff, gbase, h, vsel) do { if constexpr (GATHER) { PG8_STAGE(bufoff, gbase, (vsel)[h]); } else { PG8_STAGE(bufoff, (gbase) + (h) * hstep, voffA); } } while (0)
#define PG8_LDA(dst, b, h) do { _Pragma("unroll") for (int m = 0; m < 4; ++m) _Pragma("unroll") for (int k = 0; k < 2; ++k) dst[m][k] = *(const PG8_LAS bf16x8*)(lds + PG8_SA(b, h) + aoff + m * 2048 + k * 1024); } while (0)
#define PG8_LDB(dst, b, h) do { _Pragma("unroll") for (int n = 0; n < 2; ++n) _Pragma("unroll") for (int k = 0; k < 2; ++k) dst[n][k] = *(const PG8_LAS bf16x8*)(lds + PG8_SB(b, h) + boff + n * 2048 + k * 1024); } while (0)
#define PG8_MMA(ai, bj, At, Bt) do { __builtin_amdgcn_s_setprio(1); _Pragma("unroll") for (int m = 0; m < 4; ++m) _Pragma("unroll") for (int n = 0; n < 2; ++n) _Pragma("unroll") for (int k = 0; k < 2; ++k) \
        { if constexpr (I8) acc[ai][bj][m][n] = __builtin_bit_cast(acc_t, __builtin_amdgcn_mfma_i32_16x16x64_i8(__builtin_bit_cast(i32x4, Bt[n][k]), __builtin_bit_cast(i32x4, At[m][k]), __builtin_bit_cast(i32x4, acc[ai][bj][m][n]), 0, 0, 0)); \
          else acc[ai][bj][m][n] = __builtin_bit_cast(acc_t, __builtin_amdgcn_mfma_f32_16x16x32_bf16(Bt[n][k], At[m][k], __builtin_bit_cast(f32x4, acc[ai][bj][m][n]), 0, 0, 0)); } __builtin_amdgcn_s_setprio(0); } while (0)
#define PG8_WAIT_V(n) asm volatile("s_waitcnt vmcnt(" #n ")" ::: "memory")
#define PG8_WAIT_L(n) asm volatile("s_waitcnt lgkmcnt(" #n ")" ::: "memory")
#define PG8_BAR __builtin_amdgcn_s_barrier()
#define PG8_SCHED __builtin_amdgcn_sched_barrier(0)
    Unit cur, nxt; int ui = 0;
    if (!S.next(0, cur)) return;
    typedef typename std::conditional<I8, i32x4, f32x4>::type acc_t;
    acc_t acc[2][2][4][2];
#pragma unroll
    for (int a = 0; a < 2; ++a)
#pragma unroll
        for (int b = 0; b < 2; ++b)
#pragma unroll
            for (int m = 0; m < 4; ++m)
#pragma unroll
                for (int n = 0; n < 2; ++n) acc[a][b][m][n] = acc_t{};
    bf16x8 At[4][2], B0[2][2], B1[2][2];
    const char* cA = (const char*)g.A + (GATHER ? (size_t)0 : (size_t)cur.pm * tstep); if constexpr (GATHER) { PG8_GIDX(vC, 0); } const char* cB = (const char*)g.Bt + (size_t)cur.pb * tstep;
    S.a_ready(cur);
    if constexpr (SP2) {
        PG8_STAGE(PG8_SB(0, 0), cB, voffB); PG8_STAGE(PG8_SB(0, 1), cB + hstep, voffB); PG8_STAGE_A(PG8_SA(0, 0), cA, 0, vC); PG8_STAGE_A(PG8_SA(0, 1), cA, 1, vC);
        if (wr == 1) PG8_BAR;
        PG8_WAIT_V(2); PG8_BAR;
        PG8_STAGE(PG8_SB(1, 0), cB + kstep, voffB); PG8_STAGE_A(PG8_SA(1, 0), cA + kstep, 0, vC); PG8_STAGE(PG8_SB(1, 1), cB + hstep + kstep, voffB);
        PG8_WAIT_V(6); PG8_BAR;
    } else {
        PG8_STAGE(PG8_SB(0, 0), cB, voffB); PG8_STAGE(PG8_SA(0, 0), cA, voffA); PG8_STAGE(PG8_SB(0, 1), cB + hstep, voffB); PG8_STAGE(PG8_SA(0, 1), cA + hstep, voffA);
        if (wr == 1) PG8_BAR;
        PG8_WAIT_V(4); PG8_BAR;
        PG8_STAGE(PG8_SB(1, 0), cB + kstep, voffB); PG8_STAGE(PG8_SA(1, 0), cA + kstep, voffA); PG8_STAGE(PG8_SB(1, 1), cB + hstep + kstep, voffB);
        PG8_WAIT_V(6); PG8_BAR;
    }
    for (;;) {
        const bool has_next = S.next(ui + 1, nxt);
        const char* nA = (has_next && !GATHER) ? (const char*)g.A + (size_t)nxt.pm * tstep : cA;
        if constexpr (GATHER) { if (has_next) { PG8_GIDX(vN, ui + 1); } else { _Pragma("unroll") for (int _h = 0; _h < 2; ++_h) _Pragma("unroll") for (int _i = 0; _i < 2; ++_i) vN[_h][_i] = vC[_h][_i]; } } const char* nB = has_next ? (const char*)g.Bt + (size_t)nxt.pb * tstep : cB;
        for (int t = 0; t < nt; t += 2) {
            const bool last = (t == nt - 2);
            const char* a1 = cA + (size_t)(t + 1) * kstep;
            const char* a2 = last ? nA : cA + (size_t)(t + 2) * kstep; const char* b2 = last ? nB : cB + (size_t)(t + 2) * kstep;
            const char* a3 = a2 + kstep; const char* b3 = b2 + kstep;
            if (last && has_next) S.a_ready(nxt);
            unsigned vS[2][2];
            if constexpr (GATHER) { _Pragma("unroll") for (int _h = 0; _h < 2; ++_h) _Pragma("unroll") for (int _i = 0; _i < 2; ++_i) vS[_h][_i] = last ? vN[_h][_i] : vC[_h][_i]; }
            if constexpr (SP2) {
            PG8_LDB(B0, 0, 0); PG8_LDB(B1, 0, 1); PG8_SCHED; PG8_LDA(At, 0, 0); PG8_STAGE_A(PG8_SA(1, 1), a1, 1, vC);
            PG8_WAIT_V(8); PG8_WAIT_L(0); PG8_BAR; PG8_MMA(0, 0, At, B0); PG8_MMA(0, 1, At, B1); PG8_BAR; PG8_SCHED;
            PG8_LDA(At, 0, 1); PG8_STAGE(PG8_SB(0, 0), b2, voffB); PG8_STAGE(PG8_SB(0, 1), b2 + hstep, voffB); PG8_STAGE_A(PG8_SA(0, 0), a2, 0, vS);
            PG8_WAIT_V(8); PG8_WAIT_L(0); PG8_BAR; PG8_MMA(1, 0, At, B0); PG8_MMA(1, 1, At, B1); PG8_BAR; PG8_SCHED;
            PG8_LDB(B0, 1, 0); PG8_LDB(B1, 1, 1); PG8_SCHED; PG8_LDA(At, 1, 0); PG8_STAGE_A(PG8_SA(0, 1), a2, 1, vS);
            PG8_WAIT_V(8); PG8_WAIT_L(0); PG8_BAR; PG8_MMA(0, 0, At, B0); PG8_MMA(0, 1, At, B1); PG8_BAR; PG8_SCHED;
            PG8_LDA(At, 1, 1); PG8_STAGE(PG8_SB(1, 0), b3, voffB); PG8_STAGE(PG8_SB(1, 1), b3 + hstep, voffB); PG8_STAGE_A(PG8_SA(1, 0), a3, 0, vS);
            PG8_WAIT_V(8); PG8_WAIT_L(0); PG8_BAR; PG8_MMA(1, 0, At, B0); PG8_MMA(1, 1, At, B1); PG8_BAR; PG8_SCHED;
            } else {
            PG8_LDB(B0, 0, 0); PG8_SCHED; PG8_LDA(At, 0, 0); PG8_STAGE(PG8_SA(1, 1), a1 + hstep, voffA);
            PG8_WAIT_L(8); PG8_BAR; PG8_WAIT_L(0); PG8_MMA(0, 0, At, B0); PG8_BAR; PG8_SCHED;
            PG8_LDB(B1, 0, 1); PG8_STAGE(PG8_SB(0, 0), b2, voffB);
            PG8_BAR; PG8_WAIT_L(0); PG8_MMA(0, 1, At, B1); PG8_BAR;
            PG8_LDA(At, 0, 1); PG8_STAGE(PG8_SA(0, 0), a2, voffA);
            PG8_BAR; PG8_WAIT_L(0); PG8_MMA(1, 0, At, B0); PG8_BAR; PG8_SCHED;
            PG8_STAGE(PG8_SB(0, 1), b2 + hstep, voffB);
            PG8_WAIT_V(6); PG8_BAR; PG8_MMA(1, 1, At, B1); PG8_BAR;
            PG8_LDB(B0, 1, 0); PG8_SCHED; PG8_LDA(At, 1, 0); PG8_STAGE(PG8_SA(0, 1), a2 + hstep, voffA);
            PG8_WAIT_L(8); PG8_BAR; PG8_WAIT_L(0); PG8_MMA(0, 0, At, B0); PG8_BAR; PG8_SCHED;
            PG8_LDB(B1, 1, 1); PG8_STAGE(PG8_SB(1, 0), b3, voffB);
            PG8_BAR; PG8_WAIT_L(0); PG8_MMA(0, 1, At, B1); PG8_BAR;
            PG8_LDA(At, 1, 1); PG8_STAGE(PG8_SA(1, 0), a3, voffA);
            PG8_BAR; PG8_WAIT_L(0); PG8_MMA(1, 0, At, B0); PG8_BAR; PG8_SCHED;
            PG8_STAGE(PG8_SB(1, 1), b3 + hstep, voffB);
            PG8_WAIT_V(6); PG8_BAR; PG8_MMA(1, 1, At, B1); PG8_BAR;
            }
        }
        if constexpr (ALIGN_EPI) { if (wr == 0) PG8_BAR; }
        if constexpr (!Epi::AFTER_DRAIN) { E(acc, cur, wr, wc, fr, fq); S.done(cur); }
        if (!has_next) break;
#pragma unroll
        for (int a = 0; a < 2; ++a)
#pragma unroll
            for (int b = 0; b < 2; ++b)
#pragma unroll
                for (int m = 0; m < 4; ++m)
#pragma unroll
                    for (int n = 0; n < 2; ++n) acc[a][b][m][n] = acc_t{};
        cur = nxt; cA = nA; cB = nB; ++ui;
        if constexpr (GATHER) { _Pragma("unroll") for (int _h = 0; _h < 2; ++_h) _Pragma("unroll") for (int _i = 0; _i < 2; ++_i) vC[_h][_i] = vN[_h][_i]; }
        if constexpr (ALIGN_EPI) { if (wr == 1) PG8_BAR; }
    }
    PG8_WAIT_V(0);
    if constexpr (!ALIGN_EPI) { if (wr == 0) PG8_BAR; }
    PG8_BAR;
    if constexpr (Epi::AFTER_DRAIN) { E.fused(acc, cur, wr, wc, fr, fq, lds, wid, lane); S.done(cur); }
#undef PG8_SA
#undef PG8_SB
#undef PG8_STAGE
#undef PG8_STAGE_A
#undef PG8_GIDX
#undef PG8_LDA
#undef PG8_LDB
#undef PG8_MMA
#undef PG8_WAIT_V
#undef PG8_WAIT_L
#undef PG8_BAR
#undef PG8_SCHED
}
}
#include <hip/hip_bf16.h>
#include <cmath>
namespace attn_body {
using bf16=__hip_bfloat16;
using bf16x8=__attribute__((ext_vector_type(8)))short;
using s16x4=__attribute__((ext_vector_type(4)))short;
using f32x16=__attribute__((ext_vector_type(16)))float;
using u32x4=__attribute__((ext_vector_type(4)))unsigned;
using u32x2=__attribute__((ext_vector_type(2)))unsigned;
constexpr float OB_QINV=127.0f/4.0f;
constexpr int BATCH=4,NHEAD=16,SEQ=8192,D=64,DM=NHEAD*D;
constexpr int NW=8,QBLK=32,QB=QBLK*NW,KVBLK=64,NQB=SEQ/QB;
constexpr int ATTN_PITCH=DM, ATTN_UNIT_ROWS=QB;
__device__ __forceinline__ int crow(int r,int hi){return (r&3)+8*(r>>2)+4*hi;}
#define SBAR() __builtin_amdgcn_sched_barrier(0)
__device__ __forceinline__ void cmask(f32x16&p0,f32x16&p1,int jb,int qrel,int hi){
  const float NEG=-INFINITY; int kb=64*jb+4*hi;
  #pragma unroll
  for(int r=0;r<16;++r){int kv=kb+(r&3)+8*(r>>2); if(kv>qrel)p0[r]=NEG; if(kv+32>qrel)p1[r]=NEG;}
}

constexpr int NSLOT=3, SLOTB=8192;
constexpr int LDS_K=0, LDS_V=NSLOT*SLOTB, LDS_WS=2*NSLOT*SLOTB, LDS_OST=LDS_WS+NW*64*4, LDS_BYTES=LDS_OST+NW*4096;
constexpr float C2=0.125f*1.4426950408889634f;
__device__ __forceinline__ void glds16(const void*gsrc,unsigned lds_dst){unsigned keep;
  asm volatile("s_mov_b32 %0, m0\n\ts_mov_b32 m0, %2\n\ts_nop 0\n\tglobal_load_lds_dwordx4 %1, off\n\ts_mov_b32 m0, %0":"=&s"(keep):"v"(gsrc),"s"(lds_dst):"memory");}
__device__ __forceinline__ float max3f(float a,float b,float c){float r;asm("v_max3_f32 %0, %1, %2, %3":"=v"(r):"v"(a),"v"(b),"v"(c));return r;}
__device__ __forceinline__ float max2f(float a,float b){float r;asm("v_max_f32_e32 %0, %1, %2":"=v"(r):"v"(a),"v"(b));return r;}
__device__ __forceinline__ float fadd_s(float a,float b){float r;asm("v_add_f32_e32 %0, %1, %2":"=v"(r):"v"(a),"v"(b));return r;}
__device__ __forceinline__ float fsub_s(float a,float b){float r;asm("v_sub_f32_e32 %0, %1, %2":"=v"(r):"v"(a),"v"(b));return r;}
typedef float f32x2_t __attribute__((ext_vector_type(2))); typedef __bf16 bf16x2_t __attribute__((ext_vector_type(2)));
__device__ __forceinline__ unsigned cvtpk_s(float lo,float hi){f32x2_t v={lo,hi};bf16x2_t b=__builtin_convertvector(v,bf16x2_t);return __builtin_bit_cast(unsigned,b);}
#define WAIT_BAR(N) asm volatile("s_waitcnt vmcnt(" #N ") lgkmcnt(0)\n\ts_barrier":::"memory")

__device__ __forceinline__ void qkt(f32x16&p0,f32x16&p1,const char*Kslot,const bf16x8*qr,const f32x16&negm,int r32,int hi){
  const char*kb=Kslot+hi*1024+r32*16;
  #pragma unroll
  for(int d0=0;d0<4;++d0){
    const bf16x8 b0=*reinterpret_cast<const bf16x8*>(kb+d0*2048);
    const bf16x8 b1=*reinterpret_cast<const bf16x8*>(kb+d0*2048+512);
    if(d0==0){p0=__builtin_amdgcn_mfma_f32_32x32x16_bf16(b0,qr[0],negm,0,0,0);p1=__builtin_amdgcn_mfma_f32_32x32x16_bf16(b1,qr[0],negm,0,0,0);}
    else{p0=__builtin_amdgcn_mfma_f32_32x32x16_bf16(b0,qr[d0],p0,0,0,0);p1=__builtin_amdgcn_mfma_f32_32x32x16_bf16(b1,qr[d0],p1,0,0,0);}}
}
typedef __attribute__((address_space(3))) const char* lds_cptr;
typedef short v4i16_t __attribute__((ext_vector_type(4)));
__device__ __forceinline__ void kload8(bf16x8*kf,lds_cptr kp){
  kf[0]=*(const __attribute__((address_space(3))) bf16x8*)(kp);      kf[1]=*(const __attribute__((address_space(3))) bf16x8*)(kp+512);
  kf[2]=*(const __attribute__((address_space(3))) bf16x8*)(kp+2048); kf[3]=*(const __attribute__((address_space(3))) bf16x8*)(kp+2560);
  kf[4]=*(const __attribute__((address_space(3))) bf16x8*)(kp+4096); kf[5]=*(const __attribute__((address_space(3))) bf16x8*)(kp+4608);
  kf[6]=*(const __attribute__((address_space(3))) bf16x8*)(kp+6144); kf[7]=*(const __attribute__((address_space(3))) bf16x8*)(kp+6656);
}
__device__ __forceinline__ void kload2(bf16x8*kf,lds_cptr kp,int j){ kf[2*j]=*(const __attribute__((address_space(3))) bf16x8*)(kp+j*2048); kf[2*j+1]=*(const __attribute__((address_space(3))) bf16x8*)(kp+j*2048+512); }
__device__ __forceinline__ s16x4 vtr(lds_cptr p){ return __builtin_bit_cast(s16x4,__builtin_amdgcn_ds_read_tr16_b64_v4i16((__attribute__((address_space(3))) v4i16_t*)p)); }
__device__ __forceinline__ float rowmax(const f32x16&p0,const f32x16&p1){
  float a=max3f(p0[0],p0[1],p1[0]),b=max3f(p0[2],p0[3],p1[1]);a=max3f(a,p1[2],p1[3]);
  #pragma unroll
  for(int r=4;r<16;r+=4){a=max3f(a,p0[r],p0[r+1]);b=max3f(b,p0[r+2],p0[r+3]);a=max3f(a,p1[r],p1[r+1]);b=max3f(b,p1[r+2],p1[r+3]);}
  const float m=max2f(a,b);
  auto rr=__builtin_amdgcn_permlane32_swap(__float_as_uint(m),__float_as_uint(m),false,false);
  return max2f(__uint_as_float(rr[0]),__uint_as_float(rr[1]));
}
__device__ __forceinline__ void pv(f32x16*o,int vb,bf16x8 pa0,bf16x8 pa1,bf16x8 pa2,bf16x8 pa3){
  #pragma unroll
  for(int d0=0;d0<2;++d0){s16x4 lo[4],hi[4];
    #pragma unroll
    for(int ks=0;ks<4;++ks){
      asm volatile("ds_read_b64_tr_b16 %0,%1 offset:%c2":"=&v"(lo[ks]):"v"(vb),"i"(d0*4096+ks*1024):"memory");
      asm volatile("ds_read_b64_tr_b16 %0,%1 offset:%c2":"=&v"(hi[ks]):"v"(vb),"i"(d0*4096+ks*1024+512):"memory");}
    asm volatile("s_waitcnt lgkmcnt(0)":::"memory");SBAR();
    #define PK(k) (bf16x8){lo[k][0],lo[k][1],lo[k][2],lo[k][3],hi[k][0],hi[k][1],hi[k][2],hi[k][3]}
    o[d0]=__builtin_amdgcn_mfma_f32_32x32x16_bf16(pa0,PK(0),o[d0],0,0,0);
    o[d0]=__builtin_amdgcn_mfma_f32_32x32x16_bf16(pa1,PK(1),o[d0],0,0,0);
    o[d0]=__builtin_amdgcn_mfma_f32_32x32x16_bf16(pa2,PK(2),o[d0],0,0,0);
    o[d0]=__builtin_amdgcn_mfma_f32_32x32x16_bf16(pa3,PK(3),o[d0],0,0,0);
    #undef PK
  }
}

#ifndef ATTN_STORE16
#define ATTN_STORE16(p,v) (*(u32x4*)(p)=(v))
#endif
template<int THRL> __device__ __forceinline__ void attn_unit(int b,int hq,int hv,int qb,const bf16*Q,const bf16*__restrict__ K,const bf16*__restrict__ V,bf16*O,char*shm){
  int tid_=threadIdx.x; asm volatile("":"+v"(tid_)); const int tid=tid_,lane=tid&63,r32=lane&31,hi=lane>>5; const int wid=__builtin_amdgcn_readfirstlane(tid>>6);
  const long rowbase=(long)b*SEQ; const int q0=qb*QB;
  const bf16*Qw=Q+(rowbase+q0+wid*QBLK)*DM+hq*D;
  const bf16*Kh=K+rowbase*DM+hq*D,*Vh=V+rowbase*DM+hv*D;
  const unsigned lds0=(unsigned)(uintptr_t)shm;
  float*wsf=(float*)(shm+LDS_WS)+wid*64;
  const bf16*ksrc=Kh+(long)lane*DM+wid*8;
  const bf16*vsrc=Vh+(long)(16*(wid&3)+(lane>>2))*DM+(wid>>2)*32+(lane&3)*8;
  const unsigned kdst=lds0+LDS_K+wid*1024, vdst=lds0+LDS_V+wid*1024;
  #define DMA_K(t,slot) glds16(ksrc+(long)(t)*KVBLK*DM,(unsigned)__builtin_amdgcn_readfirstlane(kdst+(slot)))
  #define DMA_V(t,slot) glds16(vsrc+(long)(t)*KVBLK*DM,(unsigned)__builtin_amdgcn_readfirstlane(vdst+(slot)))
  const int vb0=(int)(lds0+LDS_V)+((lane>>4)&1)*32+(lane&3)*8+(4*hi+((lane&15)>>2))*64;
  const char*Kbase=shm+LDS_K; bf16x8 kf[8];
  const lds_cptr shm3=(lds_cptr)shm; const lds_cptr kp0=shm3+LDS_K+hi*1024+r32*16; const lds_cptr vp0=shm3+LDS_V+((lane>>4)&1)*32+(lane&3)*8+(4*hi+((lane&15)>>2))*64;
  const int NT=(q0+QB)/KVBLK;
  DMA_K(0,0);DMA_V(0,0);DMA_K(1,SLOTB);
  bf16x8 qr[4];
  #pragma unroll
  for(int d0=0;d0<4;++d0)qr[d0]=*reinterpret_cast<const bf16x8*>(&Qw[(long)r32*DM+d0*16+hi*8]);
  float mhat=0.f,l_reg=0.f;f32x16 o[2];o[0]=f32x16{};o[1]=f32x16{};f32x16 negm=f32x16{};asm volatile("":"+v"(negm));
  const int qrel=wid*QBLK+r32;
  #define CMASK(P0,P1,t) do{int jb_=(t)-(NT-4); if(jb_>=0)cmask(P0,P1,jb_,qrel,hi);}while(0)
  bool resc=false;
  #define START(P0,P1) do{ const float rm=rowmax(P0,P1); resc=false; \
    { const float dl=rm; mhat=fadd_s(mhat,dl); \
      _Pragma("unroll") for(int r=0;r<16;++r){P0[r]=fsub_s(P0[r],dl);P1[r]=fsub_s(P1[r],dl);} \
      _Pragma("unroll") for(int r=0;r<16;++r)negm[r]=-mhat; asm volatile("":"+v"(negm)); } \
    _Pragma("unroll") for(int r=0;r<16;++r)P0[r]=__builtin_amdgcn_exp2f(P0[r]); }while(0)
  #define RESC() do{ if(resc){ asm volatile("s_waitcnt lgkmcnt(0)":::"memory"); \
      _Pragma("unroll") for(int d_=0;d_<2;++d_) _Pragma("unroll") for(int r=0;r<16;++r)o[d_][r]*=wsf[crow(r,hi)]; } }while(0)
  f32x16 pA0,pA1,pB0,pB1;
  int sl_prev=0,sl_cur=0,sl_next=SLOTB;
  #define ROT() do{sl_prev=sl_cur;sl_cur=sl_next;sl_next=(sl_next==(NSLOT-1)*SLOTB)?0:sl_next+SLOTB;}while(0)
  DMA_K(2,2*SLOTB);
  WAIT_BAR(3);
  qkt(pA0,pA1,Kbase,qr,negm,r32,hi);asm volatile("s_nop 15\n\ts_nop 7":"+v"(pA0),"+v"(pA1));CMASK(pA0,pA1,0);
  START(pA0,pA1);
  _Pragma("unroll") for(int r=0;r<16;++r)pA1[r]=__builtin_amdgcn_exp2f(pA1[r]);
  WAIT_BAR(0);
  DMA_K(3,0);DMA_V(1,SLOTB);
  ROT();
  kload8(kf,kp0+sl_cur);
  WAIT_BAR(2);
  s16x4 vlo[8],vhi[8]; u32x4 pw0,pw1,pw2,pw3;
  #define PKW(P,B) cvtpk_s(P[B],P[B+1])
  #define PAF(k) __builtin_bit_cast(bf16x8,pw##k)
  #define VFR(i) (bf16x8){vlo[i][0],vlo[i][1],vlo[i][2],vlo[i][3],vhi[i][0],vhi[i][1],vhi[i][2],vhi[i][3]}
  #define PIN(x) asm volatile("":"+v"(x))
  #define MX3(a,b,c) __builtin_fmaxf(__builtin_fmaxf((a),(b)),(c))
  #define GAPA(MF,A0,A1,A2,A3,W0,W1,PW) do{ MF; sacc+=A0; sacc+=A1; sacc+=A2; sacc+=A3; PIN(sacc); W0; W1; PIN(PW); SBAR(); }while(0)
  #define EX(v) __builtin_amdgcn_exp2f(v)
  #define GAPB(MF,X,B) do{ MF; X[B]=EX(X[B]); X[B+1]=EX(X[B+1]); X[B+2]=EX(X[B+2]); X[B+3]=EX(X[B+3]); PIN(X); SBAR(); }while(0)
  #define VRD(i) do{ vlo[i]=vtr(vp_+(((i)>>2)*4096+((i)&3)*1024)); vhi[i]=vtr(vp_+(((i)>>2)*4096+((i)&3)*1024+512)); }while(0)
  #define KRD(G,j) do{ if(G){ kload2(kf,kp0+sl_next,j); SBAR(); } }while(0)
  #define STEP(C0,C1,P0,P1,t,GK,GV,GL) do{ SBAR(); \
    const lds_cptr vp_=vp0+sl_prev; \
    VRD(0); SBAR(); float sacc=(P0[0]+P0[1]); \
    GAPA(C0=__builtin_amdgcn_mfma_f32_32x32x16_bf16(kf[0],qr[0],negm,0,0,0), P0[2],P0[3],P0[4],P0[5],     pw0[0]=PKW(P0,0), pw0[1]=PKW(P0,2), pw0); \
    VRD(4); SBAR(); GAPA(C1=__builtin_amdgcn_mfma_f32_32x32x16_bf16(kf[1],qr[0],negm,0,0,0), P0[6],P0[7],P0[8],P0[9],     pw0[2]=PKW(P0,4), pw0[3]=PKW(P0,6), pw0); \
    VRD(1); SBAR(); GAPA(C0=__builtin_amdgcn_mfma_f32_32x32x16_bf16(kf[2],qr[1],C0,0,0,0),   P0[10],P0[11],P0[12],P0[13], pw1[0]=PKW(P0,8), pw1[1]=PKW(P0,10), pw1); \
    VRD(5); SBAR(); GAPA(C1=__builtin_amdgcn_mfma_f32_32x32x16_bf16(kf[3],qr[1],C1,0,0,0),   P0[14],P0[15],P1[0],P1[1],   pw1[2]=PKW(P0,12),pw1[3]=PKW(P0,14), pw1); \
    VRD(2); SBAR(); GAPA(C0=__builtin_amdgcn_mfma_f32_32x32x16_bf16(kf[4],qr[2],C0,0,0,0),   P1[2],P1[3],P1[4],P1[5],     pw2[0]=PKW(P1,0), pw2[1]=PKW(P1,2), pw2); \
    VRD(6); SBAR(); GAPA(C1=__builtin_amdgcn_mfma_f32_32x32x16_bf16(kf[5],qr[2],C1,0,0,0),   P1[6],P1[7],P1[8],P1[9],     pw2[2]=PKW(P1,4), pw2[3]=PKW(P1,6), pw2); \
    VRD(3); SBAR(); GAPA(C0=__builtin_amdgcn_mfma_f32_32x32x16_bf16(kf[6],qr[3],C0,0,0,0),   P1[10],P1[11],P1[12],P1[13], pw3[0]=PKW(P1,8), pw3[1]=PKW(P1,10), pw3); \
    VRD(7); SBAR(); GAPA(C1=__builtin_amdgcn_mfma_f32_32x32x16_bf16(kf[7],qr[3],C1,0,0,0),   P1[14],P1[15],0.f,0.f,       pw3[2]=PKW(P1,12),pw3[3]=PKW(P1,14), pw3); \
    l_reg+=sacc; \
    if(GK){DMA_K((t)+3,sl_cur);} if(GV){DMA_V((t)+1,sl_next);} \
    CMASK(C0,C1,t); \
    { float a=MX3(C0[0],C0[1],C1[0]),b=MX3(C0[2],C0[3],C1[1]); a=MX3(a,C1[2],C1[3]); \
      _Pragma("unroll") for(int r=4;r<16;r+=4){a=MX3(a,C0[r],C0[r+1]);b=MX3(b,C0[r+2],C0[r+3]);a=MX3(a,C1[r],C1[r+1]);b=MX3(b,C1[r+2],C1[r+3]);} \
      float rm=__builtin_fmaxf(a,b); { auto rr=__builtin_amdgcn_permlane32_swap(__float_as_uint(rm),__float_as_uint(rm),false,false); rm=__builtin_fmaxf(__uint_as_float(rr[0]),__uint_as_float(rr[1])); } \
      resc=false; \
      if(__builtin_expect(__any(rm>(float)THRL),0)){ const float dl=__builtin_fmaxf(rm,0.f); mhat+=dl; \
        _Pragma("unroll") for(int r=0;r<16;++r){C0[r]-=dl;C1[r]-=dl;} \
        _Pragma("unroll") for(int r=0;r<16;++r)negm[r]=-mhat; asm volatile("":"+v"(negm)); \
        const float f=__builtin_amdgcn_exp2f(-dl); l_reg*=f; if(hi==0)wsf[r32]=f; resc=true; } } \
    SBAR(); \
    GAPB(o[0]=__builtin_amdgcn_mfma_f32_32x32x16_bf16(PAF(0),VFR(0),o[0],0,0,0), C0,0); \
    GAPB(o[1]=__builtin_amdgcn_mfma_f32_32x32x16_bf16(PAF(0),VFR(4),o[1],0,0,0), C0,4); \
    KRD(GL,0); GAPB(o[0]=__builtin_amdgcn_mfma_f32_32x32x16_bf16(PAF(1),VFR(1),o[0],0,0,0), C0,8); \
    KRD(GL,1); GAPB(o[1]=__builtin_amdgcn_mfma_f32_32x32x16_bf16(PAF(1),VFR(5),o[1],0,0,0), C0,12); \
    KRD(GL,2); GAPB(o[0]=__builtin_amdgcn_mfma_f32_32x32x16_bf16(PAF(2),VFR(2),o[0],0,0,0), C1,0); \
    KRD(GL,3); GAPB(o[1]=__builtin_amdgcn_mfma_f32_32x32x16_bf16(PAF(2),VFR(6),o[1],0,0,0), C1,4); \
    GAPB(o[0]=__builtin_amdgcn_mfma_f32_32x32x16_bf16(PAF(3),VFR(3),o[0],0,0,0), C1,8); \
    GAPB(o[1]=__builtin_amdgcn_mfma_f32_32x32x16_bf16(PAF(3),VFR(7),o[1],0,0,0), C1,12); \
    }while(0)
  int t=1;
  #undef CMASK
  #define CMASK(P0,P1,t) do{}while(0)
  for(;t+5<NT;t+=2){
    STEP(pB0,pB1,pA0,pA1,t,true,true,true);     WAIT_BAR(2); RESC(); ROT();
    STEP(pA0,pA1,pB0,pB1,t+1,true,true,true);   WAIT_BAR(2); RESC(); ROT();
  }
  #undef CMASK
  #define CMASK(P0,P1,t) do{int jb_=(t)-(NT-4); if(jb_>=0)cmask(P0,P1,jb_,qrel,hi);}while(0)
  #define ENDW(tt) do{ if((tt)+3<NT){WAIT_BAR(2);} else if((tt)+2<NT){WAIT_BAR(1);} else {WAIT_BAR(0);} }while(0)
  for(;t+1<NT;t+=2){
    STEP(pB0,pB1,pA0,pA1,t,(t+3<NT),(t+1<NT),(t+1<NT));       ENDW(t);   RESC(); ROT();
    STEP(pA0,pA1,pB0,pB1,t+1,(t+4<NT),(t+2<NT),(t+2<NT));     ENDW(t+1); RESC(); ROT();
  }
  STEP(pB0,pB1,pA0,pA1,NT-1,false,false,false); RESC();
  { float sacc=pB0[0]+pB0[1]; _Pragma("unroll") for(int r=2;r<16;++r)sacc+=pB0[r]; _Pragma("unroll") for(int r=0;r<16;++r)sacc+=pB1[r]; l_reg+=sacc;
    pw0=(u32x4){PKW(pB0,0),PKW(pB0,2),PKW(pB0,4),PKW(pB0,6)};pw1=(u32x4){PKW(pB0,8),PKW(pB0,10),PKW(pB0,12),PKW(pB0,14)};pw2=(u32x4){PKW(pB1,0),PKW(pB1,2),PKW(pB1,4),PKW(pB1,6)};pw3=(u32x4){PKW(pB1,8),PKW(pB1,10),PKW(pB1,12),PKW(pB1,14)};
    SBAR(); pv(o,vb0+sl_cur,PAF(0),PAF(1),PAF(2),PAF(3)); }
  #undef PKW
  #undef PAF
  #undef VFR
  #undef PIN
  #undef MX3
  #undef GAPA
  #undef GAPB
  #undef EX
  #undef VRD
  #undef KRD
  #undef STEP
  #undef ENDW
  {auto rr=__builtin_amdgcn_permlane32_swap(__float_as_uint(l_reg),__float_as_uint(l_reg),false,false);l_reg=__uint_as_float(rr[0])+__uint_as_float(rr[1]);}
  if(hi==0)wsf[32+r32]=l_reg;asm volatile("s_waitcnt lgkmcnt(0)":::"memory");
  float rli[16];
  #pragma unroll
  for(int r=0;r<16;++r)rli[r]=__builtin_amdgcn_rcpf(wsf[32+crow(r,hi)]);
  bf16*Ow=O+(rowbase+q0+wid*QBLK)*DM+hv*D;
  { bf16*stg=(bf16*)(shm+LDS_OST)+wid*2048;
    #pragma unroll
    for(int r=0;r<16;++r){const int orow=crow(r,hi);
      #pragma unroll
      for(int d0=0;d0<2;++d0)stg[orow*64+d0*32+r32]=__float2bfloat16(o[d0][r]*rli[r]);}
    asm volatile("s_waitcnt lgkmcnt(0)":::"memory");
    #pragma unroll
    for(int i=0;i<4;++i){const int row=i*8+(lane>>3),ch=lane&7; const u32x4 v=*(const u32x4*)(stg+row*64+ch*8); ATTN_STORE16(Ow+(long)row*DM+ch*8,v);} }
  asm volatile("s_waitcnt lgkmcnt(0)\n\ts_barrier":::"memory");
  #undef DMA_K
  #undef DMA_V
  #undef CMASK
  #undef START
  #undef RESC
  #undef ROT
}
constexpr int ATTN_LDS_BYTES=LDS_BYTES;
struct DiffTensorsV { const bf16* Q; const bf16* K; const bf16* V; bf16* O0; bf16* O1; };
template<int THRL=8> __device__ __forceinline__ void diff_attn_phase(char*lds,const DiffTensorsV&T,int vcu,int G){
  for(int pr=vcu>>1; pr<BATCH*32; pr+=(G>>1)){
    const int s=vcu&1, b=pr>>5, h=(pr>>2)&7, c=(pr>>1)&1, vh=pr&1;
    for(int j=15;j>=0;--j){ const int qb=2*j+((j&1)?1-s:s);
      attn_unit<THRL>(b,2*h+c,2*h+vh,qb,T.Q,T.K,T.V,c?T.O1:T.O0,lds); } }
}
constexpr int VSLOTB=16384;
constexpr int L2_K=0, L2_V=NSLOT*SLOTB, L2_WS=L2_V+NSLOT*VSLOTB, L2_OST=L2_WS+NW*64*4, L2_Q=L2_OST+NW*4096, L2_BYTES=L2_Q+NW*4096;
template<int THRL> __device__ __forceinline__ void attn_unit128(int b,int hq,int h,int qb,const bf16*Q,const bf16*__restrict__ K,const bf16*__restrict__ V,bf16*O,bf16*OB,int cmap,float lam,const float*subw,char*shm){
  int tid_=threadIdx.x; asm volatile("":"+v"(tid_)); const int tid=tid_,lane=tid&63,r32=lane&31,hi=lane>>5; const int wid=__builtin_amdgcn_readfirstlane(tid>>6);
  const long rowbase=(long)b*SEQ; const int q0=qb*QB;
  const bf16*Qw=Q+(rowbase+q0+wid*QBLK)*DM+hq*D;
  const bf16*Kh=K+rowbase*DM+hq*D,*Vh=V+rowbase*DM+h*128;
  const unsigned lds0=(unsigned)(uintptr_t)shm;
  float*wsf=(float*)(shm+L2_WS)+wid*64;
  const bf16*ksrc=Kh+(long)lane*DM+wid*8;
  const bf16*vsrc=Vh+(long)(16*(wid&3)+(lane>>2))*DM+(wid>>2)*32+(lane&3)*8;
  const unsigned kdst=lds0+L2_K+wid*1024, vdst=lds0+L2_V+wid*1024;
  #define DMA_K(t,slot) glds16(ksrc+(long)(t)*KVBLK*DM,(unsigned)__builtin_amdgcn_readfirstlane(kdst+(slot)))
  #define DMA_V(t,slot) do{ glds16(vsrc+(long)(t)*KVBLK*DM,(unsigned)__builtin_amdgcn_readfirstlane(vdst+2*(slot))); glds16(vsrc+(long)(t)*KVBLK*DM+64,(unsigned)__builtin_amdgcn_readfirstlane(vdst+2*(slot)+8192)); }while(0)
  const int vb0=(int)(lds0+L2_V)+((lane>>4)&1)*32+(lane&3)*8+(4*hi+((lane&15)>>2))*64;
  bf16x8 kf[8];
  const lds_cptr shm3=(lds_cptr)shm; const lds_cptr kp0=shm3+L2_K+hi*1024+r32*16; const lds_cptr vp0=shm3+L2_V+((lane>>4)&1)*32+(lane&3)*8+(4*hi+((lane&15)>>2))*64;
  typedef __attribute__((address_space(3))) char* lds_ptr;
  const lds_ptr qp=(lds_ptr)shm+L2_Q+wid*4096+lane*16;
  #define QF(d0) (*(const __attribute__((address_space(3))) bf16x8*)(qp+(d0)*1024))
  const int NT=(q0+QB)/KVBLK;
  DMA_K(0,0);DMA_V(0,0);DMA_K(1,SLOTB);
  { bf16x8 q4[4];
    #pragma unroll
    for(int d0=0;d0<4;++d0)q4[d0]=*reinterpret_cast<const bf16x8*>(&Qw[(long)r32*DM+d0*16+hi*8]);
    #pragma unroll
    for(int d0=0;d0<4;++d0)*(__attribute__((address_space(3))) bf16x8*)(qp+d0*1024)=q4[d0]; }
  float zf=0.f; asm volatile("":"+v"(zf));
  float mhat=0.f,l_reg=0.f;f32x16 o[4];
  _Pragma("unroll") for(int d_=0;d_<4;++d_) _Pragma("unroll") for(int r=0;r<16;++r)o[d_][r]=zf;
  f32x16 negm; _Pragma("unroll") for(int r=0;r<16;++r)negm[r]=zf; asm volatile("":"+v"(negm));
  const int qrel=wid*QBLK+r32;
  #define CMASK(P0,P1,t) do{int jb_=(t)-(NT-4); if(jb_>=0)cmask(P0,P1,jb_,qrel,hi);}while(0)
  bool resc=false;
  #define RESC() do{ if(resc){ asm volatile("s_waitcnt lgkmcnt(0)":::"memory"); \
      _Pragma("unroll") for(int d_=0;d_<4;++d_) _Pragma("unroll") for(int r=0;r<16;++r)o[d_][r]*=wsf[crow(r,hi)]; } }while(0)
  f32x16 pA0,pA1,pB0,pB1;
  int sl_prev=0,sl_cur=0,sl_next=SLOTB;
  #define ROT() do{sl_prev=sl_cur;sl_cur=sl_next;sl_next=(sl_next==(NSLOT-1)*SLOTB)?0:sl_next+SLOTB;}while(0)
  DMA_K(2,2*SLOTB);
  WAIT_BAR(4);
  { bf16x8 kq[8]; kload8(kq,kp0);
    pA0=__builtin_amdgcn_mfma_f32_32x32x16_bf16(kq[0],QF(0),negm,0,0,0);pA1=__builtin_amdgcn_mfma_f32_32x32x16_bf16(kq[1],QF(0),negm,0,0,0);
    #pragma unroll
    for(int d0=1;d0<4;++d0){pA0=__builtin_amdgcn_mfma_f32_32x32x16_bf16(kq[2*d0],QF(d0),pA0,0,0,0);pA1=__builtin_amdgcn_mfma_f32_32x32x16_bf16(kq[2*d0+1],QF(d0),pA1,0,0,0);} }
  asm volatile("s_nop 15\n\ts_nop 7":"+v"(pA0),"+v"(pA1));CMASK(pA0,pA1,0);
  { const float rm=rowmax(pA0,pA1); mhat=rm;
    _Pragma("unroll") for(int r=0;r<16;++r){pA0[r]=__builtin_amdgcn_exp2f(pA0[r]-mhat);pA1[r]=__builtin_amdgcn_exp2f(pA1[r]-mhat);}
    _Pragma("unroll") for(int r=0;r<16;++r)negm[r]=-mhat; asm volatile("":"+v"(negm)); }
  WAIT_BAR(0);
  DMA_K(3,0);DMA_V(1,SLOTB);
  ROT();
  kload8(kf,kp0+sl_cur);
  WAIT_BAR(3);
  s16x4 vlo[8],vhi[8]; u32x4 pw0,pw1,pw2,pw3;
  #define PKW(P,B) cvtpk_s(P[B],P[B+1])
  #define PAF(k) __builtin_bit_cast(bf16x8,pw##k)
  #define VFR(i) (bf16x8){vlo[i][0],vlo[i][1],vlo[i][2],vlo[i][3],vhi[i][0],vhi[i][1],vhi[i][2],vhi[i][3]}
  #define PIN(x) asm volatile("":"+v"(x))
  #define MX3(a,b,c) __builtin_fmaxf(__builtin_fmaxf((a),(b)),(c))
  #define GAPA(MF,A0,A1,A2,A3,W0,W1,PW) do{ MF; sacc+=A0; sacc+=A1; sacc+=A2; sacc+=A3; PIN(sacc); W0; W1; PIN(PW); SBAR(); }while(0)
  #define EX(v) __builtin_amdgcn_exp2f(v)
  #define GAPB(MF,X,B) do{ MF; X[B]=EX(X[B]); X[B+1]=EX(X[B+1]); PIN(X); SBAR(); }while(0)
  #define VRD(i) do{ vlo[(i)&7]=vtr(vp_+(((i)>>2)*4096+((i)&3)*1024)); vhi[(i)&7]=vtr(vp_+(((i)>>2)*4096+((i)&3)*1024+512)); }while(0)
  #define KRD(G,j) do{ if(G){ kload2(kf,kp0+sl_next,j); SBAR(); } }while(0)
  #define STEP(C0,C1,P0,P1,t,GK,GV,GL) do{ SBAR(); \
    const lds_cptr vp_=vp0+2*sl_prev; bf16x8 qa=QF(0),qb_=QF(1); \
    VRD(0); SBAR(); float sacc=(P0[0]+P0[1]); \
    GAPA(C0=__builtin_amdgcn_mfma_f32_32x32x16_bf16(kf[0],qa,negm,0,0,0), P0[2],P0[3],P0[4],P0[5],     pw0[0]=PKW(P0,0), pw0[1]=PKW(P0,2), pw0); \
    VRD(4); SBAR(); GAPA(C1=__builtin_amdgcn_mfma_f32_32x32x16_bf16(kf[1],qa,negm,0,0,0), P0[6],P0[7],P0[8],P0[9],     pw0[2]=PKW(P0,4), pw0[3]=PKW(P0,6), pw0); \
    qa=QF(2); VRD(1); SBAR(); GAPA(C0=__builtin_amdgcn_mfma_f32_32x32x16_bf16(kf[2],qb_,C0,0,0,0),   P0[10],P0[11],P0[12],P0[13], pw1[0]=PKW(P0,8), pw1[1]=PKW(P0,10), pw1); \
    VRD(5); SBAR(); GAPA(C1=__builtin_amdgcn_mfma_f32_32x32x16_bf16(kf[3],qb_,C1,0,0,0),   P0[14],P0[15],P1[0],P1[1],   pw1[2]=PKW(P0,12),pw1[3]=PKW(P0,14), pw1); \
    qb_=QF(3); VRD(2); SBAR(); GAPA(C0=__builtin_amdgcn_mfma_f32_32x32x16_bf16(kf[4],qa,C0,0,0,0),   P1[2],P1[3],P1[4],P1[5],     pw2[0]=PKW(P1,0), pw2[1]=PKW(P1,2), pw2); \
    VRD(6); SBAR(); GAPA(C1=__builtin_amdgcn_mfma_f32_32x32x16_bf16(kf[5],qa,C1,0,0,0),   P1[6],P1[7],P1[8],P1[9],     pw2[2]=PKW(P1,4), pw2[3]=PKW(P1,6), pw2); \
    VRD(3); SBAR(); GAPA(C0=__builtin_amdgcn_mfma_f32_32x32x16_bf16(kf[6],qb_,C0,0,0,0),   P1[10],P1[11],P1[12],P1[13], pw3[0]=PKW(P1,8), pw3[1]=PKW(P1,10), pw3); \
    VRD(7); SBAR(); GAPA(C1=__builtin_amdgcn_mfma_f32_32x32x16_bf16(kf[7],qb_,C1,0,0,0),   P1[14],P1[15],0.f,0.f,       pw3[2]=PKW(P1,12),pw3[3]=PKW(P1,14), pw3); \
    l_reg+=sacc; \
    if(GK){DMA_K((t)+3,sl_cur);} if(GV){DMA_V((t)+1,sl_next);} \
    CMASK(C0,C1,t); \
    { float a=MX3(C0[0],C0[1],C1[0]),b=MX3(C0[2],C0[3],C1[1]); a=MX3(a,C1[2],C1[3]); \
      _Pragma("unroll") for(int r=4;r<16;r+=4){a=MX3(a,C0[r],C0[r+1]);b=MX3(b,C0[r+2],C0[r+3]);a=MX3(a,C1[r],C1[r+1]);b=MX3(b,C1[r+2],C1[r+3]);} \
      float rm=__builtin_fmaxf(a,b); { auto rr=__builtin_amdgcn_permlane32_swap(__float_as_uint(rm),__float_as_uint(rm),false,false); rm=__builtin_fmaxf(__uint_as_float(rr[0]),__uint_as_float(rr[1])); } \
      resc=false; \
      if(__builtin_expect(__any(rm>(float)THRL),0)){ const float dl=__builtin_fmaxf(rm,0.f); mhat+=dl; \
        _Pragma("unroll") for(int r=0;r<16;++r){C0[r]-=dl;C1[r]-=dl;} \
        _Pragma("unroll") for(int r=0;r<16;++r)negm[r]=-mhat; asm volatile("":"+v"(negm)); \
        const float f=__builtin_amdgcn_exp2f(-dl); l_reg*=f; if(hi==0)wsf[r32]=f; resc=true; } } \
    SBAR(); \
    GAPB(o[0]=__builtin_amdgcn_mfma_f32_32x32x16_bf16(PAF(0),VFR(0),o[0],0,0,0), C0,0);  VRD(8);  SBAR(); \
    GAPB(o[1]=__builtin_amdgcn_mfma_f32_32x32x16_bf16(PAF(0),VFR(4),o[1],0,0,0), C0,2);  VRD(12); SBAR(); \
    KRD(GL,0); GAPB(o[0]=__builtin_amdgcn_mfma_f32_32x32x16_bf16(PAF(1),VFR(1),o[0],0,0,0), C0,4);  VRD(9);  SBAR(); \
    KRD(GL,1); GAPB(o[1]=__builtin_amdgcn_mfma_f32_32x32x16_bf16(PAF(1),VFR(5),o[1],0,0,0), C0,6);  VRD(13); SBAR(); \
    KRD(GL,2); GAPB(o[0]=__builtin_amdgcn_mfma_f32_32x32x16_bf16(PAF(2),VFR(2),o[0],0,0,0), C0,8);  VRD(10); SBAR(); \
    KRD(GL,3); GAPB(o[1]=__builtin_amdgcn_mfma_f32_32x32x16_bf16(PAF(2),VFR(6),o[1],0,0,0), C0,10); VRD(14); SBAR(); \
    GAPB(o[0]=__builtin_amdgcn_mfma_f32_32x32x16_bf16(PAF(3),VFR(3),o[0],0,0,0), C0,12); VRD(11); SBAR(); \
    GAPB(o[1]=__builtin_amdgcn_mfma_f32_32x32x16_bf16(PAF(3),VFR(7),o[1],0,0,0), C0,14); VRD(15); SBAR(); \
    GAPB(o[2]=__builtin_amdgcn_mfma_f32_32x32x16_bf16(PAF(0),VFR(0),o[2],0,0,0), C1,0); \
    GAPB(o[3]=__builtin_amdgcn_mfma_f32_32x32x16_bf16(PAF(0),VFR(4),o[3],0,0,0), C1,2); \
    GAPB(o[2]=__builtin_amdgcn_mfma_f32_32x32x16_bf16(PAF(1),VFR(1),o[2],0,0,0), C1,4); \
    GAPB(o[3]=__builtin_amdgcn_mfma_f32_32x32x16_bf16(PAF(1),VFR(5),o[3],0,0,0), C1,6); \
    GAPB(o[2]=__builtin_amdgcn_mfma_f32_32x32x16_bf16(PAF(2),VFR(2),o[2],0,0,0), C1,8); \
    GAPB(o[3]=__builtin_amdgcn_mfma_f32_32x32x16_bf16(PAF(2),VFR(6),o[3],0,0,0), C1,10); \
    GAPB(o[2]=__builtin_amdgcn_mfma_f32_32x32x16_bf16(PAF(3),VFR(3),o[2],0,0,0), C1,12); \
    GAPB(o[3]=__builtin_amdgcn_mfma_f32_32x32x16_bf16(PAF(3),VFR(7),o[3],0,0,0), C1,14); \
    }while(0)
  int t=1;
  #undef CMASK
  #define CMASK(P0,P1,t) do{}while(0)
  for(;t+5<NT;t+=2){
    STEP(pB0,pB1,pA0,pA1,t,true,true,true);     WAIT_BAR(3); RESC(); ROT();
    STEP(pA0,pA1,pB0,pB1,t+1,true,true,true);   WAIT_BAR(3); RESC(); ROT();
  }
  #undef CMASK
  #define CMASK(P0,P1,t) do{int jb_=(t)-(NT-4); if(jb_>=0)cmask(P0,P1,jb_,qrel,hi);}while(0)
  #define ENDW(tt) do{ if((tt)+3<NT){WAIT_BAR(3);} else if((tt)+2<NT){WAIT_BAR(2);} else {WAIT_BAR(0);} }while(0)
  for(;t+1<NT;t+=2){
    STEP(pB0,pB1,pA0,pA1,t,(t+3<NT),(t+1<NT),(t+1<NT));       ENDW(t);   RESC(); ROT();
    STEP(pA0,pA1,pB0,pB1,t+1,(t+4<NT),(t+2<NT),(t+2<NT));     ENDW(t+1); RESC(); ROT();
  }
  STEP(pB0,pB1,pA0,pA1,NT-1,false,false,false); RESC();
  { float sacc=pB0[0]+pB0[1]; _Pragma("unroll") for(int r=2;r<16;++r)sacc+=pB0[r]; _Pragma("unroll") for(int r=0;r<16;++r)sacc+=pB1[r]; l_reg+=sacc;
    pw0=(u32x4){PKW(pB0,0),PKW(pB0,2),PKW(pB0,4),PKW(pB0,6)};pw1=(u32x4){PKW(pB0,8),PKW(pB0,10),PKW(pB0,12),PKW(pB0,14)};pw2=(u32x4){PKW(pB1,0),PKW(pB1,2),PKW(pB1,4),PKW(pB1,6)};pw3=(u32x4){PKW(pB1,8),PKW(pB1,10),PKW(pB1,12),PKW(pB1,14)};
    SBAR();
    const int vb=vb0+2*sl_cur;
    #pragma unroll
    for(int d0=0;d0<4;++d0){s16x4 lo[4],hi4[4];
      #pragma unroll
      for(int ks=0;ks<4;++ks){
        asm volatile("ds_read_b64_tr_b16 %0,%1 offset:%c2":"=&v"(lo[ks]):"v"(vb),"i"(d0*4096+ks*1024):"memory");
        asm volatile("ds_read_b64_tr_b16 %0,%1 offset:%c2":"=&v"(hi4[ks]):"v"(vb),"i"(d0*4096+ks*1024+512):"memory");}
      asm volatile("s_waitcnt lgkmcnt(0)":::"memory");SBAR();
      #define PK(k) (bf16x8){lo[k][0],lo[k][1],lo[k][2],lo[k][3],hi4[k][0],hi4[k][1],hi4[k][2],hi4[k][3]}
      o[d0]=__builtin_amdgcn_mfma_f32_32x32x16_bf16(PAF(0),PK(0),o[d0],0,0,0);
      o[d0]=__builtin_amdgcn_mfma_f32_32x32x16_bf16(PAF(1),PK(1),o[d0],0,0,0);
      o[d0]=__builtin_amdgcn_mfma_f32_32x32x16_bf16(PAF(2),PK(2),o[d0],0,0,0);
      o[d0]=__builtin_amdgcn_mfma_f32_32x32x16_bf16(PAF(3),PK(3),o[d0],0,0,0);
      #undef PK
    } }
  #undef PKW
  #undef PAF
  #undef VFR
  #undef PIN
  #undef MX3
  #undef GAPA
  #undef GAPB
  #undef EX
  #undef VRD
  #undef KRD
  #undef STEP
  #undef ENDW
  #undef QF
  {auto rr=__builtin_amdgcn_permlane32_swap(__float_as_uint(l_reg),__float_as_uint(l_reg),false,false);l_reg=__uint_as_float(rr[0])+__uint_as_float(rr[1]);}
  if(hi==0)wsf[32+r32]=l_reg;asm volatile("s_waitcnt lgkmcnt(0)":::"memory");
  float rli[16];
  #pragma unroll
  for(int r=0;r<16;++r)rli[r]=__builtin_amdgcn_rcpf(wsf[32+crow(r,hi)]);
  bf16*Ow=O+(rowbase+q0+wid*QBLK)*DM+h*128;
  { bf16*stg=(bf16*)(shm+L2_OST)+wid*2048;
    if(cmap==0){
    #pragma unroll
    for(int ps=0;ps<2;++ps){
      #pragma unroll
      for(int r=0;r<16;++r){const int orow=crow(r,hi);
        #pragma unroll
        for(int d0=0;d0<2;++d0)stg[orow*64+d0*32+r32]=__float2bfloat16(o[2*ps+d0][r]*rli[r]);}
      asm volatile("s_waitcnt lgkmcnt(0)":::"memory");
      #pragma unroll
      for(int i=0;i<4;++i){const int row=i*8+(lane>>3),ch=lane&7; const u32x4 v=*(const u32x4*)(stg+row*64+ch*8); ATTN_STORE16(Ow+(long)row*DM+ps*64+ch*8,v);}
      asm volatile("s_waitcnt lgkmcnt(0)":::"memory"); }
    } else {
    signed char*OBw=(signed char*)OB+(rowbase+q0+wid*QBLK)*DM+h*128;
    float dv[2][4][8]; float ssq[4]={0.f,0.f,0.f,0.f};
    #pragma unroll
    for(int ps=0;ps<2;++ps){
      #pragma unroll
      for(int r=0;r<16;++r){const int orow=crow(r,hi);
        #pragma unroll
        for(int d0=0;d0<2;++d0)stg[orow*64+d0*32+r32]=__float2bfloat16(o[2*ps+d0][r]*rli[r]);}
      asm volatile("s_waitcnt lgkmcnt(0)":::"memory");
      #pragma unroll
      for(int i=0;i<4;++i){const int row=i*8+(lane>>3),ch=lane&7; const u32x4 v=*(const u32x4*)(stg+row*64+ch*8);
        const u32x4 a=__builtin_nontemporal_load((const u32x4*)(Ow+(long)row*DM+ps*64+ch*8));
        const unsigned aw[4]={a.x,a.y,a.z,a.w}, vw[4]={v.x,v.y,v.z,v.w};
        #pragma unroll
        for(int e=0;e<4;++e){ const float d0=__uint_as_float(aw[e]<<16)-lam*__uint_as_float(vw[e]<<16), d1=__uint_as_float(aw[e]&0xffff0000u)-lam*__uint_as_float(vw[e]&0xffff0000u);
          dv[ps][i][2*e]=d0; dv[ps][i][2*e+1]=d1; ssq[i]+=d0*d0+d1*d1; } }
      asm volatile("s_waitcnt lgkmcnt(0)":::"memory"); }
    #pragma unroll
    for(int i=0;i<4;++i){ float ss=ssq[i]; ss+=__shfl_xor(ss,1); ss+=__shfl_xor(ss,2); ss+=__shfl_xor(ss,4);
      const float rstd=1.0f/sqrtf(ss*(1.0f/128.0f)+1e-5f);
      #pragma unroll
      for(int ps=0;ps<2;++ps){ const int row=i*8+(lane>>3),ch=lane&7; const float*sw=subw+ps*64+ch*8; u32x4 w;
        const float rq=rstd*OB_QINV;
        const unsigned q0_=pack4_i8(dv[ps][i][0]*rq*sw[0],dv[ps][i][1]*rq*sw[1],dv[ps][i][2]*rq*sw[2],dv[ps][i][3]*rq*sw[3]), q1_=pack4_i8(dv[ps][i][4]*rq*sw[4],dv[ps][i][5]*rq*sw[5],dv[ps][i][6]*rq*sw[6],dv[ps][i][7]*rq*sw[7]);
        (void)w; *(u32x2*)((signed char*)OBw+(long)row*DM+ps*64+ch*8)=(u32x2){q0_,q1_}; } }
    } }
  asm volatile("s_waitcnt lgkmcnt(0)\n\ts_barrier":::"memory");
  #undef DMA_K
  #undef DMA_V
  #undef CMASK
  #undef RESC
  #undef ROT
}
struct DiffTensors { const bf16* Q; const bf16* K; const bf16* V; bf16* O0; bf16* OB; const float* lam; const float* subw; float lam_init; };
template<int THRL=8> __device__ __forceinline__ void diff_attn_phase128(char*lds,const DiffTensors&T,int vcu,int G){
  const int lane=threadIdx.x&63;
  float l1=T.lam[lane]*T.lam[64+lane], l2=T.lam[128+lane]*T.lam[192+lane];
  #pragma unroll
  for(int o=1;o<64;o<<=1){ l1+=__shfl_xor(l1,o); l2+=__shfl_xor(l2,o); }
  const float lam_full=expf(l1)-expf(l2)+T.lam_init;
  for(int bh=vcu>>3; bh<BATCH*8; bh+=(G>>3)){
    const int s=vcu&7, b=bh>>3, h=bh&7;
    for(int j=3;j>=0;--j){ const int qb=(j==0)?s:(j==1)?15-s:(j==2)?16+s:31-s;
      attn_unit128<THRL>(b,2*h,h,qb,T.Q,T.K,T.V,T.O0,T.OB,0,lam_full,T.subw,lds);
      attn_unit128<THRL>(b,2*h+1,h,qb,T.Q,T.K,T.V,T.O0,T.OB,1,lam_full,T.subw,lds); } }
}
#undef SBAR
#undef WAIT_BAR
}

constexpr int NB = 4, SEQ = 8192, T = NB * SEQ, D = 1024;
constexpr int NE = 32, TOPK = 4;
constexpr int GLA_H = 4, GLA_DK = 128, GLA_DV = 256, GLA_C = 64, GLA_RUN = 8, GLA_NRUN = SEQ / (GLA_C * GLA_RUN), GLA_UNITS = NB * GLA_H * GLA_NRUN;
constexpr int NQKVR = 3072, LDW_IN = 3088;
constexpr float LN_EPS = 1e-5f, RMS_EPS = 1e-5f, DN_ALPHA = 1.4142135623730951f;
constexpr float LAMBDA_INIT = 0.35550906759096926f;
constexpr int NPAN_MAX = 544, NPAD_MAX = NPAN_MAX * 256;
constexpr int NWAVES = 8, NTHR = 512;
constexpr int NPHASE = 20;
#ifndef MK_N_LAUNCHES
#define MK_N_LAUNCHES 1
#endif
constexpr int N_LAUNCHES = MK_N_LAUNCHES;

constexpr size_t MiB = 1u << 20;
constexpr size_t WS_CTL = 0, CTL_ZERO_BYTES = 1 * MiB;
constexpr size_t WS_META = 2 * MiB;
constexpr size_t WS_TOPI = WS_META, WS_TOPG = WS_META + MiB / 2, WS_LRANK = WS_META + MiB, WS_SLOT = WS_META + 3 * MiB / 2, WS_CNT = WS_META + 2 * MiB, WS_PEXP = WS_META + 2 * MiB + MiB / 4;
constexpr size_t WS_SWD = WS_META + 2 * MiB + MiB / 2 + 8192, WS_SACT = WS_META + 2 * MiB + MiB / 2 + 12288;
constexpr size_t WS_SWKVQ = WS_META + 2 * MiB + MiB / 2 + 20480;
constexpr size_t WS_SWAO = WS_META + 2 * MiB + MiB / 2 + 24576, WS_SWBO = WS_META + 2 * MiB + MiB / 2 + 28672;
constexpr float OG_QS = 8.0f / 127.0f, OB_QS = 1.0f / attn_body::OB_QINV;
constexpr size_t WS_SWIN = WS_META + 2 * MiB + MiB / 2 + 16384;
constexpr size_t WS_SWQ = WS_META + 2 * MiB + MiB / 2 + 4096;
constexpr size_t WS_SUBW = WS_META + 2 * MiB + MiB / 2;
constexpr size_t WS_SROW = WS_META + 13 * MiB;
constexpr size_t WS_GKLOW = WS_META + 3 * MiB, WS_COS = WS_META + 5 * MiB, WS_SIN = WS_META + 9 * MiB;
constexpr size_t WS_WIN = 16 * MiB, WS_WAO = 22 * MiB, WS_WKVQ = 24 * MiB, WS_WBO = 30 * MiB, WS_WGU = 32 * MiB, WS_WD = 288 * MiB;
constexpr size_t WS_XB = 416 * MiB;
constexpr size_t WS_Y = 480 * MiB;
constexpr size_t WS_X1 = 608 * MiB;
constexpr size_t WS_X1Q = 608 * MiB, WS_SX = 640 * MiB, WS_SXS = 641 * MiB;
constexpr size_t WS_X1B = 736 * MiB;
constexpr size_t WS_X2 = 800 * MiB;
constexpr size_t WS_X2Q = 800 * MiB, WS_SX2 = 832 * MiB;
constexpr size_t WS_X2B = 928 * MiB;
constexpr size_t WS_M = 992 * MiB;
constexpr size_t WS_XG = WS_M, WS_ACT = WS_M + 272 * MiB, WS_YB = WS_M + 544 * MiB;
constexpr size_t WS_QKVR = WS_M, WS_OLOC = WS_M + 192 * MiB, WS_QDEC = WS_M + 320 * MiB, WS_SEND = WS_M + 352 * MiB, WS_SINIT = WS_M + 384 * MiB, WS_GSUM = WS_M + 400 * MiB, WS_OG = WS_M + 408 * MiB;
constexpr size_t WS_KB = WS_M, WS_VB = WS_M + 64 * MiB, WS_QB = WS_M + 128 * MiB, WS_O0 = WS_M + 192 * MiB, WS_O1 = WS_M + 256 * MiB, WS_OB = WS_M + 320 * MiB;
constexpr size_t WS_END = 1808 * MiB;
constexpr int CW_BAR = 4096;

constexpr int PHASE_LDS = 155648;
constexpr int MISC_OFF = PHASE_LDS, LDS_BYTES = PHASE_LDS + 512;
#define GAS __attribute__((address_space(1)))
#define LAS __attribute__((address_space(3)))
typedef unsigned short bf16;
typedef unsigned v4u __attribute__((ext_vector_type(4)));
typedef float f32x4 __attribute__((ext_vector_type(4)));
typedef short bf16x8 __attribute__((ext_vector_type(8)));
typedef GAS unsigned gu32;
typedef GAS unsigned long long gu64;
#define RLX_AGENT __ATOMIC_RELAXED, __HIP_MEMORY_SCOPE_AGENT
#define LDS_WAIT() asm volatile("s_waitcnt lgkmcnt(0)" ::: "memory")
#define VM_WAIT() asm volatile("s_waitcnt vmcnt(0)" ::: "memory")
__device__ __forceinline__ unsigned long long rt() { return __builtin_amdgcn_s_memrealtime(); }
__device__ __forceinline__ unsigned f2bf(float f) { unsigned u = __builtin_bit_cast(unsigned, f); return (u + 0x7fffu + ((u >> 16) & 1u)) >> 16; }
__device__ __forceinline__ unsigned pk2(float lo, float hi) { return f2bf(lo) | (f2bf(hi) << 16); }

#define XB_TMO      128
#define XB_XCNT(j)  (256  + 64 * (j))
#define XB_XSUB(j)  (1280 + 64 * (j))
#define XB_XGEN(j)  (2304 + 64 * (j))
#define XB_TOP      3328
#define XB_TOPGEN   3392
#define XCD_BAR_WORDS 3456
#define XB_SPIN_CAP (1u << 18)

__device__ __forceinline__ unsigned xb_ld(unsigned* p)              { return __hip_atomic_load(p, __ATOMIC_RELAXED, __HIP_MEMORY_SCOPE_AGENT); }
__device__ __forceinline__ unsigned xb_add(unsigned* p, unsigned v) { return __hip_atomic_fetch_add(p, v, __ATOMIC_RELAXED, __HIP_MEMORY_SCOPE_AGENT); }
__device__ __forceinline__ unsigned xb_xcc_id() { return (unsigned)__builtin_amdgcn_s_getreg((3 << 11) | 20) & 0xFu; }
#define XB_SPIN(cond, bar) do { unsigned _sp = 0; while (cond) { __builtin_amdgcn_s_sleep(1); \
    if ((++_sp & 255u) == 0u) { if (xb_ld(&(bar)[XB_TMO])) break; if (_sp > XB_SPIN_CAP) { atomicAdd(&(bar)[XB_TMO], 1u); break; } } } } while (0)

struct XcdBarrier {
    unsigned* bar; unsigned x;
    volatile LAS unsigned* st;
};

__device__ __forceinline__ XcdBarrier xcd_barrier_post(unsigned* bar, volatile LAS unsigned* st) {
    XcdBarrier b; b.bar = bar; b.x = xb_xcc_id(); b.st = st;
    if (threadIdx.x == 0) (void)xb_add(&bar[XB_XCNT(b.x)], 1u);
    return b;
}
__device__ __forceinline__ void xcd_barrier_complete(unsigned* bar, unsigned x, unsigned& nloc, unsigned& nx) {
    const unsigned G = gridDim.x * gridDim.y * gridDim.z;
    unsigned sum, cnt, mine, sp = 0u;
    for (;;) {
        sum = 0u; cnt = 0u; mine = 0u;
#pragma unroll
        for (unsigned j = 0; j < 16; ++j) { const unsigned c = xb_ld(&bar[XB_XCNT(j)]); sum += c; cnt += (c > 0u) ? 1u : 0u; mine = (j == x) ? c : mine; }
        if (sum == G) break;
        __builtin_amdgcn_s_sleep(1);
        if ((++sp & 255u) == 0u) { if (xb_ld(&bar[XB_TMO])) break; if (sp > XB_SPIN_CAP) { atomicAdd(&bar[XB_TMO], 1u); break; } }
    }
    nloc = mine > 0u ? mine : 1u; nx = cnt > 0u ? cnt : 1u;
}

__device__ __forceinline__ void xcd_barrier(const XcdBarrier& b) {
    asm volatile("s_waitcnt vmcnt(0)" ::: "memory");
    __syncthreads();
    if (threadIdx.x == 0) {
        unsigned* bar = b.bar;
        __builtin_amdgcn_s_waitcnt(0);
        unsigned nloc = b.st[0], nx = b.st[1];
        if (nloc == 0u) { xcd_barrier_complete(bar, b.x, nloc, nx); b.st[0] = nloc; b.st[1] = nx; }
        const unsigned old = xb_add(&bar[XB_XSUB(b.x)], 1u);
        const unsigned gen = old / nloc;
        if (old + 1u == (gen + 1u) * nloc) {
            __builtin_amdgcn_fence(__ATOMIC_RELEASE, "agent");
            asm volatile("s_waitcnt vmcnt(0)" ::: "memory");
            const unsigned og = xb_add(&bar[XB_TOP], 1u);
            const unsigned tg = og / nx;
            if (og + 1u == (tg + 1u) * nx) xb_add(&bar[XB_TOPGEN], 1u);
            else XB_SPIN(xb_ld(&bar[XB_TOPGEN]) == tg, bar);
            __builtin_amdgcn_fence(__ATOMIC_ACQUIRE, "agent");
            xb_add(&bar[XB_XGEN(b.x)], 1u);
            asm volatile("s_waitcnt vmcnt(0)" ::: "memory");
        } else {
            XB_SPIN(xb_ld(&bar[XB_XGEN(b.x)]) == gen, bar);
            __builtin_amdgcn_fence(__ATOMIC_ACQUIRE, "agent");
            asm volatile("s_waitcnt vmcnt(0)" ::: "memory");
        }
    }
    __syncthreads();
}

typedef float f32x16 __attribute__((ext_vector_type(16)));
typedef float f32x2 __attribute__((ext_vector_type(2)));
typedef __bf16 bf16x2_t __attribute__((ext_vector_type(2)));
typedef unsigned u32x2 __attribute__((ext_vector_type(2)));
__device__ __forceinline__ unsigned cvtpk(float lo, float hi) { f32x2 v = {lo, hi}; bf16x2_t b = __builtin_convertvector(v, bf16x2_t); return __builtin_bit_cast(unsigned, b); }
__device__ __forceinline__ float bf_lo(unsigned w) { return __builtin_bit_cast(float, w << 16); }
__device__ __forceinline__ float bf_hi(unsigned w) { return __builtin_bit_cast(float, w & 0xffff0000u); }
__device__ __forceinline__ float bf2f(unsigned short u) { return __builtin_bit_cast(float, (unsigned)u << 16); }
__device__ __forceinline__ int crow(int r, int hi) { return (r & 3) + 8 * (r >> 2) + 4 * hi; }
#define MFMA32(a, b, c) __builtin_amdgcn_mfma_f32_32x32x16_bf16((a), (b), (c), 0, 0, 0)
__device__ __forceinline__ bf16x8 pack_step(const f32x16& x, int s) {
    v4u p; p.x = cvtpk(x[8 * s], x[8 * s + 1]); p.y = cvtpk(x[8 * s + 2], x[8 * s + 3]); p.z = cvtpk(x[8 * s + 4], x[8 * s + 5]); p.w = cvtpk(x[8 * s + 6], x[8 * s + 7]);
    return __builtin_bit_cast(bf16x8, p);
}
__device__ __forceinline__ bf16x8 lds_frag2(const LAS unsigned char* p) {
    const u32x2 a = *(const LAS u32x2*)p, b = *(const LAS u32x2*)(p + 16); v4u w = {a.x, a.y, b.x, b.y}; return __builtin_bit_cast(bf16x8, w);
}
__device__ __forceinline__ float u2f(unsigned u) { return __builtin_bit_cast(float, u); }
__device__ __forceinline__ unsigned f2u(float f) { return __builtin_bit_cast(unsigned, f); }
template <int CTRL> __device__ __forceinline__ float dppf(float v) { const int x = __builtin_bit_cast(int, v); return __builtin_bit_cast(float, __builtin_amdgcn_update_dpp(x, x, CTRL, 0xF, 0xF, true)); }
template <int CTRL> __device__ __forceinline__ int dppi(int v) { return __builtin_amdgcn_update_dpp(v, v, CTRL, 0xF, 0xF, true); }
constexpr int DPP_XOR1 = 0xB1, DPP_XOR2 = 0x4E, DPP_XOR3 = 0x1B, DPP_HMIRROR = 0x141, DPP_MIRROR = 0x140, DPP_ROR8 = 0x128;
__device__ __forceinline__ float xor4f(float v) { return dppf<DPP_XOR3>(dppf<DPP_HMIRROR>(v)); }
#ifndef DBG_OLDSUM
#define DBG_OLDSUM 0
#endif
#ifndef DBG_OLDTR
#define DBG_OLDTR 0
#endif
__device__ __forceinline__ float wave_sum(float v) {
    if (DBG_OLDSUM) { for (int o = 1; o < 64; o <<= 1) v += __shfl_xor(v, o); return v; }
    v += dppf<DPP_XOR1>(v); v += dppf<DPP_XOR2>(v); v += dppf<DPP_HMIRROR>(v); v += dppf<DPP_MIRROR>(v);
    { const auto r = __builtin_amdgcn_permlane16_swap(f2u(v), f2u(v), false, false); v = u2f(r[0]) + u2f(r[1]); }
    { const auto r = __builtin_amdgcn_permlane32_swap(f2u(v), f2u(v), false, false); v = u2f(r[0]) + u2f(r[1]); }
    return v;
}
__device__ __forceinline__ float wave_max(float v) {
    if (DBG_OLDSUM) { for (int o = 1; o < 64; o <<= 1) v = fmaxf(v, __shfl_xor(v, o)); return v; }
    v = fmaxf(v, dppf<DPP_XOR1>(v)); v = fmaxf(v, dppf<DPP_XOR2>(v)); v = fmaxf(v, dppf<DPP_HMIRROR>(v)); v = fmaxf(v, dppf<DPP_MIRROR>(v));
    { const auto r = __builtin_amdgcn_permlane16_swap(f2u(v), f2u(v), false, false); v = fmaxf(u2f(r[0]), u2f(r[1])); }
    { const auto r = __builtin_amdgcn_permlane32_swap(f2u(v), f2u(v), false, false); v = fmaxf(u2f(r[0]), u2f(r[1])); }
    return v;
}
__device__ __forceinline__ int imin(int a, int b) { return a < b ? a : b; }
__device__ __forceinline__ int wave_min_i(int v) {
    if (DBG_OLDSUM) { for (int o = 1; o < 64; o <<= 1) v = imin(v, __shfl_xor(v, o)); return v; }
    v = imin(v, dppi<DPP_XOR1>(v)); v = imin(v, dppi<DPP_XOR2>(v)); v = imin(v, dppi<DPP_HMIRROR>(v)); v = imin(v, dppi<DPP_MIRROR>(v));
    { const auto r = __builtin_amdgcn_permlane16_swap((unsigned)v, (unsigned)v, false, false); v = imin((int)r[0], (int)r[1]); }
    { const auto r = __builtin_amdgcn_permlane32_swap((unsigned)v, (unsigned)v, false, false); v = imin((int)r[0], (int)r[1]); }
    return v;
}
__device__ __forceinline__ unsigned umaxu(unsigned a, unsigned b) { return a > b ? a : b; }
__device__ __forceinline__ unsigned half_max_u(unsigned v) {
    v = umaxu(v, (unsigned)dppi<DPP_XOR1>((int)v)); v = umaxu(v, (unsigned)dppi<DPP_XOR2>((int)v)); v = umaxu(v, (unsigned)dppi<DPP_HMIRROR>((int)v)); v = umaxu(v, (unsigned)dppi<DPP_MIRROR>((int)v));
    { const auto r = __builtin_amdgcn_permlane16_swap(v, v, false, false); v = umaxu(r[0], r[1]); }
    return v;
}
__device__ __forceinline__ float sum8(float v) { if (DBG_OLDSUM) { v += __shfl_xor(v, 1); v += __shfl_xor(v, 2); v += __shfl_xor(v, 4); return v; } v += dppf<DPP_XOR1>(v); v += dppf<DPP_XOR2>(v); v += dppf<DPP_HMIRROR>(v); return v; }
__device__ __forceinline__ float sum16(float v) { v = sum8(v); if (DBG_OLDSUM) { v += __shfl_xor(v, 8); return v; } v += dppf<DPP_MIRROR>(v); return v; }
template <int N, int W, int MASK> struct TRed {
    static __device__ __forceinline__ void run(float (&p)[N], int lane) {
        constexpr int half = W / 2;
#pragma unroll
        for (int i = 0; i < half; ++i) {
            if constexpr (DBG_OLDTR != 0) { const bool up = (lane & MASK) != 0; const float send = up ? p[i] : p[half + i], keep = up ? p[half + i] : p[i]; p[i] = keep + __shfl_xor(send, MASK); }
            else if constexpr (MASK == 32) { const auto r = __builtin_amdgcn_permlane32_swap(f2u(p[i]), f2u(p[half + i]), false, false); p[i] = u2f(r[0]) + u2f(r[1]); }
            else if constexpr (MASK == 16) { const auto r = __builtin_amdgcn_permlane16_swap(f2u(p[i]), f2u(p[half + i]), false, false); p[i] = u2f(r[0]) + u2f(r[1]); }
            else { const bool up = (lane & MASK) != 0; const float send = up ? p[i] : p[half + i], keep = up ? p[half + i] : p[i];
                p[i] = keep + (MASK == 8 ? dppf<DPP_ROR8>(send) : MASK == 4 ? xor4f(send) : MASK == 2 ? dppf<DPP_XOR2>(send) : dppf<DPP_XOR1>(send)); }
        }
        TRed<N, half, MASK / 2>::run(p, lane);
    }
};
template <int N, int MASK> struct TRed<N, 1, MASK> {
    static __device__ __forceinline__ void run(float (&p)[N], int) {
        if constexpr (MASK >= 1 && DBG_OLDTR != 0) { p[0] += __shfl_xor(p[0], MASK); TRed<N, 1, MASK / 2>::run(p, 0); }
        else if constexpr (MASK >= 1) { p[0] += (MASK == 8 ? dppf<DPP_ROR8>(p[0]) : MASK == 4 ? dppf<DPP_HMIRROR>(p[0]) : MASK == 2 ? dppf<DPP_XOR2>(p[0]) : dppf<DPP_XOR1>(p[0])); TRed<N, 1, MASK / 2>::run(p, 0); }
    }
};
template <int N> __device__ __forceinline__ float treduce(float (&p)[N], int lane) { TRed<N, N, 32>::run(p, lane); return p[0]; }

struct Frame {
    LAS unsigned char* lds;
    volatile LAS unsigned* MISC;
    gu32* ctl;
    unsigned char* ws;
    const void* const* in;
    float* out;
    int wave, vcu, G;
};
__device__ __forceinline__ int ftid_l() { int t = (int)threadIdx.x; asm volatile("" : "+v"(t)); return t; }
#define FTID ftid_l()
#define FLANE (ftid_l() & 63)
#define WSP(type, off) ((type*)(F.ws + (off)))

__device__ __forceinline__ int map_row(int mode, int n) {
    if (mode == 1) return ((n & 1023) >> 7) * 256 + (n >> 10) * 128 + (n & 127);
    if (mode == 2) return (n & ~255) + ((n >> 5) & 1) * 128 + ((n >> 6) & 3) * 32 + (n & 31);
    return n;
}
__device__ __forceinline__ void p0_transpose_item(const float* W, int K, int ldw, int ncols, bf16* WT, int col_off, int mode, LAS float* scr, int item, int lane) {
    const int nblk = ncols / 64, kb = item / nblk, nb = item % nblk, k0 = 64 * kb, n0 = 64 * nb;
    float tv[64];
    const float* wp = W + (size_t)k0 * ldw + n0 + lane;
#pragma unroll
    for (int i = 0; i < 64; ++i) tv[i] = wp[(size_t)i * ldw];
#pragma unroll
    for (int i = 0; i < 64; ++i) scr[i * 65 + lane] = tv[i];
    LDS_WAIT(); asm volatile("" ::: "memory");
    const int c = lane & 7;
#pragma unroll
    for (int j = 0; j < 8; ++j) { const int n = (lane >> 3) + 8 * j; const LAS float* s = scr + (8 * c) * 65 + n;
        v4u o; o.x = pk2(s[0 * 65], s[1 * 65]); o.y = pk2(s[2 * 65], s[3 * 65]); o.z = pk2(s[4 * 65], s[5 * 65]); o.w = pk2(s[6 * 65], s[7 * 65]);
        *(GAS v4u*)(WT + (size_t)map_row(mode, col_off + n0 + n) * K + k0 + 8 * c) = o; }
    LDS_WAIT(); asm volatile("" ::: "memory");
}
__device__ __forceinline__ void p0_q8_item(Frame& F, const float* Wm, int ldw, int fcol0, int mode, signed char* WQ0, float* scp, int tile, LAS float* scr, int it) {
    const int lane = FLANE, kb = it >> 2, nb = it & 3, k0 = 64 * kb, n0 = 64 * nb;
    float ss = 0.f;
    {   f32x4 v[8];
#pragma unroll
        for (int i = 0; i < 8; ++i) v[i] = *(const f32x4*)(Wm + (size_t)(128 * i) * ldw + lane * 4);
#pragma unroll
        for (int i = 0; i < 8; ++i) ss += (v[i].x * v[i].x + v[i].y * v[i].y) + (v[i].z * v[i].z + v[i].w * v[i].w); }
    ss = wave_sum(ss);
    const float sc = 4.0f * sqrtf(ss * (1.0f / 2048.0f)) * (1.0f / 127.0f), inv = 1.0f / sc;
    if (it == 0 && lane == 0) scp[tile] = sc;
    float tv[64]; const float* wp = Wm + (size_t)k0 * ldw + n0 + lane;
#pragma unroll
    for (int i = 0; i < 64; ++i) tv[i] = wp[(size_t)i * ldw];
#pragma unroll
    for (int i = 0; i < 64; ++i) scr[i * 65 + lane] = tv[i];
    LDS_WAIT(); asm volatile("" ::: "memory");
    const int c = lane & 3;
#pragma unroll
    for (int j = 0; j < 4; ++j) { const int n = (lane >> 2) + 16 * j; const LAS float* sp = scr + (16 * c) * 65 + n; unsigned w4[4];
#pragma unroll
        for (int g = 0; g < 4; ++g) w4[g] = pack4_i8(sp[(4 * g) * 65] * inv, sp[(4 * g + 1) * 65] * inv, sp[(4 * g + 2) * 65] * inv, sp[(4 * g + 3) * 65] * inv);
        *(GAS v4u*)(WQ0 + (size_t)map_row(mode, fcol0 + n0 + n) * 1024 + k0 + 16 * c) = (v4u){w4[0], w4[1], w4[2], w4[3]}; }
    LDS_WAIT(); asm volatile("" ::: "memory");
}
__device__ __forceinline__ void p0_prologue(Frame& F) {
    const int gw = F.vcu * NWAVES + F.wave, NGW = F.G * NWAVES;
    {
        LAS float* scr = (LAS float*)(F.lds + F.wave * 16896);
        const float* a_w_in = (const float*)F.in[2]; const float* a_w_out = (const float*)F.in[6]; const float* kv_w = (const float*)F.in[7]; const float* b_w_q = (const float*)F.in[8];
        const float* b_w_out = (const float*)F.in[11]; const float* w_gu = (const float*)F.in[18]; const float* w_dn = (const float*)F.in[20];
        {
            constexpr int NI_GU = 64 * 512, NI_DN = 64 * 256;
            const int lane = FLANE, half = lane >> 5, l32 = lane & 31;
            for (int gi = gw; gi < NI_GU + NI_DN; gi += NGW) {
                const bool dn = gi >= NI_GU; const int gj = dn ? gi - NI_GU : gi;
                const int m = dn ? gj >> 8 : gj >> 9, r = dn ? gj & 255 : gj & 511, NW_ = dn ? 1024 : 2048, kb2 = dn ? r >> 5 : r >> 6, nb = dn ? r & 31 : r & 63, k0 = 128 * kb2, n0 = 32 * nb;
                const float* Wm = dn ? w_dn + (size_t)m * 1024 * 1024 : w_gu + (size_t)m * 1024 * 2048;
                f32x4 sv[8];
#pragma unroll
                for (int i = 0; i < 8; ++i) sv[i] = *(const f32x4*)(Wm + (size_t)(128 * i) * NW_ + 4 * lane);
                float tv[64]; const float* wp = Wm + (size_t)(k0 + half) * NW_ + n0 + l32;
#pragma unroll
                for (int i = 0; i < 64; ++i) tv[i] = __builtin_nontemporal_load(&wp[(size_t)(2 * i) * NW_]);
                float ss = 0.f;
#pragma unroll
                for (int i = 0; i < 8; ++i) ss += (sv[i].x * sv[i].x + sv[i].y * sv[i].y) + (sv[i].z * sv[i].z + sv[i].w * sv[i].w);
                const float rmsw = sqrtf(wave_sum(ss) * (1.0f / 2048.0f)), sc = 4.0f * rmsw * (1.0f / 127.0f), inv = 1.0f / sc;
                if (r == 0) {
                    if (dn) { if (lane == 0) WSP(float, WS_SWD)[m] = sc; }
                    else { const int layer = m >> 5; const float* lg1 = (const float*)F.in[12] + layer * D; const float* lb1 = (const float*)F.in[13] + layer * D; float sx = 0.f;
#pragma unroll
                        for (int i = 0; i < 4; ++i) { const f32x4 g_ = *((const f32x4*)lg1 + lane + 64 * i), b_ = *((const f32x4*)lb1 + lane + 64 * i); sx += (g_.x * g_.x + g_.y * g_.y) + (g_.z * g_.z + g_.w * g_.w) + (b_.x * b_.x + b_.y * b_.y) + (b_.z * b_.z + b_.w * b_.w); }
                        sx = wave_sum(sx);
                        if (lane == 0) { WSP(float, WS_SWQ)[m] = sc; WSP(float, WS_SACT)[m] = 10.0f * (32.0f * rmsw * sqrtf(sx * (1.0f / 1024.0f))) * (1.0f / 127.0f); } } }
                signed char* WQ = dn ? (signed char*)WSP(unsigned char, WS_WD) + (size_t)m * 1024 * 1024 : (signed char*)WSP(unsigned char, WS_WGU) + (size_t)m * 2048 * 1024;
#pragma unroll
                for (int i = 0; i < 64; ++i) scr[(2 * i + half) * 33 + l32] = tv[i];
                LDS_WAIT(); asm volatile("" ::: "memory");
                const int c = lane >> 3;
#pragma unroll
                for (int j = 0; j < 4; ++j) { const int n = (lane & 7) + 8 * j; const LAS float* sp = scr + (16 * c) * 33 + n; unsigned w4[4];
#pragma unroll
                    for (int g = 0; g < 4; ++g) w4[g] = pack4_i8(sp[(4 * g) * 33] * inv, sp[(4 * g + 1) * 33] * inv, sp[(4 * g + 2) * 33] * inv, sp[(4 * g + 3) * 33] * inv);
                    *(GAS v4u*)(WQ + (size_t)(dn ? n0 + n : map_row(1, n0 + n)) * 1024 + k0 + 16 * c) = (v4u){w4[0], w4[1], w4[2], w4[3]}; }
                LDS_WAIT(); asm volatile("" ::: "memory"); }
        }
        for (int task = (int)blockIdx.x; task < 256; task += F.G) { const int item = task * 8 + F.wave, tile = item >> 6, it_ = item & 63;
            if (tile >= 28) { p0_q8_item(F, b_w_out + (tile - 28) * 256, 1024, (tile - 28) * 256, 0, (signed char*)WSP(unsigned char, WS_WBO), WSP(float, WS_SWBO), tile - 28, scr, it_); continue; }
            if (tile >= 24) { p0_q8_item(F, a_w_out + (tile - 24) * 256, 1024, (tile - 24) * 256, 0, (signed char*)WSP(unsigned char, WS_WAO), WSP(float, WS_SWAO), tile - 24, scr, it_); continue; }
            if (tile < 12) p0_q8_item(F, a_w_in + tile * 256, LDW_IN, tile * 256, 0, (signed char*)WSP(unsigned char, WS_WIN), WSP(float, WS_SWIN), tile, scr, it_);
            else if (tile < 20) p0_q8_item(F, kv_w + (tile - 12) * 256, 2048, (tile - 12) * 256, 2, (signed char*)WSP(unsigned char, WS_WKVQ), WSP(float, WS_SWKVQ), tile - 12, scr, it_);
            else p0_q8_item(F, b_w_q + (tile - 20) * 256, 1024, 2048 + (tile - 20) * 256, 2, (signed char*)WSP(unsigned char, WS_WKVQ), WSP(float, WS_SWKVQ), tile - 12, scr, it_); }
    }
    __syncthreads();
    {
        const float* a_w_in = (const float*)F.in[2]; const float* x = (const float*)F.in[0];
        LAS float* Wgl = (LAS float*)F.lds;
        for (int idx = FTID; idx < 1024 * 16; idx += NTHR) { const int k = idx >> 4, c = idx & 15, l = (k & 255) >> 2, jc = (k >> 8) * 4 + (k & 3);
            Wgl[(jc * 64 + l) * 20 + c] = a_w_in[(size_t)k * LDW_IN + NQKVR + c]; }
        __syncthreads();
        bf16* XB = WSP(bf16, WS_XB); float* GK = WSP(float, WS_GKLOW);
        f32x4 rn[4], v[4];
        const int mlast = gw < T ? gw + ((T - 1 - gw) / NGW) * NGW : 0;
#define P0B_FETCH(M) do { const GAS f32x4* xr_ = (const GAS f32x4*)(x + (size_t)(M) * D) + FLANE; _Pragma("unroll") for (int j = 0; j < 4; ++j) rn[j] = xr_[64 * j]; } while (0)
#define P0B_TAKE() do { _Pragma("unroll") for (int j = 0; j < 4; ++j) { asm volatile("" : "+v"(rn[j])); v[j] = rn[j]; } } while (0)
        if (gw < T) { P0B_FETCH(gw); P0B_TAKE(); }
#pragma unroll 1
        for (int m = gw; m < T; m += NGW) {
            asm volatile("" ::: "memory");
            P0B_FETCH(imin(m + NGW, mlast));
            GAS unsigned long long* o8 = (GAS unsigned long long*)(XB + (size_t)m * D) + FLANE;
            float am = 0.f;
#pragma unroll
            for (int j = 0; j < 4; ++j) { o8[64 * j] = (unsigned long long)cvtpk(v[j].x, v[j].y) | ((unsigned long long)cvtpk(v[j].z, v[j].w) << 32);
                am = fmaxf(fmaxf(am, fmaxf(fabsf(v[j].x), fabsf(v[j].y))), fmaxf(fabsf(v[j].z), fabsf(v[j].w))); }
            am = fmaxf(wave_max(am), 1e-20f);
            {   const float qi = 127.0f / am; GAS unsigned* q8 = (GAS unsigned*)((signed char*)WSP(unsigned char, WS_X1Q) + (size_t)m * D) + FLANE;
#pragma unroll
                for (int j = 0; j < 4; ++j) q8[64 * j] = pack4_i8(v[j].x * qi, v[j].y * qi, v[j].z * qi, v[j].w * qi);
                WSP(float, WS_SX)[m] = am * (1.0f / 127.0f); }
            float p[16];
#pragma unroll
            for (int c = 0; c < 16; ++c) p[c] = 0.f;
#pragma unroll
            for (int j = 0; j < 4; ++j)
#pragma unroll
                for (int cc = 0; cc < 4; ++cc) { const float xv = v[j][cc]; const LAS f32x4* wp = (const LAS f32x4*)(Wgl + ((j * 4 + cc) * 64 + FLANE) * 20);
#pragma unroll
                    for (int q = 0; q < 4; ++q) { const f32x4 w = wp[q]; p[4 * q] += xv * w.x; p[4 * q + 1] += xv * w.y; p[4 * q + 2] += xv * w.z; p[4 * q + 3] += xv * w.w; } }
            const float r = treduce<16>(p, FLANE);
            GK[(size_t)m * 16 + (FLANE >> 2)] = r;
            asm volatile("" ::: "memory");
            P0B_TAKE();
        }
#undef P0B_FETCH
#undef P0B_TAKE
    }
    if (blockIdx.x == 0 && FTID < 128) WSP(float, WS_SUBW)[FTID] = ((const float*)F.in[10])[FTID] * (1.0f - LAMBDA_INIT);
    {
        const int* pos = (const int*)F.in[1]; float* CT = WSP(float, WS_COS); float* ST = WSP(float, WS_SIN);
        for (int idx = F.vcu * NTHR + FTID; idx < T * 32; idx += F.G * NTHR) { const int row = idx >> 5, i = idx & 31;
            const float inv = exp2f(-(float)i * 0.41524101186092029f); const float ang = (float)pos[row] * inv;
            const double rev = (double)ang * 0.15915494309189535; const float fr = (float)(rev - floor(rev));
            CT[idx] = __builtin_amdgcn_cosf(fr); ST[idx] = __builtin_amdgcn_sinf(fr); }
    }
    __syncthreads();
}

constexpr int QROW = 272, KSTROW = 320, VROW = 576;
constexpr int G1_QRAW = 0, G1_KRAW = 17408, G1_QIN = 34816, G1_KIN = 52224, G1_KST = 69632, G1_VT = 90112, G1_GK = 126976, G1_SEG = 131072, G1_DEC = 135168, G1_W2 = 135680;
__device__ __forceinline__ bf16x8 tr_frag(const LAS unsigned char* p0, const LAS unsigned char* p1) {
    typedef short v4s __attribute__((ext_vector_type(4)));
    const v4s a = __builtin_amdgcn_ds_read_tr16_b64_v4i16((LAS v4s*)p0), b = __builtin_amdgcn_ds_read_tr16_b64_v4i16((LAS v4s*)p1);
    return (bf16x8){a[0], a[1], a[2], a[3], b[0], b[1], b[2], b[3]};
}
__device__ __forceinline__ void gla_stage1(Frame& F) {
    const float* w_gk2 = (const float*)F.in[3]; const float* b_gk = (const float*)F.in[4];
    const bf16* QKVR = WSP(bf16, WS_QKVR); const float* GKL = WSP(float, WS_GKLOW);
    bf16* OLOC = WSP(bf16, WS_OLOC); bf16* QDEC = WSP(bf16, WS_QDEC); float* SEND = WSP(float, WS_SEND); float* GSUM = WSP(float, WS_GSUM);
    LAS unsigned char* L = F.lds;
    const int w = F.wave;
    for (int u = blockIdx.x; u < GLA_UNITS; u += F.G) {
        int tid_ = FTID; asm volatile("" : "+v"(tid_));
        const int tid = tid_, lane = tid & 63, r = lane & 31, hh = lane >> 5;
        const int dp = tid & 63, sg = w;
        const int trq = (lane & 15) >> 2, trc = 16 * ((lane >> 4) & 1) + 4 * (lane & 3);
        const LAS unsigned char* vtp = L + G1_VT + (trq + 4 * hh) * VROW + (32 * w + trc) * 2;
        const LAS unsigned char* vtn = L + G1_VT + (trq + 8 * hh) * VROW + (32 * w + trc) * 2;
        const LAS unsigned char* ksn = L + G1_KST + (trq + 8 * hh) * KSTROW + trc * 2;
        const int b = u >> 6, h = (u >> 4) & 3, run = u & 15; const size_t t0 = (size_t)b * SEQ + (size_t)run * (GLA_C * GLA_RUN);
        __syncthreads();
        for (int idx = tid; idx < 16 * 128; idx += NTHR) *(LAS float*)(L + G1_W2 + idx * 4) = w_gk2[(idx >> 7) * 512 + h * 128 + (idx & 127)];
        const f32x2 bg2 = *(const f32x2*)(b_gk + h * 128 + 2 * dp);
        float cuma = 0.f, cumb = 0.f;
        f32x16 S[4];
#pragma unroll
        for (int t = 0; t < 4; ++t) S[t] = f32x16{};
        v4u pq[2], pk[2], pv[4]; f32x4 pg;
#define G1_FETCH(r0_) do { \
            _Pragma("unroll") for (int q_ = 0; q_ < 2; ++q_) { const int idx = tid + NTHR * q_, row = idx >> 4, ch = idx & 15; const bf16* src = QKVR + ((r0_) + row) * NQKVR + h * 128 + ch * 8; pq[q_] = *(const v4u*)src; pk[q_] = *(const v4u*)(src + 512); } \
            _Pragma("unroll") for (int q_ = 0; q_ < 4; ++q_) { const int idx = tid + NTHR * q_, row = idx >> 5, ch = idx & 31; pv[q_] = *(const v4u*)(QKVR + ((r0_) + row) * NQKVR + 1024 + h * 256 + ch * 8); } \
            if (tid < 256) pg = *(const f32x4*)(GKL + ((r0_) + (tid >> 2)) * 16 + (tid & 3) * 4); } while (0)
#define G1_COMMIT() do { \
            _Pragma("unroll") for (int q_ = 0; q_ < 2; ++q_) { const int idx = tid + NTHR * q_, row = idx >> 4, ch = idx & 15; *(LAS v4u*)(L + G1_QRAW + row * QROW + ch * 16) = pq[q_]; *(LAS v4u*)(L + G1_KRAW + row * QROW + ch * 16) = pk[q_]; } \
            _Pragma("unroll") for (int q_ = 0; q_ < 4; ++q_) { const int idx = tid + NTHR * q_, row = idx >> 5, ch = idx & 31; *(LAS v4u*)(L + G1_VT + row * VROW + ch * 16) = pv[q_]; } \
            if (tid < 256) *(LAS f32x4*)(L + G1_GK + ((tid >> 2) * 16 + (tid & 3) * 4) * 4) = pg; } while (0)
        G1_FETCH(t0);
        for (int c = 0; c < GLA_RUN; ++c) {
            const size_t r0 = t0 + (size_t)c * GLA_C;
            G1_COMMIT();
            __syncthreads();
            float Ga[8], Gb[8]; float rsa = 0.f, rsb = 0.f;
            float w2a[16], w2b[16];
#pragma unroll
            for (int k = 0; k < 16; ++k) { const f32x2 t = *(const LAS f32x2*)(L + G1_W2 + (k * 128 + 2 * dp) * 4); w2a[k] = t.x; w2b[k] = t.y; }
#pragma unroll
            for (int ii = 0; ii < 8; ++ii) { const LAS f32x4* gp = (const LAS f32x4*)(L + G1_GK + (8 * sg + ii) * 64);
                float za = bg2.x, zb = bg2.y;
#pragma unroll
                for (int q = 0; q < 4; ++q) { const f32x4 g = gp[q];
                    za += g.x * w2a[4 * q] + g.y * w2a[4 * q + 1] + g.z * w2a[4 * q + 2] + g.w * w2a[4 * q + 3];
                    zb += g.x * w2b[4 * q] + g.y * w2b[4 * q + 1] + g.z * w2b[4 * q + 2] + g.w * w2b[4 * q + 3]; }
                rsa += (fminf(za, 0.f) - __logf(1.0f + __expf(-fabsf(za)))) * (1.0f / 16.0f); Ga[ii] = rsa;
                rsb += (fminf(zb, 0.f) - __logf(1.0f + __expf(-fabsf(zb)))) * (1.0f / 16.0f); Gb[ii] = rsb; }
            *(LAS f32x2*)(L + G1_SEG + (sg * 128 + 2 * dp) * 4) = (f32x2){rsa, rsb};
            __syncthreads();
            float offa = 0.f, offb = 0.f, gla = 0.f, glb = 0.f;
#pragma unroll
            for (int s2 = 0; s2 < 8; ++s2) { const f32x2 sv = *(const LAS f32x2*)(L + G1_SEG + (s2 * 128 + 2 * dp) * 4); gla += sv.x; glb += sv.y; if (s2 < sg) { offa += sv.x; offb += sv.y; } }
            const float eca = __expf(cuma), ecb = __expf(cumb);
#pragma unroll
            for (int ii = 0; ii < 8; ++ii) { const int i = 8 * sg + ii;
                const unsigned qw = *(const LAS unsigned*)(L + G1_QRAW + i * QROW + dp * 4), kw = *(const LAS unsigned*)(L + G1_KRAW + i * QROW + dp * 4);
                const float Gxa = Ga[ii] + offa, Gxb = Gb[ii] + offb;
                const float qia = bf_lo(qw) * 0.08838834764831845f * __expf(Gxa), qib = bf_hi(qw) * 0.08838834764831845f * __expf(Gxb);
                const float ka = bf_lo(kw), kb = bf_hi(kw);
                *(LAS unsigned*)(L + G1_QIN + i * QROW + dp * 4) = cvtpk(qia, qib);
                *(LAS unsigned*)(L + G1_KIN + i * QROW + dp * 4) = cvtpk(ka * __expf(-Gxa), kb * __expf(-Gxb));
                *(LAS unsigned*)(L + G1_KST + i * KSTROW + dp * 4) = cvtpk(ka * __expf(gla - Gxa), kb * __expf(glb - Gxb));
                *(LAS unsigned*)(L + G1_QRAW + i * QROW + dp * 4) = cvtpk(qia * eca, qib * ecb); }
            if (sg == 0) *(LAS f32x2*)(L + G1_DEC + 2 * dp * 4) = (f32x2){__expf(gla), __expf(glb)};
            cuma += gla; cumb += glb;
            __syncthreads();
#pragma unroll
            for (int q_ = 0; q_ < 2; ++q_) { const int idx = tid + NTHR * q_, row = idx >> 4, ch = idx & 15; *(v4u*)(QDEC + (r0 + row) * 512 + h * 128 + ch * 8) = *(const LAS v4u*)(L + G1_QRAW + row * QROW + ch * 16); }
            if (c + 1 < GLA_RUN) G1_FETCH(r0 + GLA_C);
            f32x16 X00 = f32x16{}, X01 = f32x16{}, X11 = f32x16{};
#pragma unroll
            for (int s = 0; s < 8; ++s) { const int ko = (16 * s + 8 * hh) * 2;
                const bf16x8 aK0 = *(const LAS bf16x8*)(L + G1_KIN + r * QROW + ko), aK1 = *(const LAS bf16x8*)(L + G1_KIN + (32 + r) * QROW + ko);
                const bf16x8 bQ0 = *(const LAS bf16x8*)(L + G1_QIN + r * QROW + ko), bQ1 = *(const LAS bf16x8*)(L + G1_QIN + (32 + r) * QROW + ko);
                X00 = MFMA32(aK0, bQ0, X00); X01 = MFMA32(aK0, bQ1, X01); X11 = MFMA32(aK1, bQ1, X11);
                if (s & 1) asm volatile("" ::: "memory"); }
#pragma unroll
            for (int q = 0; q < 16; ++q) { const bool keep = crow(q, hh) <= r; X00[q] = keep ? X00[q] : 0.f; X11[q] = keep ? X11[q] : 0.f; }
            f32x16 o0 = f32x16{}, o1 = f32x16{};
#pragma unroll
            for (int s = 0; s < 2; ++s) { const bf16x8 v0 = tr_frag(vtp + (16 * s) * VROW, vtp + (16 * s + 8) * VROW), v1 = tr_frag(vtp + (32 + 16 * s) * VROW, vtp + (32 + 16 * s + 8) * VROW);
                o0 = MFMA32(pack_step(X00, s), v0, o0); o1 = MFMA32(pack_step(X01, s), v0, o1); o1 = MFMA32(pack_step(X11, s), v1, o1); }
            asm volatile("" ::: "memory");
#pragma unroll
            for (int t = 0; t < 4; ++t) {
#pragma unroll
                for (int s = 0; s < 2; ++s) { const bf16x8 xs = pack_step(S[t], s); const int doff = (32 * t + 16 * s + 4 * hh) * 2;
                    o0 = MFMA32(lds_frag2(L + G1_QIN + r * QROW + doff), xs, o0); o1 = MFMA32(lds_frag2(L + G1_QIN + (32 + r) * QROW + doff), xs, o1); }
                asm volatile("" ::: "memory"); }
            {   bf16* op = OLOC + (r0 + 4 * hh) * D + h * 256 + 32 * w + r;
#pragma unroll
                for (int q = 0; q < 16; ++q) { const int rr = (q & 3) + 8 * (q >> 2); op[(size_t)rr * D] = (bf16)cvtpk(o0[q], 0.f); op[(size_t)(32 + rr) * D] = (bf16)cvtpk(o1[q], 0.f); } }
#pragma unroll
            for (int t = 0; t < 4; ++t) {
#pragma unroll
                for (int g = 0; g < 4; ++g) { const f32x4 dv = *(const LAS f32x4*)(L + G1_DEC + (32 * t + 8 * g + 4 * hh) * 4);
                    S[t][4 * g] *= dv.x; S[t][4 * g + 1] *= dv.y; S[t][4 * g + 2] *= dv.z; S[t][4 * g + 3] *= dv.w; }
#pragma unroll
                for (int s = 0; s < 4; ++s)
                    S[t] = MFMA32(tr_frag(ksn + (16 * s) * KSTROW + 64 * t, ksn + (16 * s + 4) * KSTROW + 64 * t), tr_frag(vtn + (16 * s) * VROW, vtn + (16 * s + 4) * VROW), S[t]);
                asm volatile("" ::: "memory");
            }
            __syncthreads();
        }
#undef G1_FETCH
#undef G1_COMMIT
        {   float* sp = SEND + ((size_t)u * 256 + 32 * w + r) * 128 + 4 * hh;
#pragma unroll
            for (int t = 0; t < 4; ++t)
#pragma unroll
                for (int g = 0; g < 4; ++g) *(f32x4*)(sp + 32 * t + 8 * g) = (f32x4){S[t][4 * g], S[t][4 * g + 1], S[t][4 * g + 2], S[t][4 * g + 3]}; }
        if (sg == 0) *(f32x2*)(GSUM + u * 128 + 2 * dp) = (f32x2){cuma, cumb};
    }
}
__device__ __forceinline__ void gla_stage2(Frame& F) {
    const float* SEND = WSP(float, WS_SEND); const float* GSUM = WSP(float, WS_GSUM); bf16* SINIT = WSP(bf16, WS_SINIT);
    for (int gid = F.vcu * NTHR + FTID; gid < NB * GLA_H * 8192; gid += F.G * NTHR) {
        const int bh = gid >> 13, e4 = gid & 8191, d4 = (e4 & 31) * 4; const size_t eo = (size_t)(e4 >> 5) * 128 + d4;
        f32x4 S = {0.f, 0.f, 0.f, 0.f};
        for (int run = 0; run < GLA_NRUN; ++run) { const int u = bh * GLA_NRUN + run;
            *(u32x2*)(SINIT + (size_t)u * 32768 + eo) = (u32x2){cvtpk(S.x, S.y), cvtpk(S.z, S.w)};
            const f32x4 g = *(const f32x4*)(GSUM + u * 128 + d4), e = *(const f32x4*)(SEND + (size_t)u * 32768 + eo);
            S.x = S.x * __expf(g.x) + e.x; S.y = S.y * __expf(g.y) + e.y; S.z = S.z * __expf(g.z) + e.z; S.w = S.w * __expf(g.w) + e.w; }
    }
}
constexpr int G3_SL = 0, G3_QD = 69632, G3_OT = 87040, OTROW = 260, G3_NW = 153600;
__device__ __forceinline__ void gla_stage3(Frame& F) {
    const float* norm_w = (const float*)F.in[5];
    const bf16* QKVR = WSP(bf16, WS_QKVR); const bf16* OLOC = WSP(bf16, WS_OLOC); const bf16* QDEC = WSP(bf16, WS_QDEC); const bf16* SINIT = WSP(bf16, WS_SINIT); bf16* OG = WSP(bf16, WS_OG);
    LAS unsigned char* L = F.lds;
    const int tid = FTID, lane = FLANE, w = F.wave, r = lane & 31, hh = lane >> 5;
    const int nrow = tid >> 3, part = tid & 7;
    if (tid < 256) ((LAS float*)(L + G3_NW))[tid] = norm_w[tid];
    for (int u = blockIdx.x; u < GLA_UNITS; u += F.G) {
        const int b = u >> 6, h = (u >> 4) & 3, run = u & 15; const size_t t0 = (size_t)b * SEQ + (size_t)run * (GLA_C * GLA_RUN);
        __syncthreads();
#pragma unroll
        for (int q = 0; q < 8; ++q) { const int idx = tid + NTHR * q, row = idx >> 4, ch = idx & 15;
            *(LAS v4u*)(L + G3_SL + row * QROW + ch * 16) = *(const v4u*)(SINIT + (size_t)u * 32768 + row * 128 + ch * 8); }
        v4u qd[2];
#define G3_QFETCH(C) do { const size_t r0_ = t0 + (size_t)(C) * GLA_C; _Pragma("unroll") for (int q = 0; q < 2; ++q) { const int idx = tid + NTHR * q, row = idx >> 4, ch = idx & 15; \
            qd[q] = *(const v4u*)(QDEC + (r0_ + row) * 512 + h * 128 + ch * 8); } } while (0)
        G3_QFETCH(0);
#pragma unroll
        for (int q = 0; q < 2; ++q) asm volatile("" : "+v"(qd[q]));
#pragma unroll 1
        for (int c = 0; c < GLA_RUN; ++c) {
            const size_t r0 = t0 + (size_t)c * GLA_C;
#pragma unroll
            for (int q = 0; q < 2; ++q) { const int idx = tid + NTHR * q, row = idx >> 4, ch = idx & 15; *(LAS v4u*)(L + G3_QD + row * QROW + ch * 16) = qd[q]; }
            v4u ol[4], rgv[4];
            {   const v4u* op = (const v4u*)(OLOC + (r0 + nrow) * D + h * 256 + part * 32); const v4u* rp = (const v4u*)(QKVR + (r0 + nrow) * NQKVR + 2048 + h * 256 + part * 32);
#pragma unroll
                for (int q = 0; q < 4; ++q) { ol[q] = op[q]; rgv[q] = rp[q]; } }
            G3_QFETCH(c + 1 < GLA_RUN ? c + 1 : c);
            __syncthreads();
            f32x16 o0 = f32x16{}, o1 = f32x16{};
#pragma unroll
            for (int s = 0; s < 8; ++s) { const int ko = (16 * s + 8 * hh) * 2;
                const bf16x8 bS = *(const LAS bf16x8*)(L + G3_SL + (32 * w + r) * QROW + ko);
                o0 = MFMA32(*(const LAS bf16x8*)(L + G3_QD + r * QROW + ko), bS, o0); o1 = MFMA32(*(const LAS bf16x8*)(L + G3_QD + (32 + r) * QROW + ko), bS, o1); }
            {   LAS float* ot = (LAS float*)(L + G3_OT) + (4 * hh) * OTROW + 32 * w + r;
#pragma unroll
                for (int q = 0; q < 16; ++q) { const int rr = (q & 3) + 8 * (q >> 2); ot[rr * OTROW] = o0[q]; ot[(32 + rr) * OTROW] = o1[q]; } }
            __syncthreads();
            {   const LAS f32x4* orow = (const LAS f32x4*)((LAS float*)(L + G3_OT) + nrow * OTROW + part * 32);
                f32x4 x[8]; float ss = 0.f;
#pragma unroll
                for (int q = 0; q < 4; ++q) { const v4u ov_ = ol[q];
                    x[2 * q] = orow[2 * q] + (f32x4){bf_lo(ov_.x), bf_hi(ov_.x), bf_lo(ov_.y), bf_hi(ov_.y)}; x[2 * q + 1] = orow[2 * q + 1] + (f32x4){bf_lo(ov_.z), bf_hi(ov_.z), bf_lo(ov_.w), bf_hi(ov_.w)}; }
#pragma unroll
                for (int q = 0; q < 8; ++q) ss += (x[q].x * x[q].x + x[q].y * x[q].y) + (x[q].z * x[q].z + x[q].w * x[q].w);
                ss = sum8(ss);
                const float rstd = 1.0f / sqrtf(ss * (1.0f / 256.0f) + RMS_EPS);
                v4u* gp = (v4u*)((signed char*)OG + (r0 + nrow) * D + h * 256 + part * 32);
                unsigned qw[8]; const LAS f32x4* nwp = (const LAS f32x4*)(L + G3_NW) + part * 8;
#pragma unroll
                for (int q = 0; q < 4; ++q) { const v4u rv = rgv[q]; const f32x4 nwa = nwp[2 * q], nwb = nwp[2 * q + 1]; float rg[8] = {bf_lo(rv.x), bf_hi(rv.x), bf_lo(rv.y), bf_hi(rv.y), bf_lo(rv.z), bf_hi(rv.z), bf_lo(rv.w), bf_hi(rv.w)}; float ov[8];
#pragma unroll
                    for (int e = 0; e < 8; ++e) { const float xv = x[2 * q + (e >> 2)][e & 3], nv = (e >> 2) ? nwb[e & 3] : nwa[e & 3]; ov[e] = xv * rstd * nv * (rg[e] * __builtin_amdgcn_rcpf(1.0f + __expf(-rg[e]))); }
                    qw[2 * q] = pack4_i8(ov[0] * (1.0f / OG_QS), ov[1] * (1.0f / OG_QS), ov[2] * (1.0f / OG_QS), ov[3] * (1.0f / OG_QS)); qw[2 * q + 1] = pack4_i8(ov[4] * (1.0f / OG_QS), ov[5] * (1.0f / OG_QS), ov[6] * (1.0f / OG_QS), ov[7] * (1.0f / OG_QS)); }
                gp[0] = (v4u){qw[0], qw[1], qw[2], qw[3]}; gp[1] = (v4u){qw[4], qw[5], qw[6], qw[7]};
            }
            __syncthreads();
#pragma unroll
            for (int q = 0; q < 2; ++q) asm volatile("" : "+v"(qd[q]));
        }
#undef G3_QFETCH
    }
}

constexpr int RT_RS = 2064;
constexpr int RT_TILE = 2 * 16 * RT_RS;
constexpr int RT_PP = 2 * RT_TILE;
constexpr int RT_LCNT = RT_PP + 2 * 4 * 16 * 32 * 4, RT_STG = RT_LCNT + 128;
static_assert(RT_STG + 128 * 4 + 3 * 512 * 4 <= PHASE_LDS, "router LDS");
__device__ __forceinline__ void moe_router(Frame& F, int layer) {
    const bf16* Y = WSP(bf16, WS_Y); bf16* X1B = WSP(bf16, WS_X1B); signed char* X1Q = (signed char*)WSP(unsigned char, WS_X1Q); float* SX = WSP(float, WS_SX);
    const float* lg = (const float*)F.in[12] + layer * D; const float* lb = (const float*)F.in[13] + layer * D;
    const float* Wr = (const float*)F.in[16] + (size_t)layer * D * NE; const float* br = (const float*)F.in[17] + layer * NE;
    int* TOPI = WSP(int, WS_TOPI); float* TOPG = WSP(float, WS_TOPG); int* LRANK = WSP(int, WS_LRANK); int* CNT = WSP(int, WS_CNT);
    LAS unsigned char* L = F.lds; LAS int* lcnt = (LAS int*)(F.lds + RT_LCNT);
    const int lane = FLANE, w = F.wave, ks = w >> 1, nt = w & 1, kg = lane >> 4, i16 = lane & 15;
    if (FTID < NE) lcnt[FTID] = 0;
    bf16x8 Bh[8], Bl[8];
#pragma unroll
    for (int s_ = 0; s_ < 8; ++s_) { const float* wp = Wr + (size_t)(256 * ks + 32 * s_ + 8 * kg) * NE + 16 * nt + i16; float wv[8];
#pragma unroll
        for (int t = 0; t < 8; ++t) wv[t] = wp[t * NE];
        unsigned h[4], l[4];
#pragma unroll
        for (int p = 0; p < 4; ++p) { h[p] = cvtpk(wv[2 * p], wv[2 * p + 1]); l[p] = cvtpk(wv[2 * p] - bf_lo(h[p]), wv[2 * p + 1] - bf_hi(h[p])); }
        Bh[s_] = __builtin_bit_cast(bf16x8, (v4u){h[0], h[1], h[2], h[3]}); Bl[s_] = __builtin_bit_cast(bf16x8, (v4u){l[0], l[1], l[2], l[3]}); }
    __syncthreads();
    const int TPW = (T + F.G - 1) / F.G, wg = blockIdx.x;
    const float brl = br[lane & 31];
    f32x4 lgv[4], lbv[4];
#pragma unroll
    for (int j = 0; j < 4; ++j) { lgv[j] = *((const f32x4*)lg + lane + 64 * j); lbv[j] = *((const f32x4*)lb + lane + 64 * j); }
    LAS float* SXl = (LAS float*)(F.lds + RT_STG); LAS int* TIl = (LAS int*)(SXl + 128); LAS float* TGl = (LAS float*)(TIl + 512); LAS int* LRl = (LAS int*)(TGl + 512);
    for (int c0 = 0; c0 < TPW; c0 += 128) {
        const int base = wg * TPW + c0, ntok = imin(128, TPW - c0), nbt = (ntok + 15) / 16;
        u32x2 ra[4], rb[4];
#define ROUTER_FETCH(B_) do { const int m0_ = imin(base + 16 * (B_) + 2 * w, T - 1), m1_ = imin(m0_ + 1, T - 1); \
        const GAS u32x2* ya = (const GAS u32x2*)(Y + (size_t)m0_ * D) + lane; const GAS u32x2* yb = (const GAS u32x2*)(Y + (size_t)m1_ * D) + lane; \
        _Pragma("unroll") for (int j = 0; j < 4; ++j) { ra[j] = ya[64 * j]; rb[j] = yb[64 * j]; } } while (0)
#define ROUTER_TAIL2(BB_) do { const int e = lane & 31, tk_ = 16 * (BB_) + 2 * w + (lane >> 5); const bool ok_ = tk_ < ntok && base + tk_ < T;          \
            const LAS float* pq = (const LAS float*)(L + RT_PP) + ((((BB_) & 1) * 4) * 16 + 2 * w + (lane >> 5)) * 32 + e; \
            const float val = ((pq[0] + pq[16 * 32]) + (pq[2 * 16 * 32] + pq[3 * 16 * 32])) + brl; \
            unsigned u_ = f2u(val); u_ = (u_ & 0x80000000u) ? ~u_ : (u_ | 0x80000000u); unsigned key = (u_ & ~31u) | (unsigned)(31 - e);        \
            float sv[4]; int si[4]; \
            _Pragma("unroll") for (int k = 0; k < 4; ++k) { const unsigned km = half_max_u(key); si[k] = 31 - (int)(km & 31u); const unsigned uu = km & ~31u; sv[k] = u2f((uu & 0x80000000u) ? (uu ^ 0x80000000u) : ~uu); if (e == si[k]) key = 0u; } \
            float ex[4], den = 0.f; \
            _Pragma("unroll") for (int k = 0; k < 4; ++k) { ex[k] = __expf(sv[k] - sv[0]); den += ex[k]; } \
            if (e == 0 && ok_) { \
                _Pragma("unroll") for (int k = 0; k < 4; ++k) { const int rk = __hip_atomic_fetch_add(&lcnt[si[k]], 1, __ATOMIC_RELAXED, __HIP_MEMORY_SCOPE_WORKGROUP); TIl[tk_ * 4 + k] = si[k]; TGl[tk_ * 4 + k] = ex[k] / den; LRl[tk_ * 4 + k] = rk; } } } while (0)
        f32x4 va[4], vb[4];
#define ROUTER_UNPACK() do { _Pragma("unroll") for (int j = 0; j < 4; ++j) { asm volatile("" : "+v"(ra[j]), "+v"(rb[j])); \
            va[j] = (f32x4){bf_lo(ra[j].x), bf_hi(ra[j].x), bf_lo(ra[j].y), bf_hi(ra[j].y)}; vb[j] = (f32x4){bf_lo(rb[j].x), bf_hi(rb[j].x), bf_lo(rb[j].y), bf_hi(rb[j].y)}; } } while (0)
        ROUTER_FETCH(0); ROUTER_UNPACK();
#pragma unroll 1
        for (int b = 0; b < nbt; ++b) {
            asm volatile("" ::: "memory");
            ROUTER_FETCH(imin(b + 1, nbt - 1));
            LAS unsigned char* tw = L + (b & 1) * RT_TILE + 8 * lane;
#define ROUTER_LN(V, R_) do { const int tk_ = 16 * b + 2 * w + (R_), m = imin(base + tk_, T - 1); float s = 0.f; \
            _Pragma("unroll") for (int j = 0; j < 4; ++j) s += (V[j].x + V[j].y) + (V[j].z + V[j].w); \
            const float mean = wave_sum(s) * (1.f / D); float s2 = 0.f; \
            _Pragma("unroll") for (int j = 0; j < 4; ++j) { V[j] = V[j] - mean; s2 += (V[j].x * V[j].x + V[j].y * V[j].y) + (V[j].z * V[j].z + V[j].w * V[j].w); } \
            const float rstd = 1.f / sqrtf(wave_sum(s2) * (1.f / D) + LN_EPS); \
            GAS unsigned long long* o8 = (GAS unsigned long long*)(X1B + (size_t)m * D) + lane; \
            float am = 0.f; \
            _Pragma("unroll") for (int j = 0; j < 4; ++j) { V[j] = V[j] * rstd * lgv[j] + lbv[j]; \
                const unsigned h0 = cvtpk(V[j].x, V[j].y), h1 = cvtpk(V[j].z, V[j].w), l0 = cvtpk(V[j].x - bf_lo(h0), V[j].y - bf_hi(h0)), l1 = cvtpk(V[j].z - bf_lo(h1), V[j].w - bf_hi(h1)); \
                o8[64 * j] = (unsigned long long)h0 | ((unsigned long long)h1 << 32); \
                *(LAS u32x2*)(tw + (2 * w + (R_)) * RT_RS + 512 * j) = (u32x2){h0, h1}; *(LAS u32x2*)(tw + (16 + 2 * w + (R_)) * RT_RS + 512 * j) = (u32x2){l0, l1}; \
                am = fmaxf(fmaxf(am, fmaxf(fabsf(V[j].x), fabsf(V[j].y))), fmaxf(fabsf(V[j].z), fabsf(V[j].w))); } \
            am = fmaxf(wave_max(am), 1e-20f); const float qi = 127.0f / am; GAS unsigned* q8 = (GAS unsigned*)(X1Q + (size_t)m * D) + lane;        \
            _Pragma("unroll") for (int j = 0; j < 4; ++j) q8[64 * j] = pack4_i8(V[j].x * qi, V[j].y * qi, V[j].z * qi, V[j].w * qi); \
            if (lane == 0) SXl[tk_ & 127] = am * (1.0f / 127.0f); } while (0)
            ROUTER_LN(va, 0); ROUTER_LN(vb, 1);
#undef ROUTER_LN
            __syncthreads();
            if (b > 0) ROUTER_TAIL2(b - 1);
            f32x4 acc = {0.f, 0.f, 0.f, 0.f};
            const LAS unsigned char* th = L + (b & 1) * RT_TILE + i16 * RT_RS + 512 * ks + 16 * kg;
#pragma unroll
            for (int s_ = 0; s_ < 8; ++s_) { const bf16x8 ah = *(const LAS bf16x8*)(th + 64 * s_), al = *(const LAS bf16x8*)(th + 16 * RT_RS + 64 * s_);
                acc = __builtin_amdgcn_mfma_f32_16x16x32_bf16(ah, Bh[s_], acc, 0, 0, 0); acc = __builtin_amdgcn_mfma_f32_16x16x32_bf16(al, Bh[s_], acc, 0, 0, 0); acc = __builtin_amdgcn_mfma_f32_16x16x32_bf16(ah, Bl[s_], acc, 0, 0, 0); }
            LAS float* pp = (LAS float*)(L + RT_PP) + (((b & 1) * 4 + ks) * 16 + 4 * kg) * 32 + 16 * nt + i16;
#pragma unroll
            for (int r = 0; r < 4; ++r) pp[r * 32] = acc[r];
            asm volatile("" ::: "memory");
            ROUTER_UNPACK();
        }
        __syncthreads();
        ROUTER_TAIL2(nbt - 1);
        __syncthreads();
        for (int t = FTID; t < 4 * ntok; t += NTHR) if (base + (t >> 2) < T) { TOPI[(size_t)base * 4 + t] = TIl[t]; TOPG[(size_t)base * 4 + t] = TGl[t]; LRANK[(size_t)base * 4 + t] = LRl[t]; }
        if (FTID < ntok && base + FTID < T) SX[base + FTID] = SXl[FTID];
        __syncthreads();
#undef ROUTER_FETCH
#undef ROUTER_TAIL2
#undef ROUTER_UNPACK
    }
    if (FTID < NE) CNT[wg * NE + FTID] = lcnt[FTID];
}
__device__ __forceinline__ void moe_scatter(Frame& F) {
    const int* TOPI = WSP(int, WS_TOPI); const int* LRANK = WSP(int, WS_LRANK); const int* CNT = WSP(int, WS_CNT); int* SLOT = WSP(int, WS_SLOT); int* PEXP = WSP(int, WS_PEXP); int* SROW = WSP(int, WS_SROW); const float* SX = WSP(float, WS_SX); float* SXS = WSP(float, WS_SXS);
    LAS int* red = (LAS int*)F.lds;
    LAS int* basev = red + 1024;
    const int wg = blockIdx.x, G = F.G, TPW = (T + G - 1) / G;
    __syncthreads();
    {   const int e = FTID & 31, part = FTID >> 5, per = (G + 15) / 16; int tot = 0, pre = 0;
        for (int w2 = part * per; w2 < (part + 1) * per && w2 < G; ++w2) { const int c = CNT[w2 * NE + e]; tot += c; if (w2 < wg) pre += c; }
        red[part * 32 + e] = tot; red[512 + part * 32 + e] = pre; }
    __syncthreads();
    if (FTID < NE) { int tot = 0, pre = 0;
        for (int p = 0; p < 16; ++p) { tot += red[p * 32 + FTID]; pre += red[512 + p * 32 + FTID]; }
        red[FTID] = (tot + 255) & ~255; red[512 + FTID] = pre; }
    __syncthreads();
    if (FTID < NE) { int ps = 0; for (int e2 = 0; e2 < FTID; ++e2) ps += red[e2]; basev[FTID] = ps + red[512 + FTID];
        if (wg == 0) { const int p0 = ps >> 8, p1 = (ps + red[FTID]) >> 8; for (int p = p0; p < p1; ++p) PEXP[16 + p] = FTID; if (FTID == NE - 1) PEXP[0] = p1; } }
    __syncthreads();
    for (int a = FTID; a < TPW * 4; a += NTHR) { const int m = wg * TPW + (a >> 2); if (m < T) { const int sl = basev[TOPI[m * 4 + (a & 3)]] + LRANK[m * 4 + (a & 3)]; SLOT[m * 4 + (a & 3)] = sl; SROW[sl] = m; SXS[sl] = SX[m]; } }
}
constexpr int UTAB_OFF = 131072, GIDX_OFF = UTAB_OFF + 512, GIDX_UNITS = 17;
static_assert(GIDX_OFF + GIDX_UNITS * 1024 <= PHASE_LDS && pg8::MOE_MAX_UNITS * 16 <= 512, "MoE tables above the GEMM ring");
__device__ __forceinline__ void moe_setup(Frame& F, int NT, bool gather) {
    const int* PEXP = WSP(int, WS_PEXP); const int* SROW = WSP(int, WS_SROW);
    LAS int* utab = (LAS int*)(F.lds + UTAB_OFF); LAS int* gidx = (LAS int*)(F.lds + GIDX_OFF);
    __syncthreads();
    const int npan = PEXP[0], G = F.G, c = blockIdx.x;
    if (FTID < pg8::MOE_MAX_UNITS) { const int i = FTID; int pm, pn;
        if ((G & 7) == 0) { const int x = c & 7, j = c >> 3, U = i * (G >> 3) + j, q8 = npan >> 3, r8 = npan & 7, px = q8 + (x < r8 ? 1 : 0), st = x * q8 + (x < r8 ? x : r8);
            pn = U % NT; const int k = U / NT; pm = k < px ? st + k : npan; }
        else { const int L = i * G + c; pn = L % NT; pm = L / NT; }
        const int valid = pm < npan && (!gather || i < GIDX_UNITS); const int e = valid ? PEXP[16 + pm] : 0;
        utab[4 * i] = pm; utab[4 * i + 1] = pn; utab[4 * i + 2] = e * NT + pn; utab[4 * i + 3] = valid; }
    __syncthreads();
    if (gather) { for (int i = 0; i < GIDX_UNITS; ++i) { if (!utab[4 * i + 3]) break; if (FTID < 256) { int tk = SROW[utab[4 * i] * 256 + FTID]; tk = tk < 0 ? 0 : (tk >= T ? T - 1 : tk); gidx[i * 256 + FTID] = tk; } }
        __syncthreads(); }
}
__device__ __forceinline__ void moe_combine(Frame& F, int layer, float* OUT, bf16* OB, signed char* OQ, float* OQS) {
    const bf16* X1B = WSP(bf16, WS_X1B); const bf16* YB = WSP(bf16, WS_YB); const int* SLOT = WSP(int, WS_SLOT); const float* TOPG = WSP(float, WS_TOPG);
    const float* lg = (const float*)F.in[14] + layer * D; const float* lb = (const float*)F.in[15] + layer * D;
    const int lane = FLANE, gw = F.vcu * NWAVES + F.wave, NGW = F.G * NWAVES;
    f32x4 gv[4], bv[4];
#pragma unroll
    for (int q = 0; q < 4; ++q) { const int col = (q >> 1) * 512 + 8 * lane + (q & 1) * 4; gv[q] = *(const f32x4*)(lg + col); bv[q] = *(const f32x4*)(lb + col); }
    const int nrows = gw < T ? (T - gw + NGW - 1) / NGW : 0;
    for (int r0 = 0; r0 < nrows; r0 += 16) {
        const int nr = imin(16, nrows - r0);
        int slv; float gtv;
        { const size_t ri = (size_t)(gw + (r0 + imin(lane >> 2, nr - 1)) * NGW) * 4 + (lane & 3); slv = SLOT[ri]; gtv = TOPG[ri]; }
        float amv = 0.f;
        v4u da[6], db[6], dc[6];
#define CMB_LOAD(BUF, IT) do { const int itc_ = imin((IT), nr - 1), m_ = gw + (r0 + itc_) * NGW; const GAS v4u* xp_ = (const GAS v4u*)(X1B + (size_t)m_ * D) + lane; BUF[0] = xp_[0]; BUF[1] = xp_[64]; \
        _Pragma("unroll") for (int k = 0; k < 4; ++k) { const int sl_ = __builtin_amdgcn_readlane(slv, itc_ * 4 + k); const GAS u32x2* yp_ = (const GAS u32x2*)((const unsigned char*)YB + (size_t)sl_ * D) + lane; \
            const u32x2 ya_ = yp_[0], yb_ = yp_[64]; BUF[2 + k] = (v4u){ya_.x, ya_.y, yb_.x, yb_.y}; } } while (0)
#define CMB_TAKE(BUF) do { _Pragma("unroll") for (int i = 0; i < 6; ++i) { asm volatile("" : "+v"(BUF[i])); dc[i] = BUF[i]; } } while (0)
#define CMB_ROW(IT) do { const int itc_ = imin((IT), nr - 1), m = gw + (r0 + itc_) * NGW; \
        f32x4 v[4]; \
        v[0] = (f32x4){bf_lo(dc[0].x), bf_hi(dc[0].x), bf_lo(dc[0].y), bf_hi(dc[0].y)} * DN_ALPHA; v[1] = (f32x4){bf_lo(dc[0].z), bf_hi(dc[0].z), bf_lo(dc[0].w), bf_hi(dc[0].w)} * DN_ALPHA; \
        v[2] = (f32x4){bf_lo(dc[1].x), bf_hi(dc[1].x), bf_lo(dc[1].y), bf_hi(dc[1].y)} * DN_ALPHA; v[3] = (f32x4){bf_lo(dc[1].z), bf_hi(dc[1].z), bf_lo(dc[1].w), bf_hi(dc[1].w)} * DN_ALPHA; \
        _Pragma("unroll") for (int k = 0; k < 4; ++k) { const float g = __builtin_bit_cast(float, __builtin_amdgcn_readlane(__builtin_bit_cast(int, gtv), itc_ * 4 + k)) * (1.0f / 16.0f); const v4u a = dc[2 + k];          \
            const f32x2 a0 = __builtin_amdgcn_cvt_pk_f32_fp8((int)a.x, false), a1 = __builtin_amdgcn_cvt_pk_f32_fp8((int)a.x, true), a2 = __builtin_amdgcn_cvt_pk_f32_fp8((int)a.y, false), a3 = __builtin_amdgcn_cvt_pk_f32_fp8((int)a.y, true); \
            const f32x2 b0 = __builtin_amdgcn_cvt_pk_f32_fp8((int)a.z, false), b1 = __builtin_amdgcn_cvt_pk_f32_fp8((int)a.z, true), b2 = __builtin_amdgcn_cvt_pk_f32_fp8((int)a.w, false), b3 = __builtin_amdgcn_cvt_pk_f32_fp8((int)a.w, true); \
            v[0] += (f32x4){a0.x, a0.y, a1.x, a1.y} * g; v[1] += (f32x4){a2.x, a2.y, a3.x, a3.y} * g; \
            v[2] += (f32x4){b0.x, b0.y, b1.x, b1.y} * g; v[3] += (f32x4){b2.x, b2.y, b3.x, b3.y} * g; } \
        float s = 0.f; \
        _Pragma("unroll") for (int q = 0; q < 4; ++q) s += (v[q].x + v[q].y) + (v[q].z + v[q].w); \
        const float mean = wave_sum(s) * (1.f / D); float s2 = 0.f; \
        _Pragma("unroll") for (int q = 0; q < 4; ++q) { v[q] = v[q] - mean; s2 += (v[q].x * v[q].x + v[q].y * v[q].y) + (v[q].z * v[q].z + v[q].w * v[q].w); } \
        const float rstd = 1.f / sqrtf(wave_sum(s2) * (1.f / D) + LN_EPS); \
        _Pragma("unroll") for (int q = 0; q < 4; ++q) { const int col = (q >> 1) * 512 + 8 * lane + (q & 1) * 4; v[q] = v[q] * rstd * gv[q] + bv[q]; if (OUT) *(f32x4*)(OUT + (size_t)m * D + col) = v[q]; } \
        if (OQ) { float am = 0.f; \
            _Pragma("unroll") for (int q = 0; q < 4; ++q) am = fmaxf(fmaxf(am, fmaxf(fabsf(v[q].x), fabsf(v[q].y))), fmaxf(fabsf(v[q].z), fabsf(v[q].w))); \
            am = fmaxf(wave_max(am), 1e-20f); const float qi = 127.0f / am; unsigned w4[4]; \
            _Pragma("unroll") for (int q = 0; q < 4; ++q) w4[q] = pack4_i8(v[q].x * qi, v[q].y * qi, v[q].z * qi, v[q].w * qi); \
            GAS u32x2* oq = (GAS u32x2*)(OQ + (size_t)m * D) + lane; oq[0] = (u32x2){w4[0], w4[1]}; oq[64] = (u32x2){w4[2], w4[3]}; \
            amv = lane == itc_ ? am * (1.0f / 127.0f) : amv; } \
        if (OB) { GAS v4u* ob = (GAS v4u*)(OB + (size_t)m * D) + lane; \
            ob[0] = (v4u){cvtpk(v[0].x, v[0].y), cvtpk(v[0].z, v[0].w), cvtpk(v[1].x, v[1].y), cvtpk(v[1].z, v[1].w)}; ob[64] = (v4u){cvtpk(v[2].x, v[2].y), cvtpk(v[2].z, v[2].w), cvtpk(v[3].x, v[3].y), cvtpk(v[3].z, v[3].w)}; } } while (0)
        CMB_LOAD(da, 0); CMB_LOAD(db, 1); CMB_TAKE(da);
#pragma unroll 1
        for (int it = 0; it < nr; it += 2) {
            CMB_LOAD(da, it + 2); CMB_ROW(it); CMB_TAKE(db);
            CMB_LOAD(db, it + 3); CMB_ROW(it + 1); CMB_TAKE(da);
        }
        if (OQ && lane < nr) OQS[gw + (r0 + lane) * NGW] = amv;
#undef CMB_LOAD
#undef CMB_TAKE
#undef CMB_ROW
    }
}
__device__ __forceinline__ void diff_subln(Frame& F) {
    const bf16* O0 = WSP(bf16, WS_O0); const bf16* O1 = WSP(bf16, WS_O1); bf16* OB = WSP(bf16, WS_OB);
    const float* lam = (const float*)F.in[9]; const float* sw = (const float*)F.in[10];
    const int lane = FLANE, gw = F.vcu * NWAVES + F.wave, NGW = F.G * NWAVES;
    const float l1 = wave_sum(lam[lane] * lam[64 + lane]), l2 = wave_sum(lam[128 + lane] * lam[192 + lane]);
    const float lam_full = expf(l1) - expf(l2) + LAMBDA_INIT;
    f32x4 wv[2];
#pragma unroll
    for (int q = 0; q < 2; ++q) wv[q] = *(const f32x4*)(sw + ((8 * lane) & 127) + 4 * q) * (1.0f - LAMBDA_INIT);
    for (int m = gw; m < T; m += NGW) {
        const GAS v4u* p0 = (const GAS v4u*)(O0 + (size_t)m * D) + lane; const GAS v4u* p1 = (const GAS v4u*)(O1 + (size_t)m * D) + lane; GAS v4u* po = (GAS v4u*)(OB + (size_t)m * D) + lane;
#pragma unroll
        for (int hf = 0; hf < 2; ++hf) { const v4u a = p0[64 * hf], b = p1[64 * hf];
            float o[8] = {bf_lo(a.x) - lam_full * bf_lo(b.x), bf_hi(a.x) - lam_full * bf_hi(b.x), bf_lo(a.y) - lam_full * bf_lo(b.y), bf_hi(a.y) - lam_full * bf_hi(b.y),
                          bf_lo(a.z) - lam_full * bf_lo(b.z), bf_hi(a.z) - lam_full * bf_hi(b.z), bf_lo(a.w) - lam_full * bf_lo(b.w), bf_hi(a.w) - lam_full * bf_hi(b.w)};
            float ss = 0.f;
#pragma unroll
            for (int e = 0; e < 8; ++e) ss += o[e] * o[e];
            ss = sum16(ss);
            const float rstd = 1.0f / sqrtf(ss * (1.0f / 128.0f) + RMS_EPS);
            po[64 * hf] = (v4u){pk2(o[0] * rstd * wv[0].x, o[1] * rstd * wv[0].y), pk2(o[2] * rstd * wv[0].z, o[3] * rstd * wv[0].w), pk2(o[4] * rstd * wv[1].x, o[5] * rstd * wv[1].y), pk2(o[6] * rstd * wv[1].z, o[7] * rstd * wv[1].w)}; }
    }
}

struct Args { const void* in[22]; float* out; unsigned char* ws; int ph_lo, ph_hi; };
__global__ void __launch_bounds__(NTHR, 2) yoco_fwd(Args args) {
    extern __shared__ __attribute__((aligned(16))) unsigned char lds[];
    Frame F;
    F.lds = (LAS unsigned char*)lds;
    F.MISC = (volatile LAS unsigned*)(F.lds + MISC_OFF);
    F.wave = __builtin_amdgcn_readfirstlane((int)threadIdx.x >> 6);
    F.G = gridDim.x; { const int bx = blockIdx.x; F.vcu = (F.G % 8 == 0) ? (bx % 8) * (F.G / 8) + bx / 8 : bx; }
    F.ws = args.ws; F.ctl = (gu32*)(args.ws + WS_CTL); F.in = args.in; F.out = args.out;
    for (int u = FTID; u < (LDS_BYTES - MISC_OFF) / 4; u += NTHR) ((LAS unsigned*)(F.lds + MISC_OFF))[u] = 0u;
    __syncthreads();
    XcdBarrier bar; bar.bar = (unsigned*)(F.ctl + CW_BAR); bar.x = 0; bar.st = nullptr;
    if (N_LAUNCHES == 1) bar = xcd_barrier_post((unsigned*)(F.ctl + CW_BAR), F.MISC + 8);
    const int lo = args.ph_lo, hi = args.ph_hi;
#ifndef DBG_MASK
#define DBG_MASK 0xFFFFFu
#endif
#define IN(k) (lo <= (k) && (k) < hi && ((DBG_MASK >> (k)) & 1u))
#define SEAM(k) do { if ((k) != 13 && IN(k) && IN((k) + 1)) xcd_barrier(bar); } while (0)
#ifndef DBG_REPEAT
#define DBG_REPEAT 0u
#endif
#define PHASE(k, ...) do { if (IN(k)) { { __VA_ARGS__ } if ((DBG_REPEAT >> (k)) & 1u) { if (N_LAUNCHES == 1) xcd_barrier(bar); { __VA_ARGS__ } } } SEAM(k); } while (0);
    LAS unsigned char* ring = F.lds;

    PHASE(0,  p0_prologue(F); )
    PHASE(1,  pg8::Gemm g{WSP(bf16, WS_X1Q), WSP(bf16, WS_WIN), T, NQKVR, D / 2}; pg8::StaticOrder S; S.init(T, NQKVR, F.G, (int)blockIdx.x);
        pg8::EpiStoreI8 E{WSP(bf16, WS_QKVR), NQKVR, WSP(float, WS_SX), WSP(float, WS_SWIN)};
        pg8::gemm_phase<pg8::EpiStoreI8, pg8::StaticOrder, true, true, false, true>(ring, g, S, E); )
    PHASE(2,  gla_stage1(F); )
    PHASE(3,  gla_stage2(F); )
    PHASE(4,  gla_stage3(F); )
    PHASE(5,  pg8::Gemm g{WSP(bf16, WS_OG), WSP(bf16, WS_WAO), T, D, D / 2}; pg8::StaticOrder S; S.init(T, D, F.G, (int)blockIdx.x);
        pg8::EpiResI8 E{WSP(bf16, WS_XB), WSP(bf16, WS_Y), D, DN_ALPHA, OG_QS, WSP(float, WS_SWAO)};
        pg8::gemm_phase<pg8::EpiResI8, pg8::StaticOrder, true, true, false, true>(ring, g, S, E); )
    PHASE(6,  moe_router(F, 0); )
    PHASE(7,  moe_scatter(F); )
    PHASE(8,  moe_setup(F, 8, true);
        pg8::Gemm g{WSP(bf16, WS_X1Q), WSP(bf16, WS_WGU) + (size_t)0 * NE * 2048 * 512, NPAD_MAX, 2048, D / 2}; pg8::MoeOrder S{(const LAS int*)(F.lds + UTAB_OFF)};
        pg8::EpiSwigluI8 E{(const float*)F.in[19], WSP(bf16, WS_ACT), WSP(float, WS_SXS), WSP(float, WS_SWQ) + 0 * NE, WSP(float, WS_SACT) + 0 * NE};
        pg8::gemm_phase<pg8::EpiSwigluI8, pg8::MoeOrder, true, true, true, true>(ring, g, S, E, (const LAS int*)(F.lds + GIDX_OFF)); )
    PHASE(9,  moe_setup(F, 4, false);
        pg8::Gemm g{WSP(bf16, WS_ACT), WSP(bf16, WS_WD) + (size_t)0 * NE * 1024 * 512, NPAD_MAX, D, D / 2}; pg8::MoeOrder S{(const LAS int*)(F.lds + UTAB_OFF)};
        pg8::EpiDownI8 E{(const float*)F.in[21], WSP(bf16, WS_YB), WSP(float, WS_SACT) + 0 * NE, WSP(float, WS_SWD) + 0 * NE};
        pg8::gemm_phase<pg8::EpiDownI8, pg8::MoeOrder, true, true, false, true>(ring, g, S, E); )
    PHASE(10,  moe_combine(F, 0, (float*)nullptr, WSP(bf16, WS_X2B), (signed char*)WSP(unsigned char, WS_X2Q), WSP(float, WS_SX2)); )
    PHASE(11,  pg8::Gemm g{WSP(bf16, WS_X2Q), WSP(bf16, WS_WKVQ), T, 3072, D / 2}; pg8::StaticOrder S; S.init(T, 3072, F.G, (int)blockIdx.x);
        pg8::EpiRopeI8 E{WSP(bf16, WS_KB), (size_t)(WS_VB - WS_KB) / 2, WSP(float, WS_COS), WSP(float, WS_SIN), attn_body::C2, WSP(float, WS_SX2), WSP(float, WS_SWKVQ)};
        static_assert(WS_QB - WS_VB == WS_VB - WS_KB, "K | V | Q equally spaced");
        pg8::gemm_phase<pg8::EpiRopeI8, pg8::StaticOrder, true, true, false, true>(ring, g, S, E); )
    PHASE(12,  const attn_body::DiffTensors AT{(const attn_body::bf16*)WSP(bf16, WS_QB), (const attn_body::bf16*)WSP(bf16, WS_KB), (const attn_body::bf16*)WSP(bf16, WS_VB), (attn_body::bf16*)WSP(bf16, WS_O0), (attn_body::bf16*)WSP(bf16, WS_OB),
            (const float*)F.in[9], WSP(float, WS_SUBW), LAMBDA_INIT};
        static_assert(attn_body::L2_BYTES <= PHASE_LDS, "attention LDS");
        attn_body::diff_attn_phase128<8>((char*)lds, AT, F.vcu, F.G); )
    PHASE(13, )
    PHASE(14,  pg8::Gemm g{WSP(bf16, WS_OB), WSP(bf16, WS_WBO), T, D, D / 2}; pg8::StaticOrder S; S.init(T, D, F.G, (int)blockIdx.x);
        pg8::EpiResI8 E{WSP(bf16, WS_X2B), WSP(bf16, WS_Y), D, DN_ALPHA, OB_QS, WSP(float, WS_SWBO)};
        pg8::gemm_phase<pg8::EpiResI8, pg8::StaticOrder, true, true, false, true>(ring, g, S, E); )
    PHASE(15,  moe_router(F, 1); )
    PHASE(16,  moe_scatter(F); )
    PHASE(17,  moe_setup(F, 8, true);
        pg8::Gemm g{WSP(bf16, WS_X1Q), WSP(bf16, WS_WGU) + (size_t)1 * NE * 2048 * 512, NPAD_MAX, 2048, D / 2}; pg8::MoeOrder S{(const LAS int*)(F.lds + UTAB_OFF)};
        pg8::EpiSwigluI8 E{(const float*)F.in[19] + NE * 2048, WSP(bf16, WS_ACT), WSP(float, WS_SXS), WSP(float, WS_SWQ) + 1 * NE, WSP(float, WS_SACT) + 1 * NE};
        pg8::gemm_phase<pg8::EpiSwigluI8, pg8::MoeOrder, true, true, true, true>(ring, g, S, E, (const LAS int*)(F.lds + GIDX_OFF)); )
    PHASE(18,  moe_setup(F, 4, false);
        pg8::Gemm g{WSP(bf16, WS_ACT), WSP(bf16, WS_WD) + (size_t)1 * NE * 1024 * 512, NPAD_MAX, D, D / 2}; pg8::MoeOrder S{(const LAS int*)(F.lds + UTAB_OFF)};
        pg8::EpiDownI8 E{(const float*)F.in[21] + NE * 1024, WSP(bf16, WS_YB), WSP(float, WS_SACT) + 1 * NE, WSP(float, WS_SWD) + 1 * NE};
        pg8::gemm_phase<pg8::EpiDownI8, pg8::MoeOrder, true, true, false, true>(ring, g, S, E); )
    PHASE(19,  moe_combine(F, 1, F.out, (bf16*)nullptr, (signed char*)nullptr, (float*)nullptr); )
#undef IN
#undef SEAM
#undef PHASE
}

extern "C" void kernel_launch(void* const* d_in, const int* in_sizes, int n_in, void* d_out, int out_size, void* d_ws, size_t ws_size, hipStream_t stream) {
    static int grid = 0;
    if (grid == 0) {
        if (n_in != 22 || in_sizes[0] != T * D || out_size != T * D || ws_size < WS_END) { fprintf(stderr, "kernel_launch: unexpected problem (n_in %d, in0 %d, out %d, ws %zu); nothing launched\n", n_in, n_in > 0 ? in_sizes[0] : -1, out_size, ws_size); grid = -1; return; }
        int dev = 0, cus = 0, per_cu = 0;
        if (hipGetDevice(&dev) != hipSuccess || hipDeviceGetAttribute(&cus, hipDeviceAttributeMultiprocessorCount, dev) != hipSuccess) { grid = -1; return; }
        if (hipFuncSetAttribute((const void*)yoco_fwd, hipFuncAttributeMaxDynamicSharedMemorySize, LDS_BYTES) != hipSuccess) { fprintf(stderr, "kernel_launch: hipFuncSetAttribute failed\n"); grid = -1; return; }
        if (hipOccupancyMaxActiveBlocksPerMultiprocessor(&per_cu, (const void*)yoco_fwd, NTHR, LDS_BYTES) != hipSuccess || per_cu < 1) fprintf(stderr, "kernel_launch: note: occupancy query reports %d workgroups per CU\n", per_cu);
        (void)hipGetLastError();
        grid = cus < 256 ? (cus & ~7) : 256;
        if (grid < 8) grid = 8;
    }
    if (grid < 0) return;
    if (hipMemsetAsync((char*)d_ws + WS_CTL, 0, CTL_ZERO_BYTES, stream) != hipSuccess) return;
    Args a{};
    for (int i = 0; i < 22; ++i) a.in[i] = d_in[i];
    a.out = (float*)d_out; a.ws = (unsigned char*)d_ws;
    for (int li = 0; li < N_LAUNCHES; ++li) {
        a.ph_lo = (N_LAUNCHES == 1) ? 0 : li; a.ph_hi = (N_LAUNCHES == 1) ? NPHASE : li + 1;
        hipLaunchKernelGGL(yoco_fwd, dim3(grid), dim3(NTHR), LDS_BYTES, stream, a);
        if (hipPeekAtLastError() != hipSuccess) { fprintf(stderr, "kernel_launch: launch %d failed\n", li); break; }
    }
}
```

```cpp
#include <hip/hip_runtime.h>
#include <hip/hip_bf16.h>
#include <cstdio>
#include <cstdint>
#include <cmath>
#include <type_traits>
__device__ __forceinline__ unsigned pack4_i8(float a, float b, float c, float d) {
    unsigned p = 0u;
    p = __builtin_amdgcn_cvt_pk_u8_f32(a + 128.0f, 0, p); p = __builtin_amdgcn_cvt_pk_u8_f32(b + 128.0f, 1, p);
    p = __builtin_amdgcn_cvt_pk_u8_f32(c + 128.0f, 2, p); p = __builtin_amdgcn_cvt_pk_u8_f32(d + 128.0f, 3, p);
    return p ^ 0x80808080u;
}
__device__ __forceinline__ unsigned pack4_i8_biased(float a, float b, float c, float d) {
    unsigned p = 0u;
    p = __builtin_amdgcn_cvt_pk_u8_f32(a, 0, p); p = __builtin_amdgcn_cvt_pk_u8_f32(b, 1, p);
    p = __builtin_amdgcn_cvt_pk_u8_f32(c, 2, p); p = __builtin_amdgcn_cvt_pk_u8_f32(d, 3, p);
    return p ^ 0x80808080u;
}
namespace pg8 {
#define PG8_LAS __attribute__((address_space(3)))
typedef unsigned short bf16_t;
typedef short bf16x8 __attribute__((ext_vector_type(8)));
typedef float f32x4 __attribute__((ext_vector_type(4)));
typedef unsigned u32x4 __attribute__((ext_vector_type(4)));
typedef int i32x4 __attribute__((ext_vector_type(4)));
constexpr int BM = 256, BK = 64, HALF = 128, HTB = HALF * BK * 2  , STAGE_BYTES = 8 * HTB, NXCD = 8, WGM = 8;

__host__ __device__ __forceinline__ int lds_byte(int r, int c) { const int st = (r >> 4) * 2 + (c >> 5), rr = r & 15, cc = c & 31, ob = rr * 64 + cc * 2; return st * 1024 + (ob ^ (((ob >> 9) & 1) << 5)); }
__host__ __device__ __forceinline__ void stage_rc(int b, int& R, int& C) { const int st = b / 1024, sb = b % 1024, swz = sb ^ (((sb >> 9) & 1) << 5); R = (st >> 1) * 16 + swz / 64; C = (st & 1) * 32 + (swz % 64) / 2; }
__host__ __device__ __forceinline__ int perm32(int rho) { const int n = rho >> 4, i = rho & 15; return 8 * (i >> 2) + 4 * n + (i & 3); }

struct Unit { int pm, pn, pb; };
struct Gemm { const bf16_t* A; const bf16_t* Bt; int M, N, K; };

struct StaticOrder {
    int nM, nN, nwg, G, c;
    __host__ __device__ void init(int M, int N, int G_, int c_) { nM = M / BM; nN = N / BM; nwg = nM * nN; G = G_; c = c_; }
    __host__ __device__ bool next(int i, Unit& u) const {
        const long L = (long)i * G + c; if (L >= nwg) return false;
        int wgid = (int)L; { const int q = nwg / NXCD, r = nwg % NXCD, xcd = wgid % NXCD, off = wgid / NXCD; wgid = (xcd < r ? xcd * (q + 1) : r * (q + 1) + (xcd - r) * q) + off; }
        const int nig = WGM * nN, gid = wgid / nig, fm = gid * WGM, gsz = (nM - fm) < WGM ? (nM - fm) : WGM;
        u.pm = fm + ((wgid % nig) % gsz); u.pn = (wgid % nig) / gsz; u.pb = u.pn; return true;
    }
    __device__ __forceinline__ void a_ready(const Unit&) const {}
    __device__ __forceinline__ void done(const Unit&) const {}
};
constexpr int MOE_MAX_UNITS = 24;
struct MoeOrder {
    const PG8_LAS int* utab;
    __device__ __forceinline__ bool next(int i, Unit& u) const {
        if (i >= MOE_MAX_UNITS) return false;
        const int v = __builtin_amdgcn_readfirstlane(utab[4 * i + 3]); if (!v) return false;
        u.pm = __builtin_amdgcn_readfirstlane(utab[4 * i]); u.pn = __builtin_amdgcn_readfirstlane(utab[4 * i + 1]); u.pb = __builtin_amdgcn_readfirstlane(utab[4 * i + 2]); return true;
    }
    __device__ __forceinline__ void a_ready(const Unit&) const {}
    __device__ __forceinline__ void done(const Unit&) const {}
};

typedef float f32x2v __attribute__((ext_vector_type(2))); typedef unsigned u32x2v __attribute__((ext_vector_type(2))); typedef __bf16 bf16x2v __attribute__((ext_vector_type(2)));
__device__ __forceinline__ unsigned cvt_pk_bf16(float lo, float hi) { f32x2v v = {lo, hi}; bf16x2v b = __builtin_convertvector(v, bf16x2v); return __builtin_bit_cast(unsigned, b); }
__device__ __forceinline__ u32x4 pack8(const f32x4 v0, const f32x4 v1) { u32x4 w; w.x = cvt_pk_bf16(v0[0], v0[1]); w.y = cvt_pk_bf16(v0[2], v0[3]); w.z = cvt_pk_bf16(v1[0], v1[1]); w.w = cvt_pk_bf16(v1[2], v1[3]); return w; }

struct EpiStore {
    static constexpr bool PERM = true, AFTER_DRAIN = false;
    bf16_t* O; int ldc;
    __device__ __forceinline__ void operator()(const f32x4 (&acc)[2][2][4][2], const Unit& u, int wr, int wc, int fr, int fq) const {
        const int row0 = u.pm * BM + wr * 64 + fr, col0 = u.pn * BM + wc * 32 + 8 * fq;
#pragma unroll
        for (int ai = 0; ai < 2; ++ai)
#pragma unroll
            for (int m = 0; m < 4; ++m) { bf16_t* rowp = O + (size_t)(row0 + ai * HALF + m * 16) * ldc + col0;
#pragma unroll
                for (int bj = 0; bj < 2; ++bj) *(u32x4*)(rowp + bj * HALF) = pack8(acc[ai][bj][m][0], acc[ai][bj][m][1]); }
    }
};
struct EpiStoreI8 {
    static constexpr bool PERM = true, AFTER_DRAIN = false;
    bf16_t* O; int ldc; const float* sx; const float* sw;
    __device__ __forceinline__ void operator()(const i32x4 (&acc)[2][2][4][2], const Unit& u, int wr, int wc, int fr, int fq) const {
        const int row0 = u.pm * BM + wr * 64 + fr, col0 = u.pn * BM + wc * 32 + 8 * fq; const float swt = sw[u.pn];
        float sxv[2][4];
#pragma unroll
        for (int ai = 0; ai < 2; ++ai)
#pragma unroll
            for (int m = 0; m < 4; ++m) sxv[ai][m] = sx[row0 + ai * HALF + m * 16];
#pragma unroll
        for (int ai = 0; ai < 2; ++ai)
#pragma unroll
            for (int m = 0; m < 4; ++m) { const int row = row0 + ai * HALF + m * 16; bf16_t* rowp = O + (size_t)row * ldc + col0; const float sc = sxv[ai][m] * swt;
#pragma unroll
                for (int bj = 0; bj < 2; ++bj) { f32x4 v0, v1;
#pragma unroll
                    for (int j = 0; j < 4; ++j) { v0[j] = (float)acc[ai][bj][m][0][j] * sc; v1[j] = (float)acc[ai][bj][m][1][j] * sc; }
                    *(u32x4*)(rowp + bj * HALF) = pack8(v0, v1); } }
    }
};
template <bool RBF> struct EpiRes {
    static constexpr bool PERM = true, AFTER_DRAIN = false;
    const void* R; bf16_t* Y; int ldc; float alpha;
    __device__ __forceinline__ void operator()(const f32x4 (&acc)[2][2][4][2], const Unit& u, int wr, int wc, int fr, int fq) const {
        const int row0 = u.pm * BM + wr * 64 + fr, col0 = u.pn * BM + wc * 32 + 8 * fq;
#pragma unroll
        for (int ai = 0; ai < 2; ++ai)
#pragma unroll
            for (int m = 0; m < 4; ++m) { const size_t p = (size_t)(row0 + ai * HALF + m * 16) * ldc + col0;
#pragma unroll
                for (int bj = 0; bj < 2; ++bj) { f32x4 r0, r1;
                    if constexpr (RBF) { const u32x4 w = *(const u32x4*)((const bf16_t*)R + p + bj * HALF);
                        r0 = (f32x4){__builtin_bit_cast(float, w.x << 16), __builtin_bit_cast(float, w.x & 0xffff0000u), __builtin_bit_cast(float, w.y << 16), __builtin_bit_cast(float, w.y & 0xffff0000u)};
                        r1 = (f32x4){__builtin_bit_cast(float, w.z << 16), __builtin_bit_cast(float, w.z & 0xffff0000u), __builtin_bit_cast(float, w.w << 16), __builtin_bit_cast(float, w.w & 0xffff0000u)}; }
                    else { r0 = *(const f32x4*)((const float*)R + p + bj * HALF); r1 = *(const f32x4*)((const float*)R + p + bj * HALF + 4); }
                    *(u32x4*)(Y + p + bj * HALF) = pack8(r0 * alpha + acc[ai][bj][m][0], r1 * alpha + acc[ai][bj][m][1]); } }
    }
};
struct EpiResI8 {
    static constexpr bool PERM = true, AFTER_DRAIN = false;
    const bf16_t* R; bf16_t* Y; int ldc; float alpha; float sa; const float* sw;
    __device__ __forceinline__ void operator()(const i32x4 (&acc)[2][2][4][2], const Unit& u, int wr, int wc, int fr, int fq) const {
        const int row0 = u.pm * BM + wr * 64 + fr, col0 = u.pn * BM + wc * 32 + 8 * fq; const float sc = sa * sw[u.pn];
#pragma unroll
        for (int ai = 0; ai < 2; ++ai) {
            u32x4 rw[4][2];
#pragma unroll
            for (int m = 0; m < 4; ++m)
#pragma unroll
                for (int bj = 0; bj < 2; ++bj) rw[m][bj] = *(const u32x4*)(R + (size_t)(row0 + ai * HALF + m * 16) * ldc + col0 + bj * HALF);
#pragma unroll
            for (int m = 0; m < 4; ++m) { const size_t p = (size_t)(row0 + ai * HALF + m * 16) * ldc + col0;
#pragma unroll
                for (int bj = 0; bj < 2; ++bj) { const u32x4 w = rw[m][bj];
                    const f32x4 r0 = (f32x4){__builtin_bit_cast(float, w.x << 16), __builtin_bit_cast(float, w.x & 0xffff0000u), __builtin_bit_cast(float, w.y << 16), __builtin_bit_cast(float, w.y & 0xffff0000u)};
                    const f32x4 r1 = (f32x4){__builtin_bit_cast(float, w.z << 16), __builtin_bit_cast(float, w.z & 0xffff0000u), __builtin_bit_cast(float, w.w << 16), __builtin_bit_cast(float, w.w & 0xffff0000u)};
                    f32x4 v0, v1;
#pragma unroll
                    for (int j = 0; j < 4; ++j) { v0[j] = (float)acc[ai][bj][m][0][j] * sc; v1[j] = (float)acc[ai][bj][m][1][j] * sc; }
                    *(u32x4*)(Y + p + bj * HALF) = pack8(r0 * alpha + v0, r1 * alpha + v1); } } }
    }
};
struct EpiSwiglu {
    static constexpr bool PERM = true, AFTER_DRAIN = false;
    const float* bgu; bf16_t* O;
    __device__ __forceinline__ void operator()(const f32x4 (&acc)[2][2][4][2], const Unit& u, int wr, int wc, int fr, int fq) const {
        const int e = u.pb >> 3, row0 = u.pm * BM + wr * 64 + fr, colh = u.pn * HALF + wc * 32 + 8 * fq;
        const float* bb = bgu + (size_t)e * 2048 + colh;
        f32x4 bg[2], bl[2];
#pragma unroll
        for (int n = 0; n < 2; ++n) { bg[n] = *(const f32x4*)(bb + 4 * n); bl[n] = *(const f32x4*)(bb + 1024 + 4 * n); }
#pragma unroll
        for (int ai = 0; ai < 2; ++ai)
#pragma unroll
            for (int m = 0; m < 4; ++m) { f32x4 a[2];
#pragma unroll
                for (int n = 0; n < 2; ++n) { const f32x4 g = acc[ai][0][m][n] + bg[n], l = acc[ai][1][m][n] + bl[n];
#pragma unroll
                    for (int j = 0; j < 4; ++j) { const float xg = fminf(g[j], 7.0f), xl = fminf(fmaxf(l[j], -7.0f), 7.0f);
                        a[n][j] = xg * __builtin_amdgcn_rcpf(1.0f + __expf(-1.702f * xg)) * (xl + 1.0f); } }
                *(u32x4*)(O + (size_t)(row0 + ai * HALF + m * 16) * 1024 + colh) = pack8(a[0], a[1]); }
    }
};
struct EpiSwigluI8 {
    static constexpr bool PERM = true, AFTER_DRAIN = false;
    const float* bgu; bf16_t* O; const float* sxs; const float* swq; const float* sact;
    __device__ __forceinline__ void operator()(const i32x4 (&acc)[2][2][4][2], const Unit& u, int wr, int wc, int fr, int fq) const {
        const int e = u.pb >> 3, row0 = u.pm * BM + wr * 64 + fr, colh = u.pn * HALF + wc * 32 + 8 * fq;
        const float* bb = bgu + (size_t)e * 2048 + colh; constexpr float CS = 2.4554669595930156f;
        const float sw = swq[e], qa = 1.0f / (sact[e] * CS);
        f32x4 bg[2], bl[2];
#pragma unroll
        for (int n = 0; n < 2; ++n) { bg[n] = *(const f32x4*)(bb + 4 * n) * CS; bl[n] = *(const f32x4*)(bb + 1024 + 4 * n); }
        float sxv[2][4];
#pragma unroll
        for (int ai = 0; ai < 2; ++ai)
#pragma unroll
            for (int m = 0; m < 4; ++m) sxv[ai][m] = sxs[row0 + ai * HALF + m * 16];
#pragma unroll
        for (int ai = 0; ai < 2; ++ai)
#pragma unroll
            for (int mp = 0; mp < 2; ++mp) { u32x2v w[2];
#pragma unroll
                for (int mm = 0; mm < 2; ++mm) { const int m = 2 * mp + mm; f32x4 a[2]; const float sc = sxv[ai][m] * sw, scg = sc * CS;
#pragma unroll
                    for (int n = 0; n < 2; ++n) { const i32x4 gi = acc[ai][0][m][n], li = acc[ai][1][m][n];
#pragma unroll
                        for (int j = 0; j < 4; ++j) { const float g = __builtin_fmaf((float)gi[j], scg, bg[n][j]), l = __builtin_fmaf((float)li[j], sc, bl[n][j]);
                            const float xg = fminf(g, 7.0f * CS), xl = fminf(fmaxf(l, -7.0f), 7.0f);
                            a[n][j] = (xg * __builtin_amdgcn_rcpf(1.0f + __builtin_amdgcn_exp2f(-xg))) * (xl * qa + qa) + 128.0f; } }
                    w[mm].x = pack4_i8_biased(a[0][0], a[0][1], a[0][2], a[0][3]); w[mm].y = pack4_i8_biased(a[1][0], a[1][1], a[1][2], a[1][3]); }
                const auto rx = __builtin_amdgcn_permlane16_swap(w[0].x, w[1].x, false, false), ry = __builtin_amdgcn_permlane16_swap(w[0].y, w[1].y, false, false);
                const int odd = fq & 1, row = row0 + ai * HALF + (2 * mp + odd) * 16;
                *(u32x4*)((signed char*)O + (size_t)row * 1024 + colh - 8 * odd) = (u32x4){rx[0], ry[0], rx[1], ry[1]}; }
    }
};
struct EpiDown {
    static constexpr bool PERM = true, AFTER_DRAIN = false;
    const float* bd; bf16_t* O;
    __device__ __forceinline__ void operator()(const f32x4 (&acc)[2][2][4][2], const Unit& u, int wr, int wc, int fr, int fq) const {
        const int e = u.pb >> 2, row0 = u.pm * BM + wr * 64 + fr, col0 = u.pn * BM + wc * 32 + 8 * fq;
        const float* bb = bd + (size_t)e * 1024 + col0;
        f32x4 bv[2][2];
#pragma unroll
        for (int bj = 0; bj < 2; ++bj)
#pragma unroll
            for (int n = 0; n < 2; ++n) bv[bj][n] = *(const f32x4*)(bb + bj * HALF + 4 * n);
#pragma unroll
        for (int ai = 0; ai < 2; ++ai)
#pragma unroll
            for (int m = 0; m < 4; ++m) { bf16_t* rowp = O + (size_t)(row0 + ai * HALF + m * 16) * 1024 + col0;
#pragma unroll
                for (int bj = 0; bj < 2; ++bj) *(u32x4*)(rowp + bj * HALF) = pack8(acc[ai][bj][m][0] + bv[bj][0], acc[ai][bj][m][1] + bv[bj][1]); }
    }
};
struct EpiDownI8 {
    static constexpr bool PERM = true, AFTER_DRAIN = false;
    const float* bd; bf16_t* O; const float* sact; const float* swd;
    __device__ __forceinline__ void operator()(const i32x4 (&acc)[2][2][4][2], const Unit& u, int wr, int wc, int fr, int fq) const {
        const int e = u.pb >> 2, row0 = u.pm * BM + wr * 64 + fr, col0 = u.pn * BM + wc * 32 + 8 * fq;
        const float* bb = bd + (size_t)e * 1024 + col0; const float sc = sact[e] * swd[e] * 16.0f;
        f32x4 bv[2][2];
#pragma unroll
        for (int bj = 0; bj < 2; ++bj)
#pragma unroll
            for (int n = 0; n < 2; ++n) bv[bj][n] = *(const f32x4*)(bb + bj * HALF + 4 * n) * 16.0f;
#pragma unroll
        for (int ai = 0; ai < 2; ++ai)
#pragma unroll
            for (int mp = 0; mp < 2; ++mp)
#pragma unroll
                for (int bj = 0; bj < 2; ++bj) { unsigned wx[2], wy[2];
#pragma unroll
                    for (int mm = 0; mm < 2; ++mm) { const int m = 2 * mp + mm; f32x4 v0, v1;
#pragma unroll
                        for (int j = 0; j < 4; ++j) { v0[j] = (float)acc[ai][bj][m][0][j] * sc + bv[bj][0][j]; v1[j] = (float)acc[ai][bj][m][1][j] * sc + bv[bj][1][j]; }
                        int w0 = __builtin_amdgcn_cvt_pk_fp8_f32(v0[0], v0[1], 0, false); w0 = __builtin_amdgcn_cvt_pk_fp8_f32(v0[2], v0[3], w0, true);
                        int w1 = __builtin_amdgcn_cvt_pk_fp8_f32(v1[0], v1[1], 0, false); w1 = __builtin_amdgcn_cvt_pk_fp8_f32(v1[2], v1[3], w1, true);
                        wx[mm] = (unsigned)w0; wy[mm] = (unsigned)w1; }
                    const auto rx = __builtin_amdgcn_permlane16_swap(wx[0], wx[1], false, false), ry = __builtin_amdgcn_permlane16_swap(wy[0], wy[1], false, false);
                    const int odd = fq & 1; unsigned char* rowp = (unsigned char*)O + (size_t)(row0 + ai * HALF + (2 * mp + odd) * 16) * 1024 + col0 - 8 * odd;
                    *(u32x4*)(rowp + bj * HALF) = (u32x4){rx[0], ry[0], rx[1], ry[1]}; }
    }
};
struct EpiRopeI8 {
    static constexpr bool PERM = true, AFTER_DRAIN = false;
    bf16_t* KVQ; size_t kind_stride; const float *cosT, *sinT; float qscale; const float* sx; const float* sw;
    __device__ __forceinline__ void operator()(const i32x4 (&acc)[2][2][4][2], const Unit& u, int wr, int wc, int fr, int fq) const {
        const int kind = u.pn >> 2, pl = u.pn & 3, row0 = u.pm * BM + wr * 64 + fr, col0 = pl * 256 + wc * 64 + 8 * fq;
        bf16_t* base = KVQ + (size_t)kind * kind_stride;
        const float sc = kind == 2 ? qscale : 1.0f, swt = sw[u.pn];
        float sxv[2][4];
#pragma unroll
        for (int ai = 0; ai < 2; ++ai)
#pragma unroll
            for (int m = 0; m < 4; ++m) sxv[ai][m] = sx[row0 + ai * HALF + m * 16];
#pragma unroll
        for (int am = 0; am < 4; ++am) { const int ai = am >> 1;
            f32x4 cv[2][2], sv[2][2];
            if (kind != 1) {
#pragma unroll
                for (int mm = 0; mm < 2; ++mm)
#pragma unroll
                    for (int n = 0; n < 2; ++n) { const size_t o_ = (size_t)(row0 + ai * HALF + (2 * (am & 1) + mm) * 16) * 32 + 8 * fq + 4 * n; cv[mm][n] = *(const f32x4*)(cosT + o_); sv[mm][n] = *(const f32x4*)(sinT + o_); } }
            else {
#pragma unroll
                for (int mm = 0; mm < 2; ++mm)
#pragma unroll
                    for (int n = 0; n < 2; ++n) { cv[mm][n] = (f32x4){1.f, 1.f, 1.f, 1.f}; sv[mm][n] = (f32x4){0.f, 0.f, 0.f, 0.f}; } }
#pragma unroll
            for (int mm = 0; mm < 2; ++mm) { const int m = 2 * (am & 1) + mm; const int row = row0 + ai * HALF + m * 16; const float scq = sxv[ai][m] * swt;
                bf16_t* rowp = base + (size_t)row * 1024 + col0;
                u32x4 wa, wb;
#pragma unroll
                for (int n = 0; n < 2; ++n) { f32x4 t1, t2, o1, o2;
#pragma unroll
                    for (int j = 0; j < 4; ++j) { t1[j] = (float)acc[ai][0][m][n][j] * scq; t2[j] = (float)acc[ai][1][m][n][j] * scq; }
                    if (kind != 1) { const f32x4 c = cv[mm][n], s = sv[mm][n];
                        o1 = (t1 * c - t2 * s) * sc; o2 = (t2 * c + t1 * s) * sc; }
                    else { o1 = t1; o2 = t2; }
                    wa[2 * n] = cvt_pk_bf16(o1[0], o1[1]); wa[2 * n + 1] = cvt_pk_bf16(o1[2], o1[3]); wb[2 * n] = cvt_pk_bf16(o2[0], o2[1]); wb[2 * n + 1] = cvt_pk_bf16(o2[2], o2[3]); }
                *(u32x4*)rowp = wa; *(u32x4*)(rowp + 32) = wb;
                asm volatile("" ::: "memory"); } }
    }
};

template <class Epi, class Sched, bool ALIGN_EPI = false, bool SP2 = false, bool GATHER = false, bool I8 = false>
__device__ __forceinline__ void gemm_phase(PG8_LAS unsigned char* lds, const Gemm g, const Sched& S, const Epi& E, const PG8_LAS int* gidx = nullptr) {
    static_assert(!GATHER || SP2, "the gather variant is written for the SP2 loop");
    const int tid = threadIdx.x, wid = __builtin_amdgcn_readfirstlane(tid >> 6), lane = tid & 63, wr = wid >> 2, wc = wid & 3, fr = lane & 15, fq = lane >> 4;
    const int K = g.K, nt = K / BK;
    unsigned voffA[2], voffB[2];
#pragma unroll
    for (int i = 0; i < 2; ++i) { int R, C; stage_rc(tid * 16 + i * 8192, R, C); const int Rb = Epi::PERM ? ((R & ~31) + perm32(R & 31)) : R;
        voffA[i] = (unsigned)(R * K + C) * 2u; voffB[i] = (unsigned)(Rb * K + C) * 2u; }
    unsigned vC[2][2], vN[2][2];
#define PG8_GIDX(dst, uix) do { _Pragma("unroll") for (int _h = 0; _h < 2; ++_h) _Pragma("unroll") for (int _i = 0; _i < 2; ++_i) { int R_, C_; stage_rc(tid * 16 + _i * 8192, R_, C_); \
        dst[_h][_i] = (unsigned)gidx[(uix) * BM + _h * HALF + R_] * (unsigned)(K * 2) + (unsigned)(C_ * 2); } } while (0)
    const size_t kstep = (size_t)(BK * 2);
    const size_t hstep = (size_t)HALF * K * 2;
    const size_t tstep = 2 * hstep;
    const unsigned ldsw = (unsigned)wid * 1024u;
    const int aoff = lds_byte(wr * 64 + fr, fq * 8), boff = lds_byte(wc * 32 + fr, fq * 8);
#define PG8_SA(b, h) (((b) * 2 + (h)) * HTB)
#define PG8_SB(b, h) ((4 + (b) * 2 + (h)) * HTB)
#define PG8_STAGE(bufoff, gbase, voff) do { _Pragma("unroll") for (int _i = 0; _i < 2; ++_i) \
        __builtin_amdgcn_global_load_lds((const unsigned*)((const char*)(gbase) + (voff)[_i]), (PG8_LAS unsigned*)(lds + (bufoff) + ldsw + _i * 8192), 16, 0, 0); } while (0)
#define PG8_STAGE_A(bufoff, gbase, h, vsel) do { if constexpr (GATHER) { PG8_STAGE(bufoff, gbase, (vsel)[h]); } else { PG8_STAGE(bufoff, (gbase) + (h) * hstep, voffA); } } while (0)
#define PG8_LDA(dst, b, h) do { _Pragma("unroll") for (int m = 0; m < 4; ++m) _Pragma("unroll") for (int k = 0; k < 2; ++k) dst[m][k] = *(const PG8_LAS bf16x8*)(lds + PG8_SA(b, h) + aoff + m * 2048 + k * 1024); } while (0)
#define PG8_LDB(dst, b, h) do { _Pragma("unroll") for (int n = 0; n < 2; ++n) _Pragma("unroll") for (int k = 0; k < 2; ++k) dst[n][k] = *(const PG8_LAS bf16x8*)(lds + PG8_SB(b, h) + boff + n * 2048 + k * 1024); } while (0)
#define PG8_MMA(ai, bj, At, Bt) do { __builtin_amdgcn_s_setprio(1); _Pragma("unroll") for (int m = 0; m < 4; ++m) _Pragma("unroll") for (int n = 0; n < 2; ++n) _Pragma("unroll") for (int k = 0; k < 2; ++k) \
        { if constexpr (I8) acc[ai][bj][m][n] = __builtin_bit_cast(acc_t, __builtin_amdgcn_mfma_i32_16x16x64_i8(__builtin_bit_cast(i32x4, Bt[n][k]), __builtin_bit_cast(i32x4, At[m][k]), __builtin_bit_cast(i32x4, acc[ai][bj][m][n]), 0, 0, 0)); \
          else acc[ai][bj][m][n] = __builtin_bit_cast(acc_t, __builtin_amdgcn_mfma_f32_16x16x32_bf16(Bt[n][k], At[m][k], __builtin_bit_cast(f32x4, acc[ai][bj][m][n]), 0, 0, 0)); } __builtin_amdgcn_s_setprio(0); } while (0)
#define PG8_WAIT_V(n) asm volatile("s_waitcnt vmcnt(" #n ")" ::: "memory")
#define PG8_WAIT_L(n) asm volatile("s_waitcnt lgkmcnt(" #n ")" ::: "memory")
#define PG8_BAR __builtin_amdgcn_s_barrier()
#define PG8_SCHED __builtin_amdgcn_sched_barrier(0)
    Unit cur, nxt; int ui = 0;
    if (!S.next(0, cur)) return;
    typedef typename std::conditional<I8, i32x4, f32x4>::type acc_t;
    acc_t acc[2][2][4][2];
#pragma unroll
    for (int a = 0; a < 2; ++a)
#pragma unroll
        for (int b = 0; b < 2; ++b)
#pragma unroll
            for (int m = 0; m < 4; ++m)
#pragma unroll
                for (int n = 0; n < 2; ++n) acc[a][b][m][n] = acc_t{};
    bf16x8 At[4][2], B0[2][2], B1[2][2];
    const char* cA = (const char*)g.A + (GATHER ? (size_t)0 : (size_t)cur.pm * tstep); if constexpr (GATHER) { PG8_GIDX(vC, 0); } const char* cB = (const char*)g.Bt + (size_t)cur.pb * tstep;
    S.a_ready(cur);
    if constexpr (SP2) {
        PG8_STAGE(PG8_SB(0, 0), cB, voffB); PG8_STAGE(PG8_SB(0, 1), cB + hstep, voffB); PG8_STAGE_A(PG8_SA(0, 0), cA, 0, vC); PG8_STAGE_A(PG8_SA(0, 1), cA, 1, vC);
        if (wr == 1) PG8_BAR;
        PG8_WAIT_V(2); PG8_BAR;
        PG8_STAGE(PG8_SB(1, 0), cB + kstep, voffB); PG8_STAGE_A(PG8_SA(1, 0), cA + kstep, 0, vC); PG8_STAGE(PG8_SB(1, 1), cB + hstep + kstep, voffB);
        PG8_WAIT_V(6); PG8_BAR;
    } else {
        PG8_STAGE(PG8_SB(0, 0), cB, voffB); PG8_STAGE(PG8_SA(0, 0), cA, voffA); PG8_STAGE(PG8_SB(0, 1), cB + hstep, voffB); PG8_STAGE(PG8_SA(0, 1), cA + hstep, voffA);
        if (wr == 1) PG8_BAR;
        PG8_WAIT_V(4); PG8_BAR;
        PG8_STAGE(PG8_SB(1, 0), cB + kstep, voffB); PG8_STAGE(PG8_SA(1, 0), cA + kstep, voffA); PG8_STAGE(PG8_SB(1, 1), cB + hstep + kstep, voffB);
        PG8_WAIT_V(6); PG8_BAR;
    }
    for (;;) {
        const bool has_next = S.next(ui + 1, nxt);
        const char* nA = (has_next && !GATHER) ? (const char*)g.A + (size_t)nxt.pm * tstep : cA;
        if constexpr (GATHER) { if (has_next) { PG8_GIDX(vN, ui + 1); } else { _Pragma("unroll") for (int _h = 0; _h < 2; ++_h) _Pragma("unroll") for (int _i = 0; _i < 2; ++_i) vN[_h][_i] = vC[_h][_i]; } } const char* nB = has_next ? (const char*)g.Bt + (size_t)nxt.pb * tstep : cB;
        for (int t = 0; t < nt; t += 2) {
            const bool last = (t == nt - 2);
            const char* a1 = cA + (size_t)(t + 1) * kstep;
            const char* a2 = last ? nA : cA + (size_t)(t + 2) * kstep; const char* b2 = last ? nB : cB + (size_t)(t + 2) * kstep;
            const char* a3 = a2 + kstep; const char* b3 = b2 + kstep;
            if (last && has_next) S.a_ready(nxt);
            unsigned vS[2][2];
            if constexpr (GATHER) { _Pragma("unroll") for (int _h = 0; _h < 2; ++_h) _Pragma("unroll") for (int _i = 0; _i < 2; ++_i) vS[_h][_i] = last ? vN[_h][_i] : vC[_h][_i]; }
            if constexpr (SP2) {
            PG8_LDB(B0, 0, 0); PG8_LDB(B1, 0, 1); PG8_SCHED; PG8_LDA(At, 0, 0); PG8_STAGE_A(PG8_SA(1, 1), a1, 1, vC);
            PG8_WAIT_V(8); PG8_WAIT_L(0); PG8_BAR; PG8_MMA(0, 0, At, B0); PG8_MMA(0, 1, At, B1); PG8_BAR; PG8_SCHED;
            PG8_LDA(At, 0, 1); PG8_STAGE(PG8_SB(0, 0), b2, voffB); PG8_STAGE(PG8_SB(0, 1), b2 + hstep, voffB); PG8_STAGE_A(PG8_SA(0, 0), a2, 0, vS);
            PG8_WAIT_V(8); PG8_WAIT_L(0); PG8_BAR; PG8_MMA(1, 0, At, B0); PG8_MMA(1, 1, At, B1); PG8_BAR; PG8_SCHED;
            PG8_LDB(B0, 1, 0); PG8_LDB(B1, 1, 1); PG8_SCHED; PG8_LDA(At, 1, 0); PG8_STAGE_A(PG8_SA(0, 1), a2, 1, vS);
            PG8_WAIT_V(8); PG8_WAIT_L(0); PG8_BAR; PG8_MMA(0, 0, At, B0); PG8_MMA(0, 1, At, B1); PG8_BAR; PG8_SCHED;
            PG8_LDA(At, 1, 1); PG8_STAGE(PG8_SB(1, 0), b3, voffB); PG8_STAGE(PG8_SB(1, 1), b3 + hstep, voffB); PG8_STAGE_A(PG8_SA(1, 0), a3, 0, vS);
            PG8_WAIT_V(8); PG8_WAIT_L(0); PG8_BAR; PG8_MMA(1, 0, At, B0); PG8_MMA(1, 1, At, B1); PG8_BAR; PG8_SCHED;
            } else {
            PG8_LDB(B0, 0, 0); PG8_SCHED; PG8_LDA(At, 0, 0); PG8_STAGE(PG8_SA(1, 1), a1 + hstep, voffA);
            PG8_WAIT_L(8); PG8_BAR; PG8_WAIT_L(0); PG8_MMA(0, 0, At, B0); PG8_BAR; PG8_SCHED;
            PG8_LDB(B1, 0, 1); PG8_STAGE(PG8_SB(0, 0), b2, voffB);
            PG8_BAR; PG8_WAIT_L(0); PG8_MMA(0, 1, At, B1); PG8_BAR;
            PG8_LDA(At, 0, 1); PG8_STAGE(PG8_SA(0, 0), a2, voffA);
            PG8_BAR; PG8_WAIT_L(0); PG8_MMA(1, 0, At, B0); PG8_BAR; PG8_SCHED;
            PG8_STAGE(PG8_SB(0, 1), b2 + hstep, voffB);
            PG8_WAIT_V(6); PG8_BAR; PG8_MMA(1, 1, At, B1); PG8_BAR;
            PG8_LDB(B0, 1, 0); PG8_SCHED; PG8_LDA(At, 1, 0); PG8_STAGE(PG8_SA(0, 1), a2 + hstep, voffA);
            PG8_WAIT_L(8); PG8_BAR; PG8_WAIT_L(0); PG8_MMA(0, 0, At, B0); PG8_BAR; PG8_SCHED;
            PG8_LDB(B1, 1, 1); PG8_STAGE(PG8_SB(1, 0), b3, voffB);
            PG8_BAR; PG8_WAIT_L(0); PG8_MMA(0, 1, At, B1); PG8_BAR;
            PG8_LDA(At, 1, 1); PG8_STAGE(PG8_SA(1, 0), a3, voffA);
            PG8_BAR; PG8_WAIT_L(0); PG8_MMA(1, 0, At, B0); PG8_BAR; PG8_SCHED;
            PG8_STAGE(PG8_SB(1, 1), b3 + hstep, voffB);
            PG8_WAIT_V(6); PG8_BAR; PG8_MMA(1, 1, At, B1); PG8_BAR;
            }
        }
        if constexpr (ALIGN_EPI) { if (wr == 0) PG8_BAR; }
        if constexpr (!Epi::AFTER_DRAIN) { E(acc, cur, wr, wc, fr, fq); S.done(cur); }
        if (!has_next) break;
#pragma unroll
        for (int a = 0; a < 2; ++a)
#pragma unroll
            for (int b = 0; b < 2; ++b)
#pragma unroll
                for (int m = 0; m < 4; ++m)
#pragma unroll
                    for (int n = 0; n < 2; ++n) acc[a][b][m][n] = acc_t{};
        cur = nxt; cA = nA; cB = nB; ++ui;
        if constexpr (GATHER) { _Pragma("unroll") for (int _h = 0; _h < 2; ++_h) _Pragma("unroll") for (int _i = 0; _i < 2; ++_i) vC[_h][_i] = vN[_h][_i]; }
        if constexpr (ALIGN_EPI) { if (wr == 1) PG8_BAR; }
    }
    PG8_WAIT_V(0);
    if constexpr (!ALIGN_EPI) { if (wr == 0) PG8_BAR; }
    PG8_BAR;
    if constexpr (Epi::AFTER_DRAIN) { E.fused(acc, cur, wr, wc, fr, fq, lds, wid, lane); S.done(cur); }
#undef PG8_SA
#undef PG8_SB
#undef PG8_STAGE
#undef PG8_STAGE_A
#undef PG8_GIDX
#undef PG8_LDA
#undef PG8_LDB
#undef PG8_MMA
#undef PG8_WAIT_V
#undef PG8_WAIT_L
#undef PG8_BAR
#undef PG8_SCHED
}
}
#include <hip/hip_bf16.h>
#include <cmath>
namespace attn_body {
using bf16=__hip_bfloat16;
using bf16x8=__attribute__((ext_vector_type(8)))short;
using s16x4=__attribute__((ext_vector_type(4)))short;
using f32x16=__attribute__((ext_vector_type(16)))float;
using u32x4=__attribute__((ext_vector_type(4)))unsigned;
using u32x2=__attribute__((ext_vector_type(2)))unsigned;
using f32x4a=__attribute__((ext_vector_type(4)))float;
constexpr float OB_QINV=127.0f/4.0f;
constexpr int BATCH=4,NHEAD=16,SEQ=8192,D=64,DM=NHEAD*D;
constexpr int NW=8,QBLK=32,QB=QBLK*NW,KVBLK=64,NQB=SEQ/QB;
constexpr int ATTN_PITCH=DM, ATTN_UNIT_ROWS=QB;
__device__ __forceinline__ int crow(int r,int hi){return (r&3)+8*(r>>2)+4*hi;}
#define SBAR() __builtin_amdgcn_sched_barrier(0)
__device__ __forceinline__ void cmask(f32x16&p0,f32x16&p1,int jb,int qrel,int hi){
  const float NEG=-INFINITY; int kb=64*jb+4*hi;
  #pragma unroll
  for(int r=0;r<16;++r){int kv=kb+(r&3)+8*(r>>2); if(kv>qrel)p0[r]=NEG; if(kv+32>qrel)p1[r]=NEG;}
}

constexpr int NSLOT=3, SLOTB=8192;
constexpr int LDS_K=0, LDS_V=NSLOT*SLOTB, LDS_WS=2*NSLOT*SLOTB, LDS_OST=LDS_WS+NW*64*4, LDS_BYTES=LDS_OST+NW*4096;
constexpr float C2=0.125f*1.4426950408889634f;
__device__ __forceinline__ void glds16(const void*gsrc,unsigned lds_dst){unsigned keep;
  asm volatile("s_mov_b32 %0, m0\n\ts_mov_b32 m0, %2\n\ts_nop 0\n\tglobal_load_lds_dwordx4 %1, off\n\ts_mov_b32 m0, %0":"=&s"(keep):"v"(gsrc),"s"(lds_dst):"memory");}
__device__ __forceinline__ float max3f(float a,float b,float c){float r;asm("v_max3_f32 %0, %1, %2, %3":"=v"(r):"v"(a),"v"(b),"v"(c));return r;}
__device__ __forceinline__ float max2f(float a,float b){float r;asm("v_max_f32_e32 %0, %1, %2":"=v"(r):"v"(a),"v"(b));return r;}
__device__ __forceinline__ float fadd_s(float a,float b){float r;asm("v_add_f32_e32 %0, %1, %2":"=v"(r):"v"(a),"v"(b));return r;}
__device__ __forceinline__ float fsub_s(float a,float b){float r;asm("v_sub_f32_e32 %0, %1, %2":"=v"(r):"v"(a),"v"(b));return r;}
typedef float f32x2_t __attribute__((ext_vector_type(2))); typedef __bf16 bf16x2_t __attribute__((ext_vector_type(2)));
__device__ __forceinline__ unsigned cvtpk_s(float lo,float hi){f32x2_t v={lo,hi};bf16x2_t b=__builtin_convertvector(v,bf16x2_t);return __builtin_bit_cast(unsigned,b);}
#define WAIT_BAR(N) asm volatile("s_waitcnt vmcnt(" #N ") lgkmcnt(0)\n\ts_barrier":::"memory")

__device__ __forceinline__ void qkt(f32x16&p0,f32x16&p1,const char*Kslot,const bf16x8*qr,const f32x16&negm,int r32,int hi){
  const char*kb=Kslot+hi*1024+r32*16;
  #pragma unroll
  for(int d0=0;d0<4;++d0){
    const bf16x8 b0=*reinterpret_cast<const bf16x8*>(kb+d0*2048);
    const bf16x8 b1=*reinterpret_cast<const bf16x8*>(kb+d0*2048+512);
    if(d0==0){p0=__builtin_amdgcn_mfma_f32_32x32x16_bf16(b0,qr[0],negm,0,0,0);p1=__builtin_amdgcn_mfma_f32_32x32x16_bf16(b1,qr[0],negm,0,0,0);}
    else{p0=__builtin_amdgcn_mfma_f32_32x32x16_bf16(b0,qr[d0],p0,0,0,0);p1=__builtin_amdgcn_mfma_f32_32x32x16_bf16(b1,qr[d0],p1,0,0,0);}}
}
typedef __attribute__((address_space(3))) const char* lds_cptr;
typedef short v4i16_t __attribute__((ext_vector_type(4)));
__device__ __forceinline__ void kload8(bf16x8*kf,lds_cptr kp){
  kf[0]=*(const __attribute__((address_space(3))) bf16x8*)(kp);      kf[1]=*(const __attribute__((address_space(3))) bf16x8*)(kp+512);
  kf[2]=*(const __attribute__((address_space(3))) bf16x8*)(kp+2048); kf[3]=*(const __attribute__((address_space(3))) bf16x8*)(kp+2560);
  kf[4]=*(const __attribute__((address_space(3))) bf16x8*)(kp+4096); kf[5]=*(const __attribute__((address_space(3))) bf16x8*)(kp+4608);
  kf[6]=*(const __attribute__((address_space(3))) bf16x8*)(kp+6144); kf[7]=*(const __attribute__((address_space(3))) bf16x8*)(kp+6656);
}
__device__ __forceinline__ void kload2(bf16x8*kf,lds_cptr kp,int j){ kf[2*j]=*(const __attribute__((address_space(3))) bf16x8*)(kp+j*2048); kf[2*j+1]=*(const __attribute__((address_space(3))) bf16x8*)(kp+j*2048+512); }
__device__ __forceinline__ s16x4 vtr(lds_cptr p){ return __builtin_bit_cast(s16x4,__builtin_amdgcn_ds_read_tr16_b64_v4i16((__attribute__((address_space(3))) v4i16_t*)p)); }
__device__ __forceinline__ float rowmax(const f32x16&p0,const f32x16&p1){
  float a=max3f(p0[0],p0[1],p1[0]),b=max3f(p0[2],p0[3],p1[1]);a=max3f(a,p1[2],p1[3]);
  #pragma unroll
  for(int r=4;r<16;r+=4){a=max3f(a,p0[r],p0[r+1]);b=max3f(b,p0[r+2],p0[r+3]);a=max3f(a,p1[r],p1[r+1]);b=max3f(b,p1[r+2],p1[r+3]);}
  const float m=max2f(a,b);
  auto rr=__builtin_amdgcn_permlane32_swap(__float_as_uint(m),__float_as_uint(m),false,false);
  return max2f(__uint_as_float(rr[0]),__uint_as_float(rr[1]));
}
__device__ __forceinline__ void pv(f32x16*o,int vb,bf16x8 pa0,bf16x8 pa1,bf16x8 pa2,bf16x8 pa3){
  #pragma unroll
  for(int d0=0;d0<2;++d0){s16x4 lo[4],hi[4];
    #pragma unroll
    for(int ks=0;ks<4;++ks){
      asm volatile("ds_read_b64_tr_b16 %0,%1 offset:%c2":"=&v"(lo[ks]):"v"(vb),"i"(d0*4096+ks*1024):"memory");
      asm volatile("ds_read_b64_tr_b16 %0,%1 offset:%c2":"=&v"(hi[ks]):"v"(vb),"i"(d0*4096+ks*1024+512):"memory");}
    asm volatile("s_waitcnt lgkmcnt(0)":::"memory");SBAR();
    #define PK(k) (bf16x8){lo[k][0],lo[k][1],lo[k][2],lo[k][3],hi[k][0],hi[k][1],hi[k][2],hi[k][3]}
    o[d0]=__builtin_amdgcn_mfma_f32_32x32x16_bf16(pa0,PK(0),o[d0],0,0,0);
    o[d0]=__builtin_amdgcn_mfma_f32_32x32x16_bf16(pa1,PK(1),o[d0],0,0,0);
    o[d0]=__builtin_amdgcn_mfma_f32_32x32x16_bf16(pa2,PK(2),o[d0],0,0,0);
    o[d0]=__builtin_amdgcn_mfma_f32_32x32x16_bf16(pa3,PK(3),o[d0],0,0,0);
    #undef PK
  }
}

#ifndef ATTN_STORE16
#define ATTN_STORE16(p,v) (*(u32x4*)(p)=(v))
#endif
template<int THRL> __device__ __forceinline__ void attn_unit(int b,int hq,int hv,int qb,const bf16*Q,const bf16*__restrict__ K,const bf16*__restrict__ V,bf16*O,char*shm){
  int tid_=threadIdx.x; asm volatile("":"+v"(tid_)); const int tid=tid_,lane=tid&63,r32=lane&31,hi=lane>>5; const int wid=__builtin_amdgcn_readfirstlane(tid>>6);
  const long rowbase=(long)b*SEQ; const int q0=qb*QB;
  const bf16*Qw=Q+(rowbase+q0+wid*QBLK)*DM+hq*D;
  const bf16*Kh=K+rowbase*DM+hq*D,*Vh=V+rowbase*DM+hv*D;
  const unsigned lds0=(unsigned)(uintptr_t)shm;
  float*wsf=(float*)(shm+LDS_WS)+wid*64;
  const bf16*ksrc=Kh+(long)lane*DM+wid*8;
  const bf16*vsrc=Vh+(long)(16*(wid&3)+(lane>>2))*DM+(wid>>2)*32+(lane&3)*8;
  const unsigned kdst=lds0+LDS_K+wid*1024, vdst=lds0+LDS_V+wid*1024;
  #define DMA_K(t,slot) glds16(ksrc+(long)(t)*KVBLK*DM,(unsigned)__builtin_amdgcn_readfirstlane(kdst+(slot)))
  #define DMA_V(t,slot) glds16(vsrc+(long)(t)*KVBLK*DM,(unsigned)__builtin_amdgcn_readfirstlane(vdst+(slot)))
  const int vb0=(int)(lds0+LDS_V)+((lane>>4)&1)*32+(lane&3)*8+(4*hi+((lane&15)>>2))*64;
  const char*Kbase=shm+LDS_K; bf16x8 kf[8];
  const lds_cptr shm3=(lds_cptr)shm; const lds_cptr kp0=shm3+LDS_K+hi*1024+r32*16; const lds_cptr vp0=shm3+LDS_V+((lane>>4)&1)*32+(lane&3)*8+(4*hi+((lane&15)>>2))*64;
  const int NT=(q0+QB)/KVBLK;
  DMA_K(0,0);DMA_V(0,0);DMA_K(1,SLOTB);
  bf16x8 qr[4];
  #pragma unroll
  for(int d0=0;d0<4;++d0)qr[d0]=*reinterpret_cast<const bf16x8*>(&Qw[(long)r32*DM+d0*16+hi*8]);
  float mhat=0.f,l_reg=0.f;f32x16 o[2];o[0]=f32x16{};o[1]=f32x16{};f32x16 negm=f32x16{};asm volatile("":"+v"(negm));
  const int qrel=wid*QBLK+r32;
  #define CMASK(P0,P1,t) do{int jb_=(t)-(NT-4); if(jb_>=0)cmask(P0,P1,jb_,qrel,hi);}while(0)
  bool resc=false;
  #define START(P0,P1) do{ const float rm=rowmax(P0,P1); resc=false; \
    { const float dl=rm; mhat=fadd_s(mhat,dl); \
      _Pragma("unroll") for(int r=0;r<16;++r){P0[r]=fsub_s(P0[r],dl);P1[r]=fsub_s(P1[r],dl);} \
      _Pragma("unroll") for(int r=0;r<16;++r)negm[r]=-mhat; asm volatile("":"+v"(negm)); } \
    _Pragma("unroll") for(int r=0;r<16;++r)P0[r]=__builtin_amdgcn_exp2f(P0[r]); }while(0)
  #define RESC() do{ if(resc){ asm volatile("s_waitcnt lgkmcnt(0)":::"memory"); \
      _Pragma("unroll") for(int d_=0;d_<2;++d_) _Pragma("unroll") for(int r=0;r<16;++r)o[d_][r]*=wsf[crow(r,hi)]; } }while(0)
  f32x16 pA0,pA1,pB0,pB1;
  int sl_prev=0,sl_cur=0,sl_next=SLOTB;
  #define ROT() do{sl_prev=sl_cur;sl_cur=sl_next;sl_next=(sl_next==(NSLOT-1)*SLOTB)?0:sl_next+SLOTB;}while(0)
  DMA_K(2,2*SLOTB);
  WAIT_BAR(3);
  qkt(pA0,pA1,Kbase,qr,negm,r32,hi);asm volatile("s_nop 15\n\ts_nop 7":"+v"(pA0),"+v"(pA1));CMASK(pA0,pA1,0);
  START(pA0,pA1);
  _Pragma("unroll") for(int r=0;r<16;++r)pA1[r]=__builtin_amdgcn_exp2f(pA1[r]);
  WAIT_BAR(0);
  DMA_K(3,0);DMA_V(1,SLOTB);
  ROT();
  kload8(kf,kp0+sl_cur);
  WAIT_BAR(2);
  s16x4 vlo[8],vhi[8]; u32x4 pw0,pw1,pw2,pw3;
  #define PKW(P,B) cvtpk_s(P[B],P[B+1])
  #define PAF(k) __builtin_bit_cast(bf16x8,pw##k)
  #define VFR(i) (bf16x8){vlo[i][0],vlo[i][1],vlo[i][2],vlo[i][3],vhi[i][0],vhi[i][1],vhi[i][2],vhi[i][3]}
  #define PIN(x) asm volatile("":"+v"(x))
  #define MX3(a,b,c) __builtin_fmaxf(__builtin_fmaxf((a),(b)),(c))
  #define GAPA(MF,A0,A1,A2,A3,W0,W1,PW) do{ MF; sacc+=A0; sacc+=A1; sacc+=A2; sacc+=A3; PIN(sacc); W0; W1; PIN(PW); SBAR(); }while(0)
  #define EX(v) __builtin_amdgcn_exp2f(v)
  #define GAPB(MF,X,B) do{ MF; X[B]=EX(X[B]); X[B+1]=EX(X[B+1]); X[B+2]=EX(X[B+2]); X[B+3]=EX(X[B+3]); PIN(X); SBAR(); }while(0)
  #define VRD(i) do{ vlo[i]=vtr(vp_+(((i)>>2)*4096+((i)&3)*1024)); vhi[i]=vtr(vp_+(((i)>>2)*4096+((i)&3)*1024+512)); }while(0)
  #define KRD(G,j) do{ if(G){ kload2(kf,kp0+sl_next,j); SBAR(); } }while(0)
  #define STEP(C0,C1,P0,P1,t,GK,GV,GL) do{ SBAR(); \
    const lds_cptr vp_=vp0+sl_prev; \
    VRD(0); SBAR(); float sacc=(P0[0]+P0[1]); \
    GAPA(C0=__builtin_amdgcn_mfma_f32_32x32x16_bf16(kf[0],qr[0],negm,0,0,0), P0[2],P0[3],P0[4],P0[5],     pw0[0]=PKW(P0,0), pw0[1]=PKW(P0,2), pw0); \
    VRD(4); SBAR(); GAPA(C1=__builtin_amdgcn_mfma_f32_32x32x16_bf16(kf[1],qr[0],negm,0,0,0), P0[6],P0[7],P0[8],P0[9],     pw0[2]=PKW(P0,4), pw0[3]=PKW(P0,6), pw0); \
    VRD(1); SBAR(); GAPA(C0=__builtin_amdgcn_mfma_f32_32x32x16_bf16(kf[2],qr[1],C0,0,0,0),   P0[10],P0[11],P0[12],P0[13], pw1[0]=PKW(P0,8), pw1[1]=PKW(P0,10), pw1); \
    VRD(5); SBAR(); GAPA(C1=__builtin_amdgcn_mfma_f32_32x32x16_bf16(kf[3],qr[1],C1,0,0,0),   P0[14],P0[15],P1[0],P1[1],   pw1[2]=PKW(P0,12),pw1[3]=PKW(P0,14), pw1); \
    VRD(2); SBAR(); GAPA(C0=__builtin_amdgcn_mfma_f32_32x32x16_bf16(kf[4],qr[2],C0,0,0,0),   P1[2],P1[3],P1[4],P1[5],     pw2[0]=PKW(P1,0), pw2[1]=PKW(P1,2), pw2); \
    VRD(6); SBAR(); GAPA(C1=__builtin_amdgcn_mfma_f32_32x32x16_bf16(kf[5],qr[2],C1,0,0,0),   P1[6],P1[7],P1[8],P1[9],     pw2[2]=PKW(P1,4), pw2[3]=PKW(P1,6), pw2); \
    VRD(3); SBAR(); GAPA(C0=__builtin_amdgcn_mfma_f32_32x32x16_bf16(kf[6],qr[3],C0,0,0,0),   P1[10],P1[11],P1[12],P1[13], pw3[0]=PKW(P1,8), pw3[1]=PKW(P1,10), pw3); \
    VRD(7); SBAR(); GAPA(C1=__builtin_amdgcn_mfma_f32_32x32x16_bf16(kf[7],qr[3],C1,0,0,0),   P1[14],P1[15],0.f,0.f,       pw3[2]=PKW(P1,12),pw3[3]=PKW(P1,14), pw3); \
    l_reg+=sacc; \
    if(GK){DMA_K((t)+3,sl_cur);} if(GV){DMA_V((t)+1,sl_next);} \
    CMASK(C0,C1,t); \
    { float a=MX3(C0[0],C0[1],C1[0]),b=MX3(C0[2],C0[3],C1[1]); a=MX3(a,C1[2],C1[3]); \
      _Pragma("unroll") for(int r=4;r<16;r+=4){a=MX3(a,C0[r],C0[r+1]);b=MX3(b,C0[r+2],C0[r+3]);a=MX3(a,C1[r],C1[r+1]);b=MX3(b,C1[r+2],C1[r+3]);} \
      float rm=__builtin_fmaxf(a,b); { auto rr=__builtin_amdgcn_permlane32_swap(__float_as_uint(rm),__float_as_uint(rm),false,false); rm=__builtin_fmaxf(__uint_as_float(rr[0]),__uint_as_float(rr[1])); } \
      resc=false; \
      if(__builtin_expect(__any(rm>(float)THRL),0)){ const float dl=__builtin_fmaxf(rm,0.f); mhat+=dl; \
        _Pragma("unroll") for(int r=0;r<16;++r){C0[r]-=dl;C1[r]-=dl;} \
        _Pragma("unroll") for(int r=0;r<16;++r)negm[r]=-mhat; asm volatile("":"+v"(negm)); \
        const float f=__builtin_amdgcn_exp2f(-dl); l_reg*=f; if(hi==0)wsf[r32]=f; resc=true; } } \
    SBAR(); \
    GAPB(o[0]=__builtin_amdgcn_mfma_f32_32x32x16_bf16(PAF(0),VFR(0),o[0],0,0,0), C0,0); \
    GAPB(o[1]=__builtin_amdgcn_mfma_f32_32x32x16_bf16(PAF(0),VFR(4),o[1],0,0,0), C0,4); \
    KRD(GL,0); GAPB(o[0]=__builtin_amdgcn_mfma_f32_32x32x16_bf16(PAF(1),VFR(1),o[0],0,0,0), C0,8); \
    KRD(GL,1); GAPB(o[1]=__builtin_amdgcn_mfma_f32_32x32x16_bf16(PAF(1),VFR(5),o[1],0,0,0), C0,12); \
    KRD(GL,2); GAPB(o[0]=__builtin_amdgcn_mfma_f32_32x32x16_bf16(PAF(2),VFR(2),o[0],0,0,0), C1,0); \
    KRD(GL,3); GAPB(o[1]=__builtin_amdgcn_mfma_f32_32x32x16_bf16(PAF(2),VFR(6),o[1],0,0,0), C1,4); \
    GAPB(o[0]=__builtin_amdgcn_mfma_f32_32x32x16_bf16(PAF(3),VFR(3),o[0],0,0,0), C1,8); \
    GAPB(o[1]=__builtin_amdgcn_mfma_f32_32x32x16_bf16(PAF(3),VFR(7),o[1],0,0,0), C1,12); \
    }while(0)
  int t=1;
  #undef CMASK
  #define CMASK(P0,P1,t) do{}while(0)
  for(;t+5<NT;t+=2){
    STEP(pB0,pB1,pA0,pA1,t,true,true,true);     WAIT_BAR(2); RESC(); ROT();
    STEP(pA0,pA1,pB0,pB1,t+1,true,true,true);   WAIT_BAR(2); RESC(); ROT();
  }
  #undef CMASK
  #define CMASK(P0,P1,t) do{int jb_=(t)-(NT-4); if(jb_>=0)cmask(P0,P1,jb_,qrel,hi);}while(0)
  #define ENDW(tt) do{ if((tt)+3<NT){WAIT_BAR(2);} else if((tt)+2<NT){WAIT_BAR(1);} else {WAIT_BAR(0);} }while(0)
  for(;t+1<NT;t+=2){
    STEP(pB0,pB1,pA0,pA1,t,(t+3<NT),(t+1<NT),(t+1<NT));       ENDW(t);   RESC(); ROT();
    STEP(pA0,pA1,pB0,pB1,t+1,(t+4<NT),(t+2<NT),(t+2<NT));     ENDW(t+1); RESC(); ROT();
  }
  STEP(pB0,pB1,pA0,pA1,NT-1,false,false,false); RESC();
  { float sacc=pB0[0]+pB0[1]; _Pragma("unroll") for(int r=2;r<16;++r)sacc+=pB0[r]; _Pragma("unroll") for(int r=0;r<16;++r)sacc+=pB1[r]; l_reg+=sacc;
    pw0=(u32x4){PKW(pB0,0),PKW(pB0,2),PKW(pB0,4),PKW(pB0,6)};pw1=(u32x4){PKW(pB0,8),PKW(pB0,10),PKW(pB0,12),PKW(pB0,14)};pw2=(u32x4){PKW(pB1,0),PKW(pB1,2),PKW(pB1,4),PKW(pB1,6)};pw3=(u32x4){PKW(pB1,8),PKW(pB1,10),PKW(pB1,12),PKW(pB1,14)};
    SBAR(); pv(o,vb0+sl_cur,PAF(0),PAF(1),PAF(2),PAF(3)); }
  #undef PKW
  #undef PAF
  #undef VFR
  #undef PIN
  #undef MX3
  #undef GAPA
  #undef GAPB
  #undef EX
  #undef VRD
  #undef KRD
  #undef STEP
  #undef ENDW
  {auto rr=__builtin_amdgcn_permlane32_swap(__float_as_uint(l_reg),__float_as_uint(l_reg),false,false);l_reg=__uint_as_float(rr[0])+__uint_as_float(rr[1]);}
  if(hi==0)wsf[32+r32]=l_reg;asm volatile("s_waitcnt lgkmcnt(0)":::"memory");
  float rli[16];
  #pragma unroll
  for(int r=0;r<16;++r)rli[r]=__builtin_amdgcn_rcpf(wsf[32+crow(r,hi)]);
  bf16*Ow=O+(rowbase+q0+wid*QBLK)*DM+hv*D;
  { bf16*stg=(bf16*)(shm+LDS_OST)+wid*2048;
    #pragma unroll
    for(int r=0;r<16;++r){const int orow=crow(r,hi);
      #pragma unroll
      for(int d0=0;d0<2;++d0)stg[orow*64+d0*32+r32]=__float2bfloat16(o[d0][r]*rli[r]);}
    asm volatile("s_waitcnt lgkmcnt(0)":::"memory");
    #pragma unroll
    for(int i=0;i<4;++i){const int row=i*8+(lane>>3),ch=lane&7; const u32x4 v=*(const u32x4*)(stg+row*64+ch*8); ATTN_STORE16(Ow+(long)row*DM+ch*8,v);} }
  asm volatile("s_waitcnt lgkmcnt(0)\n\ts_barrier":::"memory");
  #undef DMA_K
  #undef DMA_V
  #undef CMASK
  #undef START
  #undef RESC
  #undef ROT
}
constexpr int ATTN_LDS_BYTES=LDS_BYTES;
struct DiffTensorsV { const bf16* Q; const bf16* K; const bf16* V; bf16* O0; bf16* O1; };
template<int THRL=8> __device__ __forceinline__ void diff_attn_phase(char*lds,const DiffTensorsV&T,int vcu,int G){
  for(int pr=vcu>>1; pr<BATCH*32; pr+=(G>>1)){
    const int s=vcu&1, b=pr>>5, h=(pr>>2)&7, c=(pr>>1)&1, vh=pr&1;
    for(int j=15;j>=0;--j){ const int qb=2*j+((j&1)?1-s:s);
      attn_unit<THRL>(b,2*h+c,2*h+vh,qb,T.Q,T.K,T.V,c?T.O1:T.O0,lds); } }
}
constexpr int VSLOTB=16384;
constexpr int L2_K=0, L2_V=NSLOT*SLOTB, L2_WS=L2_V+NSLOT*VSLOTB, L2_OST=L2_WS+NW*64*4, L2_Q=L2_OST+NW*4096, L2_BYTES=L2_Q+NW*4096;
template<int THRL> __device__ __forceinline__ void attn_unit128(int b,int hq,int h,int qb,const bf16*Q,const bf16*__restrict__ K,const bf16*__restrict__ V,bf16*O,bf16*OB,int cmap,float lam,const float*subw,char*shm){
  int tid_=threadIdx.x; asm volatile("":"+v"(tid_)); const int tid=tid_,lane=tid&63,r32=lane&31,hi=lane>>5; const int wid=__builtin_amdgcn_readfirstlane(tid>>6);
  const long rowbase=(long)b*SEQ; const int q0=qb*QB;
  const bf16*Qw=Q+(rowbase+q0+wid*QBLK)*DM+hq*D;
  const bf16*Kh=K+rowbase*DM+hq*D,*Vh=V+rowbase*DM+h*128;
  const unsigned lds0=(unsigned)(uintptr_t)shm;
  float*wsf=(float*)(shm+L2_WS)+wid*64;
  const bf16*ksrc=Kh+(long)lane*DM+wid*8;
  const bf16*vsrc=Vh+(long)(16*(wid&3)+(lane>>2))*DM+(wid>>2)*32+(lane&3)*8;
  const unsigned kdst=lds0+L2_K+wid*1024, vdst=lds0+L2_V+wid*1024;
  #define DMA_K(t,slot) glds16(ksrc+(long)(t)*KVBLK*DM,(unsigned)__builtin_amdgcn_readfirstlane(kdst+(slot)))
  #define DMA_V(t,slot) do{ glds16(vsrc+(long)(t)*KVBLK*DM,(unsigned)__builtin_amdgcn_readfirstlane(vdst+2*(slot))); glds16(vsrc+(long)(t)*KVBLK*DM+64,(unsigned)__builtin_amdgcn_readfirstlane(vdst+2*(slot)+8192)); }while(0)
  const int vb0=(int)(lds0+L2_V)+((lane>>4)&1)*32+(lane&3)*8+(4*hi+((lane&15)>>2))*64;
  bf16x8 kf[8];
  const lds_cptr shm3=(lds_cptr)shm; const lds_cptr kp0=shm3+L2_K+hi*1024+r32*16; const lds_cptr vp0=shm3+L2_V+((lane>>4)&1)*32+(lane&3)*8+(4*hi+((lane&15)>>2))*64;
  typedef __attribute__((address_space(3))) char* lds_ptr;
  const lds_ptr qp=(lds_ptr)shm+L2_Q+wid*4096+lane*16;
  #define QF(d0) (*(const __attribute__((address_space(3))) bf16x8*)(qp+(d0)*1024))
  const int NT=(q0+QB)/KVBLK;
  DMA_K(0,0);DMA_V(0,0);DMA_K(1,SLOTB);
  { bf16x8 q4[4];
    #pragma unroll
    for(int d0=0;d0<4;++d0)q4[d0]=*reinterpret_cast<const bf16x8*>(&Qw[(long)r32*DM+d0*16+hi*8]);
    #pragma unroll
    for(int d0=0;d0<4;++d0)*(__attribute__((address_space(3))) bf16x8*)(qp+d0*1024)=q4[d0]; }
  float zf=0.f; asm volatile("":"+v"(zf));
  float mhat=0.f,l_reg=0.f;f32x16 o[4];
  _Pragma("unroll") for(int d_=0;d_<4;++d_) _Pragma("unroll") for(int r=0;r<16;++r)o[d_][r]=zf;
  f32x16 negm; _Pragma("unroll") for(int r=0;r<16;++r)negm[r]=zf; asm volatile("":"+v"(negm));
  const int qrel=wid*QBLK+r32;
  #define CMASK(P0,P1,t) do{int jb_=(t)-(NT-4); if(jb_>=0)cmask(P0,P1,jb_,qrel,hi);}while(0)
  bool resc=false;
  #define RESC() do{ if(resc){ asm volatile("s_waitcnt lgkmcnt(0)":::"memory"); \
      _Pragma("unroll") for(int d_=0;d_<4;++d_) _Pragma("unroll") for(int r=0;r<16;++r)o[d_][r]*=wsf[crow(r,hi)]; } }while(0)
  f32x16 pA0,pA1,pB0,pB1;
  int sl_prev=0,sl_cur=0,sl_next=SLOTB;
  #define ROT() do{sl_prev=sl_cur;sl_cur=sl_next;sl_next=(sl_next==(NSLOT-1)*SLOTB)?0:sl_next+SLOTB;}while(0)
  DMA_K(2,2*SLOTB);
  WAIT_BAR(4);
  { bf16x8 kq[8]; kload8(kq,kp0);
    pA0=__builtin_amdgcn_mfma_f32_32x32x16_bf16(kq[0],QF(0),negm,0,0,0);pA1=__builtin_amdgcn_mfma_f32_32x32x16_bf16(kq[1],QF(0),negm,0,0,0);
    #pragma unroll
    for(int d0=1;d0<4;++d0){pA0=__builtin_amdgcn_mfma_f32_32x32x16_bf16(kq[2*d0],QF(d0),pA0,0,0,0);pA1=__builtin_amdgcn_mfma_f32_32x32x16_bf16(kq[2*d0+1],QF(d0),pA1,0,0,0);} }
  asm volatile("s_nop 15\n\ts_nop 7":"+v"(pA0),"+v"(pA1));CMASK(pA0,pA1,0);
  { const float rm=rowmax(pA0,pA1); mhat=rm;
    _Pragma("unroll") for(int r=0;r<16;++r){pA0[r]=__builtin_amdgcn_exp2f(pA0[r]-mhat);pA1[r]=__builtin_amdgcn_exp2f(pA1[r]-mhat);}
    _Pragma("unroll") for(int r=0;r<16;++r)negm[r]=-mhat; asm volatile("":"+v"(negm)); }
  WAIT_BAR(0);
  DMA_K(3,0);DMA_V(1,SLOTB);
  ROT();
  kload8(kf,kp0+sl_cur);
  WAIT_BAR(3);
  s16x4 vlo[8],vhi[8]; u32x4 pw0,pw1,pw2,pw3;
  #define PKW(P,B) cvtpk_s(P[B],P[B+1])
  #define PAF(k) __builtin_bit_cast(bf16x8,pw##k)
  #define VFR(i) (bf16x8){vlo[i][0],vlo[i][1],vlo[i][2],vlo[i][3],vhi[i][0],vhi[i][1],vhi[i][2],vhi[i][3]}
  #define PIN(x) asm volatile("":"+v"(x))
  #define MX3(a,b,c) __builtin_fmaxf(__builtin_fmaxf((a),(b)),(c))
  #define GAPA(MF,A0,A1,A2,A3,W0,W1,PW) do{ MF; sacc+=A0; sacc+=A1; sacc+=A2; sacc+=A3; PIN(sacc); W0; W1; PIN(PW); SBAR(); }while(0)
  #define EX(v) __builtin_amdgcn_exp2f(v)
  #define GAPB(MF,X,B) do{ MF; X[B]=EX(X[B]); X[B+1]=EX(X[B+1]); PIN(X); SBAR(); }while(0)
  #define VRD(i) do{ vlo[(i)&7]=vtr(vp_+(((i)>>2)*4096+((i)&3)*1024)); vhi[(i)&7]=vtr(vp_+(((i)>>2)*4096+((i)&3)*1024+512)); }while(0)
  #define KRD(G,j) do{ if(G){ kload2(kf,kp0+sl_next,j); SBAR(); } }while(0)
  #define STEP(C0,C1,P0,P1,t,GK,GV,GL) do{ SBAR(); \
    const lds_cptr vp_=vp0+2*sl_prev; bf16x8 qa=QF(0),qb_=QF(1); \
    VRD(0); SBAR(); float sacc=(P0[0]+P0[1]); \
    GAPA(C0=__builtin_amdgcn_mfma_f32_32x32x16_bf16(kf[0],qa,negm,0,0,0), P0[2],P0[3],P0[4],P0[5],     pw0[0]=PKW(P0,0), pw0[1]=PKW(P0,2), pw0); \
    VRD(4); SBAR(); GAPA(C1=__builtin_amdgcn_mfma_f32_32x32x16_bf16(kf[1],qa,negm,0,0,0), P0[6],P0[7],P0[8],P0[9],     pw0[2]=PKW(P0,4), pw0[3]=PKW(P0,6), pw0); \
    qa=QF(2); VRD(1); SBAR(); GAPA(C0=__builtin_amdgcn_mfma_f32_32x32x16_bf16(kf[2],qb_,C0,0,0,0),   P0[10],P0[11],P0[12],P0[13], pw1[0]=PKW(P0,8), pw1[1]=PKW(P0,10), pw1); \
    VRD(5); SBAR(); GAPA(C1=__builtin_amdgcn_mfma_f32_32x32x16_bf16(kf[3],qb_,C1,0,0,0),   P0[14],P0[15],P1[0],P1[1],   pw1[2]=PKW(P0,12),pw1[3]=PKW(P0,14), pw1); \
    qb_=QF(3); VRD(2); SBAR(); GAPA(C0=__builtin_amdgcn_mfma_f32_32x32x16_bf16(kf[4],qa,C0,0,0,0),   P1[2],P1[3],P1[4],P1[5],     pw2[0]=PKW(P1,0), pw2[1]=PKW(P1,2), pw2); \
    VRD(6); SBAR(); GAPA(C1=__builtin_amdgcn_mfma_f32_32x32x16_bf16(kf[5],qa,C1,0,0,0),   P1[6],P1[7],P1[8],P1[9],     pw2[2]=PKW(P1,4), pw2[3]=PKW(P1,6), pw2); \
    VRD(3); SBAR(); GAPA(C0=__builtin_amdgcn_mfma_f32_32x32x16_bf16(kf[6],qb_,C0,0,0,0),   P1[10],P1[11],P1[12],P1[13], pw3[0]=PKW(P1,8), pw3[1]=PKW(P1,10), pw3); \
    VRD(7); SBAR(); GAPA(C1=__builtin_amdgcn_mfma_f32_32x32x16_bf16(kf[7],qb_,C1,0,0,0),   P1[14],P1[15],0.f,0.f,       pw3[2]=PKW(P1,12),pw3[3]=PKW(P1,14), pw3); \
    l_reg+=sacc; \
    if(GK){DMA_K((t)+3,sl_cur);} if(GV){DMA_V((t)+1,sl_next);} \
    CMASK(C0,C1,t); \
    { float a=MX3(C0[0],C0[1],C1[0]),b=MX3(C0[2],C0[3],C1[1]); a=MX3(a,C1[2],C1[3]); \
      _Pragma("unroll") for(int r=4;r<16;r+=4){a=MX3(a,C0[r],C0[r+1]);b=MX3(b,C0[r+2],C0[r+3]);a=MX3(a,C1[r],C1[r+1]);b=MX3(b,C1[r+2],C1[r+3]);} \
      float rm=__builtin_fmaxf(a,b); { auto rr=__builtin_amdgcn_permlane32_swap(__float_as_uint(rm),__float_as_uint(rm),false,false); rm=__builtin_fmaxf(__uint_as_float(rr[0]),__uint_as_float(rr[1])); } \
      resc=false; \
      if(__builtin_expect(__any(rm>(float)THRL),0)){ const float dl=__builtin_fmaxf(rm,0.f); mhat+=dl; \
        _Pragma("unroll") for(int r=0;r<16;++r){C0[r]-=dl;C1[r]-=dl;} \
        _Pragma("unroll") for(int r=0;r<16;++r)negm[r]=-mhat; asm volatile("":"+v"(negm)); \
        const float f=__builtin_amdgcn_exp2f(-dl); l_reg*=f; if(hi==0)wsf[r32]=f; resc=true; } } \
    SBAR(); \
    GAPB(o[0]=__builtin_amdgcn_mfma_f32_32x32x16_bf16(PAF(0),VFR(0),o[0],0,0,0), C0,0);  VRD(8);  SBAR(); \
    GAPB(o[1]=__builtin_amdgcn_mfma_f32_32x32x16_bf16(PAF(0),VFR(4),o[1],0,0,0), C0,2);  VRD(12); SBAR(); \
    KRD(GL,0); GAPB(o[0]=__builtin_amdgcn_mfma_f32_32x32x16_bf16(PAF(1),VFR(1),o[0],0,0,0), C0,4);  VRD(9);  SBAR(); \
    KRD(GL,1); GAPB(o[1]=__builtin_amdgcn_mfma_f32_32x32x16_bf16(PAF(1),VFR(5),o[1],0,0,0), C0,6);  VRD(13); SBAR(); \
    KRD(GL,2); GAPB(o[0]=__builtin_amdgcn_mfma_f32_32x32x16_bf16(PAF(2),VFR(2),o[0],0,0,0), C0,8);  VRD(10); SBAR(); \
    KRD(GL,3); GAPB(o[1]=__builtin_amdgcn_mfma_f32_32x32x16_bf16(PAF(2),VFR(6),o[1],0,0,0), C0,10); VRD(14); SBAR(); \
    GAPB(o[0]=__builtin_amdgcn_mfma_f32_32x32x16_bf16(PAF(3),VFR(3),o[0],0,0,0), C0,12); VRD(11); SBAR(); \
    GAPB(o[1]=__builtin_amdgcn_mfma_f32_32x32x16_bf16(PAF(3),VFR(7),o[1],0,0,0), C0,14); VRD(15); SBAR(); \
    GAPB(o[2]=__builtin_amdgcn_mfma_f32_32x32x16_bf16(PAF(0),VFR(0),o[2],0,0,0), C1,0); \
    GAPB(o[3]=__builtin_amdgcn_mfma_f32_32x32x16_bf16(PAF(0),VFR(4),o[3],0,0,0), C1,2); \
    GAPB(o[2]=__builtin_amdgcn_mfma_f32_32x32x16_bf16(PAF(1),VFR(1),o[2],0,0,0), C1,4); \
    GAPB(o[3]=__builtin_amdgcn_mfma_f32_32x32x16_bf16(PAF(1),VFR(5),o[3],0,0,0), C1,6); \
    GAPB(o[2]=__builtin_amdgcn_mfma_f32_32x32x16_bf16(PAF(2),VFR(2),o[2],0,0,0), C1,8); \
    GAPB(o[3]=__builtin_amdgcn_mfma_f32_32x32x16_bf16(PAF(2),VFR(6),o[3],0,0,0), C1,10); \
    GAPB(o[2]=__builtin_amdgcn_mfma_f32_32x32x16_bf16(PAF(3),VFR(3),o[2],0,0,0), C1,12); \
    GAPB(o[3]=__builtin_amdgcn_mfma_f32_32x32x16_bf16(PAF(3),VFR(7),o[3],0,0,0), C1,14); \
    }while(0)
  int t=1;
  #undef CMASK
  #define CMASK(P0,P1,t) do{}while(0)
  for(;t+5<NT;t+=2){
    STEP(pB0,pB1,pA0,pA1,t,true,true,true);     WAIT_BAR(3); RESC(); ROT();
    STEP(pA0,pA1,pB0,pB1,t+1,true,true,true);   WAIT_BAR(3); RESC(); ROT();
  }
  #undef CMASK
  #define CMASK(P0,P1,t) do{int jb_=(t)-(NT-4); if(jb_>=0)cmask(P0,P1,jb_,qrel,hi);}while(0)
  #define ENDW(tt) do{ if((tt)+3<NT){WAIT_BAR(3);} else if((tt)+2<NT){WAIT_BAR(2);} else {WAIT_BAR(0);} }while(0)
  for(;t+1<NT;t+=2){
    STEP(pB0,pB1,pA0,pA1,t,(t+3<NT),(t+1<NT),(t+1<NT));       ENDW(t);   RESC(); ROT();
    STEP(pA0,pA1,pB0,pB1,t+1,(t+4<NT),(t+2<NT),(t+2<NT));     ENDW(t+1); RESC(); ROT();
  }
  STEP(pB0,pB1,pA0,pA1,NT-1,false,false,false); RESC();
  { float sacc=pB0[0]+pB0[1]; _Pragma("unroll") for(int r=2;r<16;++r)sacc+=pB0[r]; _Pragma("unroll") for(int r=0;r<16;++r)sacc+=pB1[r]; l_reg+=sacc;
    pw0=(u32x4){PKW(pB0,0),PKW(pB0,2),PKW(pB0,4),PKW(pB0,6)};pw1=(u32x4){PKW(pB0,8),PKW(pB0,10),PKW(pB0,12),PKW(pB0,14)};pw2=(u32x4){PKW(pB1,0),PKW(pB1,2),PKW(pB1,4),PKW(pB1,6)};pw3=(u32x4){PKW(pB1,8),PKW(pB1,10),PKW(pB1,12),PKW(pB1,14)};
    SBAR();
    const int vb=vb0+2*sl_cur;
    #pragma unroll
    for(int d0=0;d0<4;++d0){s16x4 lo[4],hi4[4];
      #pragma unroll
      for(int ks=0;ks<4;++ks){
        asm volatile("ds_read_b64_tr_b16 %0,%1 offset:%c2":"=&v"(lo[ks]):"v"(vb),"i"(d0*4096+ks*1024):"memory");
        asm volatile("ds_read_b64_tr_b16 %0,%1 offset:%c2":"=&v"(hi4[ks]):"v"(vb),"i"(d0*4096+ks*1024+512):"memory");}
      asm volatile("s_waitcnt lgkmcnt(0)":::"memory");SBAR();
      #define PK(k) (bf16x8){lo[k][0],lo[k][1],lo[k][2],lo[k][3],hi4[k][0],hi4[k][1],hi4[k][2],hi4[k][3]}
      o[d0]=__builtin_amdgcn_mfma_f32_32x32x16_bf16(PAF(0),PK(0),o[d0],0,0,0);
      o[d0]=__builtin_amdgcn_mfma_f32_32x32x16_bf16(PAF(1),PK(1),o[d0],0,0,0);
      o[d0]=__builtin_amdgcn_mfma_f32_32x32x16_bf16(PAF(2),PK(2),o[d0],0,0,0);
      o[d0]=__builtin_amdgcn_mfma_f32_32x32x16_bf16(PAF(3),PK(3),o[d0],0,0,0);
      #undef PK
    } }
  #undef PKW
  #undef PAF
  #undef VFR
  #undef PIN
  #undef MX3
  #undef GAPA
  #undef GAPB
  #undef EX
  #undef VRD
  #undef KRD
  #undef STEP
  #undef ENDW
  #undef QF
  {auto rr=__builtin_amdgcn_permlane32_swap(__float_as_uint(l_reg),__float_as_uint(l_reg),false,false);l_reg=__uint_as_float(rr[0])+__uint_as_float(rr[1]);}
  if(hi==0)wsf[32+r32]=l_reg;asm volatile("s_waitcnt lgkmcnt(0)":::"memory");
  float rli[16];
  #pragma unroll
  for(int r=0;r<16;++r)rli[r]=__builtin_amdgcn_rcpf(wsf[32+crow(r,hi)]);
  bf16*Ow=O+(rowbase+q0+wid*QBLK)*DM+h*128;
  { bf16*stg=(bf16*)(shm+L2_OST)+wid*2048;
    if(cmap==0){
    #pragma unroll
    for(int ps=0;ps<2;++ps){
      #pragma unroll
      for(int r=0;r<16;++r){const int orow=crow(r,hi);
        #pragma unroll
        for(int d0=0;d0<2;++d0)stg[orow*64+d0*32+r32]=__float2bfloat16(o[2*ps+d0][r]*rli[r]);}
      asm volatile("s_waitcnt lgkmcnt(0)":::"memory");
      #pragma unroll
      for(int i=0;i<4;++i){const int row=i*8+(lane>>3),ch=lane&7; const u32x4 v=*(const u32x4*)(stg+row*64+ch*8); ATTN_STORE16(Ow+(long)row*DM+ps*64+ch*8,v);}
      asm volatile("s_waitcnt lgkmcnt(0)":::"memory"); }
    } else {
    signed char*OBw=(signed char*)OB+(rowbase+q0+wid*QBLK)*DM+h*128;
    float dv[2][4][8]; float ssq[4]={0.f,0.f,0.f,0.f};
    u32x4 av[2][4]; f32x4a swv[2][2];
    #pragma unroll
    for(int ps=0;ps<2;++ps){
      #pragma unroll
      for(int i=0;i<4;++i) av[ps][i]=__builtin_nontemporal_load((const u32x4*)(Ow+(long)(i*8+(lane>>3))*DM+ps*64+(lane&7)*8));
      swv[ps][0]=*(const f32x4a*)(subw+ps*64+(lane&7)*8); swv[ps][1]=*(const f32x4a*)(subw+ps*64+(lane&7)*8+4); }
    #pragma unroll
    for(int ps=0;ps<2;++ps){
      #pragma unroll
      for(int r=0;r<16;++r){const int orow=crow(r,hi);
        #pragma unroll
        for(int d0=0;d0<2;++d0)stg[orow*64+d0*32+r32]=__float2bfloat16(o[2*ps+d0][r]*rli[r]);}
      asm volatile("s_waitcnt lgkmcnt(0)":::"memory");
      #pragma unroll
      for(int i=0;i<4;++i){const int row=i*8+(lane>>3),ch=lane&7; const u32x4 v=*(const u32x4*)(stg+row*64+ch*8);
        const u32x4 a=av[ps][i];
        const unsigned aw[4]={a.x,a.y,a.z,a.w}, vw[4]={v.x,v.y,v.z,v.w};
        #pragma unroll
        for(int e=0;e<4;++e){ const float d0=__uint_as_float(aw[e]<<16)-lam*__uint_as_float(vw[e]<<16), d1=__uint_as_float(aw[e]&0xffff0000u)-lam*__uint_as_float(vw[e]&0xffff0000u);
          dv[ps][i][2*e]=d0; dv[ps][i][2*e+1]=d1; ssq[i]+=d0*d0+d1*d1; } }
      asm volatile("s_waitcnt lgkmcnt(0)":::"memory"); }
    #pragma unroll
    for(int i=0;i<4;++i){ float ss=ssq[i]; ss+=__shfl_xor(ss,1); ss+=__shfl_xor(ss,2); ss+=__shfl_xor(ss,4);
      const float rstd=1.0f/sqrtf(ss*(1.0f/128.0f)+1e-5f);
      #pragma unroll
      for(int ps=0;ps<2;++ps){ const int row=i*8+(lane>>3),ch=lane&7; const float sw[8]={swv[ps][0].x,swv[ps][0].y,swv[ps][0].z,swv[ps][0].w,swv[ps][1].x,swv[ps][1].y,swv[ps][1].z,swv[ps][1].w}; u32x4 w;
        const float rq=rstd*OB_QINV;
        const unsigned q0_=pack4_i8(dv[ps][i][0]*rq*sw[0],dv[ps][i][1]*rq*sw[1],dv[ps][i][2]*rq*sw[2],dv[ps][i][3]*rq*sw[3]), q1_=pack4_i8(dv[ps][i][4]*rq*sw[4],dv[ps][i][5]*rq*sw[5],dv[ps][i][6]*rq*sw[6],dv[ps][i][7]*rq*sw[7]);
        (void)w; *(u32x2*)((signed char*)OBw+(long)row*DM+ps*64+ch*8)=(u32x2){q0_,q1_}; } }
    } }
  asm volatile("s_waitcnt lgkmcnt(0)\n\ts_barrier":::"memory");
  #undef DMA_K
  #undef DMA_V
  #undef CMASK
  #undef RESC
  #undef ROT
}
struct DiffTensors { const bf16* Q; const bf16* K; const bf16* V; bf16* O0; bf16* OB; const float* lam; const float* subw; float lam_init; };
template<int THRL=8> __device__ __forceinline__ void diff_attn_phase128(char*lds,const DiffTensors&T,int vcu,int G){
  const int lane=threadIdx.x&63;
  float l1=T.lam[lane]*T.lam[64+lane], l2=T.lam[128+lane]*T.lam[192+lane];
  #pragma unroll
  for(int o=1;o<64;o<<=1){ l1+=__shfl_xor(l1,o); l2+=__shfl_xor(l2,o); }
  const float lam_full=expf(l1)-expf(l2)+T.lam_init;
  for(int bh=vcu>>3; bh<BATCH*8; bh+=(G>>3)){
    const int s=vcu&7, b=bh>>3, h=bh&7;
    for(int j=3;j>=0;--j){ const int qb=(j==0)?s:(j==1)?15-s:(j==2)?16+s:31-s;
      attn_unit128<THRL>(b,2*h,h,qb,T.Q,T.K,T.V,T.O0,T.OB,0,lam_full,T.subw,lds);
      attn_unit128<THRL>(b,2*h+1,h,qb,T.Q,T.K,T.V,T.O0,T.OB,1,lam_full,T.subw,lds); } }
}
#undef SBAR
#undef WAIT_BAR
}

constexpr int NB = 4, SEQ = 8192, T = NB * SEQ, D = 1024;
constexpr int NE = 32, TOPK = 4;
constexpr int GLA_H = 4, GLA_DK = 128, GLA_DV = 256, GLA_C = 64, GLA_RUN = 8, GLA_NRUN = SEQ / (GLA_C * GLA_RUN), GLA_UNITS = NB * GLA_H * GLA_NRUN;
constexpr int NQKVR = 3072, LDW_IN = 3088;
constexpr float LN_EPS = 1e-5f, RMS_EPS = 1e-5f, DN_ALPHA = 1.4142135623730951f;
constexpr float LAMBDA_INIT = 0.35550906759096926f;
constexpr int NPAN_MAX = 544, NPAD_MAX = NPAN_MAX * 256;
constexpr int NWAVES = 8, NTHR = 512;
constexpr int NPHASE = 20;
#ifndef MK_N_LAUNCHES
#define MK_N_LAUNCHES 1
#endif
constexpr int N_LAUNCHES = MK_N_LAUNCHES;

constexpr size_t MiB = 1u << 20;
constexpr size_t WS_CTL = 0, CTL_ZERO_BYTES = 1 * MiB;
constexpr size_t WS_META = 2 * MiB;
constexpr size_t WS_TOPI = WS_META, WS_TOPG = WS_META + MiB / 2, WS_LRANK = WS_META + MiB, WS_SLOT = WS_META + 3 * MiB / 2, WS_CNT = WS_META + 2 * MiB, WS_PEXP = WS_META + 2 * MiB + MiB / 4;
constexpr size_t WS_SWD = WS_META + 2 * MiB + MiB / 2 + 8192, WS_SACT = WS_META + 2 * MiB + MiB / 2 + 12288;
constexpr size_t WS_SWKVQ = WS_META + 2 * MiB + MiB / 2 + 20480;
constexpr size_t WS_SWAO = WS_META + 2 * MiB + MiB / 2 + 24576, WS_SWBO = WS_META + 2 * MiB + MiB / 2 + 28672;
constexpr float OG_QS = 8.0f / 127.0f, OB_QS = 1.0f / attn_body::OB_QINV;
constexpr size_t WS_SWIN = WS_META + 2 * MiB + MiB / 2 + 16384;
constexpr size_t WS_SWQ = WS_META + 2 * MiB + MiB / 2 + 4096;
constexpr size_t WS_SUBW = WS_META + 2 * MiB + MiB / 2;
constexpr size_t WS_SROW = WS_META + 13 * MiB;
constexpr size_t WS_GKLOW = WS_META + 3 * MiB, WS_COS = WS_META + 5 * MiB, WS_SIN = WS_META + 9 * MiB;
constexpr size_t WS_WIN = 16 * MiB, WS_WAO = 22 * MiB, WS_WKVQ = 24 * MiB, WS_WBO = 30 * MiB, WS_WGU = 32 * MiB, WS_WD = 288 * MiB;
constexpr size_t WS_XB = 416 * MiB;
constexpr size_t WS_Y = 480 * MiB;
constexpr size_t WS_X1 = 608 * MiB;
constexpr size_t WS_X1Q = 608 * MiB, WS_SX = 640 * MiB, WS_SXS = 641 * MiB;
constexpr size_t WS_X1B = 736 * MiB;
constexpr size_t WS_X2 = 800 * MiB;
constexpr size_t WS_X2Q = 800 * MiB, WS_SX2 = 832 * MiB;
constexpr size_t WS_X2B = 928 * MiB;
constexpr size_t WS_M = 992 * MiB;
constexpr size_t WS_XG = WS_M, WS_ACT = WS_M + 272 * MiB, WS_YB = WS_M + 544 * MiB;
constexpr size_t WS_QKVR = WS_M, WS_OLOC = WS_M + 192 * MiB, WS_QDEC = WS_M + 320 * MiB, WS_SEND = WS_M + 352 * MiB, WS_SINIT = WS_M + 384 * MiB, WS_GSUM = WS_M + 400 * MiB, WS_OG = WS_M + 408 * MiB;
constexpr size_t WS_KB = WS_M, WS_VB = WS_M + 64 * MiB, WS_QB = WS_M + 128 * MiB, WS_O0 = WS_M + 192 * MiB, WS_O1 = WS_M + 256 * MiB, WS_OB = WS_M + 320 * MiB;
constexpr size_t WS_END = 1808 * MiB;
constexpr int CW_BAR = 4096;

constexpr int PHASE_LDS = 155648;
constexpr int MISC_OFF = PHASE_LDS, LDS_BYTES = PHASE_LDS + 512;
#define GAS __attribute__((address_space(1)))
#define LAS __attribute__((address_space(3)))
typedef unsigned short bf16;
typedef unsigned v4u __attribute__((ext_vector_type(4)));
typedef float f32x4 __attribute__((ext_vector_type(4)));
typedef short bf16x8 __attribute__((ext_vector_type(8)));
typedef GAS unsigned gu32;
typedef GAS unsigned long long gu64;
#define RLX_AGENT __ATOMIC_RELAXED, __HIP_MEMORY_SCOPE_AGENT
#define LDS_WAIT() asm volatile("s_waitcnt lgkmcnt(0)" ::: "memory")
#define VM_WAIT() asm volatile("s_waitcnt vmcnt(0)" ::: "memory")
__device__ __forceinline__ unsigned long long rt() { return __builtin_amdgcn_s_memrealtime(); }
__device__ __forceinline__ unsigned f2bf(float f) { unsigned u = __builtin_bit_cast(unsigned, f); return (u + 0x7fffu + ((u >> 16) & 1u)) >> 16; }
__device__ __forceinline__ unsigned pk2(float lo, float hi) { return f2bf(lo) | (f2bf(hi) << 16); }

#define XB_TMO      128
#define XB_XCNT(j)  (256  + 64 * (j))
#define XB_XSUB(j)  (1280 + 64 * (j))
#define XB_XGEN(j)  (2304 + 64 * (j))
#define XB_TOP      3328
#define XB_TOPGEN   3392
#define XCD_BAR_WORDS 3456
#define XB_SPIN_CAP (1u << 18)

__device__ __forceinline__ unsigned xb_ld(unsigned* p)              { return __hip_atomic_load(p, __ATOMIC_RELAXED, __HIP_MEMORY_SCOPE_AGENT); }
__device__ __forceinline__ unsigned xb_add(unsigned* p, unsigned v) { return __hip_atomic_fetch_add(p, v, __ATOMIC_RELAXED, __HIP_MEMORY_SCOPE_AGENT); }
__device__ __forceinline__ unsigned xb_xcc_id() { return (unsigned)__builtin_amdgcn_s_getreg((3 << 11) | 20) & 0xFu; }
#define XB_SPIN(cond, bar) do { unsigned _sp = 0; while (cond) { __builtin_amdgcn_s_sleep(1); \
    if ((++_sp & 255u) == 0u) { if (xb_ld(&(bar)[XB_TMO])) break; if (_sp > XB_SPIN_CAP) { atomicAdd(&(bar)[XB_TMO], 1u); break; } } } } while (0)

struct XcdBarrier {
    unsigned* bar; unsigned x;
    volatile LAS unsigned* st;
};

__device__ __forceinline__ XcdBarrier xcd_barrier_post(unsigned* bar, volatile LAS unsigned* st) {
    XcdBarrier b; b.bar = bar; b.x = xb_xcc_id(); b.st = st;
    if (threadIdx.x == 0) (void)xb_add(&bar[XB_XCNT(b.x)], 1u);
    return b;
}
__device__ __forceinline__ void xcd_barrier_complete(unsigned* bar, unsigned x, unsigned& nloc, unsigned& nx) {
    const unsigned G = gridDim.x * gridDim.y * gridDim.z;
    unsigned sum, cnt, mine, sp = 0u;
    for (;;) {
        sum = 0u; cnt = 0u; mine = 0u;
#pragma unroll
        for (unsigned j = 0; j < 16; ++j) { const unsigned c = xb_ld(&bar[XB_XCNT(j)]); sum += c; cnt += (c > 0u) ? 1u : 0u; mine = (j == x) ? c : mine; }
        if (sum == G) break;
        __builtin_amdgcn_s_sleep(1);
        if ((++sp & 255u) == 0u) { if (xb_ld(&bar[XB_TMO])) break; if (sp > XB_SPIN_CAP) { atomicAdd(&bar[XB_TMO], 1u); break; } }
    }
    nloc = mine > 0u ? mine : 1u; nx = cnt > 0u ? cnt : 1u;
}

__device__ __forceinline__ void xcd_barrier(const XcdBarrier& b) {
    asm volatile("s_waitcnt vmcnt(0)" ::: "memory");
    __syncthreads();
    if (threadIdx.x == 0) {
        unsigned* bar = b.bar;
        __builtin_amdgcn_s_waitcnt(0);
        unsigned nloc = b.st[0], nx = b.st[1];
        if (nloc == 0u) { xcd_barrier_complete(bar, b.x, nloc, nx); b.st[0] = nloc; b.st[1] = nx; }
        const unsigned old = xb_add(&bar[XB_XSUB(b.x)], 1u);
        const unsigned gen = old / nloc;
        if (old + 1u == (gen + 1u) * nloc) {
            __builtin_amdgcn_fence(__ATOMIC_RELEASE, "agent");
            asm volatile("s_waitcnt vmcnt(0)" ::: "memory");
            const unsigned og = xb_add(&bar[XB_TOP], 1u);
            const unsigned tg = og / nx;
            if (og + 1u == (tg + 1u) * nx) xb_add(&bar[XB_TOPGEN], 1u);
            else XB_SPIN(xb_ld(&bar[XB_TOPGEN]) == tg, bar);
            __builtin_amdgcn_fence(__ATOMIC_ACQUIRE, "agent");
            xb_add(&bar[XB_XGEN(b.x)], 1u);
            asm volatile("s_waitcnt vmcnt(0)" ::: "memory");
        } else {
            XB_SPIN(xb_ld(&bar[XB_XGEN(b.x)]) == gen, bar);
            __builtin_amdgcn_fence(__ATOMIC_ACQUIRE, "agent");
            asm volatile("s_waitcnt vmcnt(0)" ::: "memory");
        }
    }
    __syncthreads();
}

typedef float f32x16 __attribute__((ext_vector_type(16)));
typedef float f32x2 __attribute__((ext_vector_type(2)));
typedef __bf16 bf16x2_t __attribute__((ext_vector_type(2)));
typedef unsigned u32x2 __attribute__((ext_vector_type(2)));
__device__ __forceinline__ unsigned cvtpk(float lo, float hi) { f32x2 v = {lo, hi}; bf16x2_t b = __builtin_convertvector(v, bf16x2_t); return __builtin_bit_cast(unsigned, b); }
__device__ __forceinline__ float bf_lo(unsigned w) { return __builtin_bit_cast(float, w << 16); }
__device__ __forceinline__ float bf_hi(unsigned w) { return __builtin_bit_cast(float, w & 0xffff0000u); }
__device__ __forceinline__ float bf2f(unsigned short u) { return __builtin_bit_cast(float, (unsigned)u << 16); }
__device__ __forceinline__ int crow(int r, int hi) { return (r & 3) + 8 * (r >> 2) + 4 * hi; }
#define MFMA32(a, b, c) __builtin_amdgcn_mfma_f32_32x32x16_bf16((a), (b), (c), 0, 0, 0)
__device__ __forceinline__ bf16x8 pack_step(const f32x16& x, int s) {
    v4u p; p.x = cvtpk(x[8 * s], x[8 * s + 1]); p.y = cvtpk(x[8 * s + 2], x[8 * s + 3]); p.z = cvtpk(x[8 * s + 4], x[8 * s + 5]); p.w = cvtpk(x[8 * s + 6], x[8 * s + 7]);
    return __builtin_bit_cast(bf16x8, p);
}
__device__ __forceinline__ bf16x8 lds_frag2(const LAS unsigned char* p) {
    const u32x2 a = *(const LAS u32x2*)p, b = *(const LAS u32x2*)(p + 16); v4u w = {a.x, a.y, b.x, b.y}; return __builtin_bit_cast(bf16x8, w);
}
__device__ __forceinline__ float u2f(unsigned u) { return __builtin_bit_cast(float, u); }
__device__ __forceinline__ unsigned f2u(float f) { return __builtin_bit_cast(unsigned, f); }
template <int CTRL> __device__ __forceinline__ float dppf(float v) { const int x = __builtin_bit_cast(int, v); return __builtin_bit_cast(float, __builtin_amdgcn_update_dpp(x, x, CTRL, 0xF, 0xF, true)); }
template <int CTRL> __device__ __forceinline__ int dppi(int v) { return __builtin_amdgcn_update_dpp(v, v, CTRL, 0xF, 0xF, true); }
constexpr int DPP_XOR1 = 0xB1, DPP_XOR2 = 0x4E, DPP_XOR3 = 0x1B, DPP_HMIRROR = 0x141, DPP_MIRROR = 0x140, DPP_ROR8 = 0x128;
__device__ __forceinline__ float xor4f(float v) { return dppf<DPP_XOR3>(dppf<DPP_HMIRROR>(v)); }
#ifndef DBG_OLDSUM
#define DBG_OLDSUM 0
#endif
#ifndef DBG_OLDTR
#define DBG_OLDTR 0
#endif
__device__ __forceinline__ float wave_sum(float v) {
    if (DBG_OLDSUM) { for (int o = 1; o < 64; o <<= 1) v += __shfl_xor(v, o); return v; }
    v += dppf<DPP_XOR1>(v); v += dppf<DPP_XOR2>(v); v += dppf<DPP_HMIRROR>(v); v += dppf<DPP_MIRROR>(v);
    { const auto r = __builtin_amdgcn_permlane16_swap(f2u(v), f2u(v), false, false); v = u2f(r[0]) + u2f(r[1]); }
    { const auto r = __builtin_amdgcn_permlane32_swap(f2u(v), f2u(v), false, false); v = u2f(r[0]) + u2f(r[1]); }
    return v;
}
__device__ __forceinline__ float wave_max(float v) {
    if (DBG_OLDSUM) { for (int o = 1; o < 64; o <<= 1) v = fmaxf(v, __shfl_xor(v, o)); return v; }
    v = fmaxf(v, dppf<DPP_XOR1>(v)); v = fmaxf(v, dppf<DPP_XOR2>(v)); v = fmaxf(v, dppf<DPP_HMIRROR>(v)); v = fmaxf(v, dppf<DPP_MIRROR>(v));
    { const auto r = __builtin_amdgcn_permlane16_swap(f2u(v), f2u(v), false, false); v = fmaxf(u2f(r[0]), u2f(r[1])); }
    { const auto r = __builtin_amdgcn_permlane32_swap(f2u(v), f2u(v), false, false); v = fmaxf(u2f(r[0]), u2f(r[1])); }
    return v;
}
__device__ __forceinline__ int imin(int a, int b) { return a < b ? a : b; }
__device__ __forceinline__ int wave_min_i(int v) {
    if (DBG_OLDSUM) { for (int o = 1; o < 64; o <<= 1) v = imin(v, __shfl_xor(v, o)); return v; }
    v = imin(v, dppi<DPP_XOR1>(v)); v = imin(v, dppi<DPP_XOR2>(v)); v = imin(v, dppi<DPP_HMIRROR>(v)); v = imin(v, dppi<DPP_MIRROR>(v));
    { const auto r = __builtin_amdgcn_permlane16_swap((unsigned)v, (unsigned)v, false, false); v = imin((int)r[0], (int)r[1]); }
    { const auto r = __builtin_amdgcn_permlane32_swap((unsigned)v, (unsigned)v, false, false); v = imin((int)r[0], (int)r[1]); }
    return v;
}
__device__ __forceinline__ unsigned umaxu(unsigned a, unsigned b) { return a > b ? a : b; }
__device__ __forceinline__ unsigned half_max_u(unsigned v) {
    v = umaxu(v, (unsigned)dppi<DPP_XOR1>((int)v)); v = umaxu(v, (unsigned)dppi<DPP_XOR2>((int)v)); v = umaxu(v, (unsigned)dppi<DPP_HMIRROR>((int)v)); v = umaxu(v, (unsigned)dppi<DPP_MIRROR>((int)v));
    { const auto r = __builtin_amdgcn_permlane16_swap(v, v, false, false); v = umaxu(r[0], r[1]); }
    return v;
}
__device__ __forceinline__ float sum8(float v) { if (DBG_OLDSUM) { v += __shfl_xor(v, 1); v += __shfl_xor(v, 2); v += __shfl_xor(v, 4); return v; } v += dppf<DPP_XOR1>(v); v += dppf<DPP_XOR2>(v); v += dppf<DPP_HMIRROR>(v); return v; }
__device__ __forceinline__ float sum16(float v) { v = sum8(v); if (DBG_OLDSUM) { v += __shfl_xor(v, 8); return v; } v += dppf<DPP_MIRROR>(v); return v; }
template <int N, int W, int MASK> struct TRed {
    static __device__ __forceinline__ void run(float (&p)[N], int lane) {
        constexpr int half = W / 2;
#pragma unroll
        for (int i = 0; i < half; ++i) {
            if constexpr (DBG_OLDTR != 0) { const bool up = (lane & MASK) != 0; const float send = up ? p[i] : p[half + i], keep = up ? p[half + i] : p[i]; p[i] = keep + __shfl_xor(send, MASK); }
            else if constexpr (MASK == 32) { const auto r = __builtin_amdgcn_permlane32_swap(f2u(p[i]), f2u(p[half + i]), false, false); p[i] = u2f(r[0]) + u2f(r[1]); }
            else if constexpr (MASK == 16) { const auto r = __builtin_amdgcn_permlane16_swap(f2u(p[i]), f2u(p[half + i]), false, false); p[i] = u2f(r[0]) + u2f(r[1]); }
            else { const bool up = (lane & MASK) != 0; const float send = up ? p[i] : p[half + i], keep = up ? p[half + i] : p[i];
                p[i] = keep + (MASK == 8 ? dppf<DPP_ROR8>(send) : MASK == 4 ? xor4f(send) : MASK == 2 ? dppf<DPP_XOR2>(send) : dppf<DPP_XOR1>(send)); }
        }
        TRed<N, half, MASK / 2>::run(p, lane);
    }
};
template <int N, int MASK> struct TRed<N, 1, MASK> {
    static __device__ __forceinline__ void run(float (&p)[N], int) {
        if constexpr (MASK >= 1 && DBG_OLDTR != 0) { p[0] += __shfl_xor(p[0], MASK); TRed<N, 1, MASK / 2>::run(p, 0); }
        else if constexpr (MASK >= 1) { p[0] += (MASK == 8 ? dppf<DPP_ROR8>(p[0]) : MASK == 4 ? dppf<DPP_HMIRROR>(p[0]) : MASK == 2 ? dppf<DPP_XOR2>(p[0]) : dppf<DPP_XOR1>(p[0])); TRed<N, 1, MASK / 2>::run(p, 0); }
    }
};
template <int N> __device__ __forceinline__ float treduce(float (&p)[N], int lane) { TRed<N, N, 32>::run(p, lane); return p[0]; }

struct Frame {
    LAS unsigned char* lds;
    volatile LAS unsigned* MISC;
    gu32* ctl;
    unsigned char* ws;
    const void* const* in;
    float* out;
    int wave, vcu, G;
};
__device__ __forceinline__ int ftid_l() { int t = (int)threadIdx.x; asm volatile("" : "+v"(t)); return t; }
#define FTID ftid_l()
#define FLANE (ftid_l() & 63)
#define WSP(type, off) ((type*)(F.ws + (off)))

__device__ __forceinline__ int map_row(int mode, int n) {
    if (mode == 1) return ((n & 1023) >> 7) * 256 + (n >> 10) * 128 + (n & 127);
    if (mode == 2) return (n & ~255) + ((n >> 5) & 1) * 128 + ((n >> 6) & 3) * 32 + (n & 31);
    return n;
}
__device__ __forceinline__ void p0_transpose_item(const float* W, int K, int ldw, int ncols, bf16* WT, int col_off, int mode, LAS float* scr, int item, int lane) {
    const int nblk = ncols / 64, kb = item / nblk, nb = item % nblk, k0 = 64 * kb, n0 = 64 * nb;
    float tv[64];
    const float* wp = W + (size_t)k0 * ldw + n0 + lane;
#pragma unroll
    for (int i = 0; i < 64; ++i) tv[i] = wp[(size_t)i * ldw];
#pragma unroll
    for (int i = 0; i < 64; ++i) scr[i * 65 + lane] = tv[i];
    LDS_WAIT(); asm volatile("" ::: "memory");
    const int c = lane & 7;
#pragma unroll
    for (int j = 0; j < 8; ++j) { const int n = (lane >> 3) + 8 * j; const LAS float* s = scr + (8 * c) * 65 + n;
        v4u o; o.x = pk2(s[0 * 65], s[1 * 65]); o.y = pk2(s[2 * 65], s[3 * 65]); o.z = pk2(s[4 * 65], s[5 * 65]); o.w = pk2(s[6 * 65], s[7 * 65]);
        *(GAS v4u*)(WT + (size_t)map_row(mode, col_off + n0 + n) * K + k0 + 8 * c) = o; }
    LDS_WAIT(); asm volatile("" ::: "memory");
}
__device__ __forceinline__ void p0_q8_item(Frame& F, const float* Wm, int ldw, int fcol0, int mode, signed char* WQ0, float* scp, int tile, LAS float* scr, int it) {
    const int lane = FLANE, kb = it >> 2, nb = it & 3, k0 = 64 * kb, n0 = 64 * nb;
    float ss = 0.f;
    {   f32x4 v[8];
#pragma unroll
        for (int i = 0; i < 8; ++i) v[i] = *(const f32x4*)(Wm + (size_t)(128 * i) * ldw + lane * 4);
#pragma unroll
        for (int i = 0; i < 8; ++i) ss += (v[i].x * v[i].x + v[i].y * v[i].y) + (v[i].z * v[i].z + v[i].w * v[i].w); }
    ss = wave_sum(ss);
    const float sc = 4.0f * sqrtf(ss * (1.0f / 2048.0f)) * (1.0f / 127.0f), inv = 1.0f / sc;
    if (it == 0 && lane == 0) scp[tile] = sc;
    float tv[64]; const float* wp = Wm + (size_t)k0 * ldw + n0 + lane;
#pragma unroll
    for (int i = 0; i < 64; ++i) tv[i] = wp[(size_t)i * ldw];
#pragma unroll
    for (int i = 0; i < 64; ++i) scr[i * 65 + lane] = tv[i];
    LDS_WAIT(); asm volatile("" ::: "memory");
    const int c = lane & 3;
#pragma unroll
    for (int j = 0; j < 4; ++j) { const int n = (lane >> 2) + 16 * j; const LAS float* sp = scr + (16 * c) * 65 + n; unsigned w4[4];
#pragma unroll
        for (int g = 0; g < 4; ++g) w4[g] = pack4_i8(sp[(4 * g) * 65] * inv, sp[(4 * g + 1) * 65] * inv, sp[(4 * g + 2) * 65] * inv, sp[(4 * g + 3) * 65] * inv);
        *(GAS v4u*)(WQ0 + (size_t)map_row(mode, fcol0 + n0 + n) * 1024 + k0 + 16 * c) = (v4u){w4[0], w4[1], w4[2], w4[3]}; }
    LDS_WAIT(); asm volatile("" ::: "memory");
}
__device__ __forceinline__ void p0_prologue(Frame& F) {
    const int gw = F.vcu * NWAVES + F.wave, NGW = F.G * NWAVES;
    {
        LAS float* scr = (LAS float*)(F.lds + F.wave * 16896);
        const float* a_w_in = (const float*)F.in[2]; const float* a_w_out = (const float*)F.in[6]; const float* kv_w = (const float*)F.in[7]; const float* b_w_q = (const float*)F.in[8];
        const float* b_w_out = (const float*)F.in[11]; const float* w_gu = (const float*)F.in[18]; const float* w_dn = (const float*)F.in[20];
        {
            constexpr int NI_GU = 64 * 512, NI_DN = 64 * 256;
            const int lane = FLANE, half = lane >> 5, l32 = lane & 31;
            for (int gi = gw; gi < NI_GU + NI_DN; gi += NGW) {
                const bool dn = gi >= NI_GU; const int gj = dn ? gi - NI_GU : gi;
                const int m = dn ? gj >> 8 : gj >> 9, r = dn ? gj & 255 : gj & 511, NW_ = dn ? 1024 : 2048, kb2 = dn ? r >> 5 : r >> 6, nb = dn ? r & 31 : r & 63, k0 = 128 * kb2, n0 = 32 * nb;
                const float* Wm = dn ? w_dn + (size_t)m * 1024 * 1024 : w_gu + (size_t)m * 1024 * 2048;
                f32x4 sv[8];
#pragma unroll
                for (int i = 0; i < 8; ++i) sv[i] = *(const f32x4*)(Wm + (size_t)(128 * i) * NW_ + 4 * lane);
                float tv[64]; const float* wp = Wm + (size_t)(k0 + half) * NW_ + n0 + l32;
#pragma unroll
                for (int i = 0; i < 64; ++i) tv[i] = __builtin_nontemporal_load(&wp[(size_t)(2 * i) * NW_]);
                float ss = 0.f;
#pragma unroll
                for (int i = 0; i < 8; ++i) ss += (sv[i].x * sv[i].x + sv[i].y * sv[i].y) + (sv[i].z * sv[i].z + sv[i].w * sv[i].w);
                const float rmsw = sqrtf(wave_sum(ss) * (1.0f / 2048.0f)), sc = 4.0f * rmsw * (1.0f / 127.0f), inv = 1.0f / sc;
                if (r == 0) {
                    if (dn) { if (lane == 0) WSP(float, WS_SWD)[m] = sc; }
                    else { const int layer = m >> 5; const float* lg1 = (const float*)F.in[12] + layer * D; const float* lb1 = (const float*)F.in[13] + layer * D; float sx = 0.f;
#pragma unroll
                        for (int i = 0; i < 4; ++i) { const f32x4 g_ = *((const f32x4*)lg1 + lane + 64 * i), b_ = *((const f32x4*)lb1 + lane + 64 * i); sx += (g_.x * g_.x + g_.y * g_.y) + (g_.z * g_.z + g_.w * g_.w) + (b_.x * b_.x + b_.y * b_.y) + (b_.z * b_.z + b_.w * b_.w); }
                        sx = wave_sum(sx);
                        if (lane == 0) { WSP(float, WS_SWQ)[m] = sc; WSP(float, WS_SACT)[m] = 10.0f * (32.0f * rmsw * sqrtf(sx * (1.0f / 1024.0f))) * (1.0f / 127.0f); } } }
                signed char* WQ = dn ? (signed char*)WSP(unsigned char, WS_WD) + (size_t)m * 1024 * 1024 : (signed char*)WSP(unsigned char, WS_WGU) + (size_t)m * 2048 * 1024;
#pragma unroll
                for (int i = 0; i < 64; ++i) scr[(2 * i + half) * 33 + l32] = tv[i];
                LDS_WAIT(); asm volatile("" ::: "memory");
                const int c = lane >> 3;
#pragma unroll
                for (int j = 0; j < 4; ++j) { const int n = (lane & 7) + 8 * j; const LAS float* sp = scr + (16 * c) * 33 + n; unsigned w4[4];
#pragma unroll
                    for (int g = 0; g < 4; ++g) w4[g] = pack4_i8(sp[(4 * g) * 33] * inv, sp[(4 * g + 1) * 33] * inv, sp[(4 * g + 2) * 33] * inv, sp[(4 * g + 3) * 33] * inv);
                    *(GAS v4u*)(WQ + (size_t)(dn ? n0 + n : map_row(1, n0 + n)) * 1024 + k0 + 16 * c) = (v4u){w4[0], w4[1], w4[2], w4[3]}; }
                LDS_WAIT(); asm volatile("" ::: "memory"); }
        }
        for (int task = (int)blockIdx.x; task < 256; task += F.G) { const int item = task * 8 + F.wave, tile = item >> 6, it_ = item & 63;
            if (tile >= 28) { p0_q8_item(F, b_w_out + (tile - 28) * 256, 1024, (tile - 28) * 256, 0, (signed char*)WSP(unsigned char, WS_WBO), WSP(float, WS_SWBO), tile - 28, scr, it_); continue; }
            if (tile >= 24) { p0_q8_item(F, a_w_out + (tile - 24) * 256, 1024, (tile - 24) * 256, 0, (signed char*)WSP(unsigned char, WS_WAO), WSP(float, WS_SWAO), tile - 24, scr, it_); continue; }
            if (tile < 12) p0_q8_item(F, a_w_in + tile * 256, LDW_IN, tile * 256, 0, (signed char*)WSP(unsigned char, WS_WIN), WSP(float, WS_SWIN), tile, scr, it_);
            else if (tile < 20) p0_q8_item(F, kv_w + (tile - 12) * 256, 2048, (tile - 12) * 256, 2, (signed char*)WSP(unsigned char, WS_WKVQ), WSP(float, WS_SWKVQ), tile - 12, scr, it_);
            else p0_q8_item(F, b_w_q + (tile - 20) * 256, 1024, 2048 + (tile - 20) * 256, 2, (signed char*)WSP(unsigned char, WS_WKVQ), WSP(float, WS_SWKVQ), tile - 12, scr, it_); }
    }
    __syncthreads();
    {
        const float* a_w_in = (const float*)F.in[2]; const float* x = (const float*)F.in[0];
        LAS float* Wgl = (LAS float*)F.lds;
        {   float wv_[32];
#pragma unroll
            for (int q = 0; q < 32; ++q) { const int idx = FTID + NTHR * q, k = idx >> 4, c = idx & 15; wv_[q] = a_w_in[(size_t)k * LDW_IN + NQKVR + c]; }
#pragma unroll
            for (int q = 0; q < 32; ++q) { const int idx = FTID + NTHR * q, k = idx >> 4, c = idx & 15, l = (k & 255) >> 2, jc = (k >> 8) * 4 + (k & 3); Wgl[(jc * 64 + l) * 20 + c] = wv_[q]; } }
        __syncthreads();
        bf16* XB = WSP(bf16, WS_XB); float* GK = WSP(float, WS_GKLOW);
        f32x4 rn[4], v[4];
        const int mlast = gw < T ? gw + ((T - 1 - gw) / NGW) * NGW : 0;
#define P0B_FETCH(M) do { const GAS f32x4* xr_ = (const GAS f32x4*)(x + (size_t)(M) * D) + FLANE; _Pragma("unroll") for (int j = 0; j < 4; ++j) rn[j] = xr_[64 * j]; } while (0)
#define P0B_TAKE() do { _Pragma("unroll") for (int j = 0; j < 4; ++j) { asm volatile("" : "+v"(rn[j])); v[j] = rn[j]; } } while (0)
        if (gw < T) { P0B_FETCH(gw); P0B_TAKE(); }
#pragma unroll 1
        for (int m = gw; m < T; m += NGW) {
            asm volatile("" ::: "memory");
            P0B_FETCH(imin(m + NGW, mlast));
            GAS unsigned long long* o8 = (GAS unsigned long long*)(XB + (size_t)m * D) + FLANE;
            float am = 0.f;
#pragma unroll
            for (int j = 0; j < 4; ++j) { o8[64 * j] = (unsigned long long)cvtpk(v[j].x, v[j].y) | ((unsigned long long)cvtpk(v[j].z, v[j].w) << 32);
                am = fmaxf(fmaxf(am, fmaxf(fabsf(v[j].x), fabsf(v[j].y))), fmaxf(fabsf(v[j].z), fabsf(v[j].w))); }
            am = fmaxf(wave_max(am), 1e-20f);
            {   const float qi = 127.0f / am; GAS unsigned* q8 = (GAS unsigned*)((signed char*)WSP(unsigned char, WS_X1Q) + (size_t)m * D) + FLANE;
#pragma unroll
                for (int j = 0; j < 4; ++j) q8[64 * j] = pack4_i8(v[j].x * qi, v[j].y * qi, v[j].z * qi, v[j].w * qi);
                WSP(float, WS_SX)[m] = am * (1.0f / 127.0f); }
            float p[16];
#pragma unroll
            for (int c = 0; c < 16; ++c) p[c] = 0.f;
#pragma unroll
            for (int j = 0; j < 4; ++j)
#pragma unroll
                for (int cc = 0; cc < 4; ++cc) { const float xv = v[j][cc]; const LAS f32x4* wp = (const LAS f32x4*)(Wgl + ((j * 4 + cc) * 64 + FLANE) * 20);
#pragma unroll
                    for (int q = 0; q < 4; ++q) { const f32x4 w = wp[q]; p[4 * q] += xv * w.x; p[4 * q + 1] += xv * w.y; p[4 * q + 2] += xv * w.z; p[4 * q + 3] += xv * w.w; } }
            const float r = treduce<16>(p, FLANE);
            GK[(size_t)m * 16 + (FLANE >> 2)] = r;
            asm volatile("" ::: "memory");
            P0B_TAKE();
        }
#undef P0B_FETCH
#undef P0B_TAKE
    }
    if (blockIdx.x == 0 && FTID < 128) WSP(float, WS_SUBW)[FTID] = ((const float*)F.in[10])[FTID] * (1.0f - LAMBDA_INIT);
    {
        const int* pos = (const int*)F.in[1]; float* CT = WSP(float, WS_COS); float* ST = WSP(float, WS_SIN);
#pragma unroll 8
        for (int idx = F.vcu * NTHR + FTID; idx < T * 32; idx += F.G * NTHR) { const int row = idx >> 5, i = idx & 31;
            const float inv = exp2f(-(float)i * 0.41524101186092029f); const float ang = (float)pos[row] * inv;
            const double rev = (double)ang * 0.15915494309189535; const float fr = (float)(rev - floor(rev));
            CT[idx] = __builtin_amdgcn_cosf(fr); ST[idx] = __builtin_amdgcn_sinf(fr); }
    }
    __syncthreads();
}

constexpr int QROW = 272, KSTROW = 320, VROW = 576;
constexpr int G1_QRAW = 0, G1_KRAW = 17408, G1_QIN = 34816, G1_KIN = 52224, G1_KST = 69632, G1_VT = 90112, G1_GK = 126976, G1_SEG = 131072, G1_DEC = 135168, G1_W2 = 135680;
__device__ __forceinline__ bf16x8 tr_frag(const LAS unsigned char* p0, const LAS unsigned char* p1) {
    typedef short v4s __attribute__((ext_vector_type(4)));
    const v4s a = __builtin_amdgcn_ds_read_tr16_b64_v4i16((LAS v4s*)p0), b = __builtin_amdgcn_ds_read_tr16_b64_v4i16((LAS v4s*)p1);
    return (bf16x8){a[0], a[1], a[2], a[3], b[0], b[1], b[2], b[3]};
}
__device__ __forceinline__ void gla_stage1(Frame& F) {
    const float* w_gk2 = (const float*)F.in[3]; const float* b_gk = (const float*)F.in[4];
    const bf16* QKVR = WSP(bf16, WS_QKVR); const float* GKL = WSP(float, WS_GKLOW);
    bf16* OLOC = WSP(bf16, WS_OLOC); bf16* QDEC = WSP(bf16, WS_QDEC); float* SEND = WSP(float, WS_SEND); float* GSUM = WSP(float, WS_GSUM);
    LAS unsigned char* L = F.lds;
    const int w = F.wave;
    for (int u = blockIdx.x; u < GLA_UNITS; u += F.G) {
        int tid_ = FTID; asm volatile("" : "+v"(tid_));
        const int tid = tid_, lane = tid & 63, r = lane & 31, hh = lane >> 5;
        const int dp = tid & 63, sg = w;
        const int trq = (lane & 15) >> 2, trc = 16 * ((lane >> 4) & 1) + 4 * (lane & 3);
        const LAS unsigned char* vtp = L + G1_VT + (trq + 4 * hh) * VROW + (32 * w + trc) * 2;
        const LAS unsigned char* vtn = L + G1_VT + (trq + 8 * hh) * VROW + (32 * w + trc) * 2;
        const LAS unsigned char* ksn = L + G1_KST + (trq + 8 * hh) * KSTROW + trc * 2;
        const int b = u >> 6, h = (u >> 4) & 3, run = u & 15; const size_t t0 = (size_t)b * SEQ + (size_t)run * (GLA_C * GLA_RUN);
        __syncthreads();
        {   float wv_[4];
#pragma unroll
            for (int q = 0; q < 4; ++q) { const int idx = tid + NTHR * q; wv_[q] = w_gk2[(idx >> 7) * 512 + h * 128 + (idx & 127)]; }
#pragma unroll
            for (int q = 0; q < 4; ++q) *(LAS float*)(L + G1_W2 + (tid + NTHR * q) * 4) = wv_[q]; }
        const f32x2 bg2 = *(const f32x2*)(b_gk + h * 128 + 2 * dp);
        float cuma = 0.f, cumb = 0.f;
        f32x16 S[4];
#pragma unroll
        for (int t = 0; t < 4; ++t) S[t] = f32x16{};
        v4u pq[2], pk[2], pv[4]; f32x4 pg;
#define G1_FETCH(r0_) do { \
            _Pragma("unroll") for (int q_ = 0; q_ < 2; ++q_) { const int idx = tid + NTHR * q_, row = idx >> 4, ch = idx & 15; const bf16* src = QKVR + ((r0_) + row) * NQKVR + h * 128 + ch * 8; pq[q_] = *(const v4u*)src; pk[q_] = *(const v4u*)(src + 512); } \
            _Pragma("unroll") for (int q_ = 0; q_ < 4; ++q_) { const int idx = tid + NTHR * q_, row = idx >> 5, ch = idx & 31; pv[q_] = *(const v4u*)(QKVR + ((r0_) + row) * NQKVR + 1024 + h * 256 + ch * 8); } \
            if (tid < 256) pg = *(const f32x4*)(GKL + ((r0_) + (tid >> 2)) * 16 + (tid & 3) * 4); } while (0)
#define G1_COMMIT() do { \
            _Pragma("unroll") for (int q_ = 0; q_ < 2; ++q_) { const int idx = tid + NTHR * q_, row = idx >> 4, ch = idx & 15; *(LAS v4u*)(L + G1_QRAW + row * QROW + ch * 16) = pq[q_]; *(LAS v4u*)(L + G1_KRAW + row * QROW + ch * 16) = pk[q_]; } \
            _Pragma("unroll") for (int q_ = 0; q_ < 4; ++q_) { const int idx = tid + NTHR * q_, row = idx >> 5, ch = idx & 31; *(LAS v4u*)(L + G1_VT + row * VROW + ch * 16) = pv[q_]; } \
            if (tid < 256) *(LAS f32x4*)(L + G1_GK + ((tid >> 2) * 16 + (tid & 3) * 4) * 4) = pg; } while (0)
        G1_FETCH(t0);
        for (int c = 0; c < GLA_RUN; ++c) {
            const size_t r0 = t0 + (size_t)c * GLA_C;
            G1_COMMIT();
            __syncthreads();
            float Ga[8], Gb[8]; float rsa = 0.f, rsb = 0.f;
            f32x2 w2[16];
#pragma unroll
            for (int k = 0; k < 16; ++k) w2[k] = *(const LAS f32x2*)(L + G1_W2 + (k * 128 + 2 * dp) * 4);
#pragma unroll
            for (int ii = 0; ii < 8; ++ii) { const LAS f32x4* gp = (const LAS f32x4*)(L + G1_GK + (8 * sg + ii) * 64);
                f32x2 z = bg2;
#pragma unroll
                for (int q = 0; q < 4; ++q) { const f32x4 g = gp[q]; z += w2[4 * q] * g.x; z += w2[4 * q + 1] * g.y; z += w2[4 * q + 2] * g.z; z += w2[4 * q + 3] * g.w; }
                const float za = z.x, zb = z.y;
                rsa += fminf(za, 0.f) * (1.0f / 16.0f) - 0.043321698784996581f * __builtin_amdgcn_logf(1.0f + __builtin_amdgcn_exp2f(-1.4426950408889634f * fabsf(za))); Ga[ii] = rsa;
                rsb += fminf(zb, 0.f) * (1.0f / 16.0f) - 0.043321698784996581f * __builtin_amdgcn_logf(1.0f + __builtin_amdgcn_exp2f(-1.4426950408889634f * fabsf(zb))); Gb[ii] = rsb; }
            *(LAS f32x2*)(L + G1_SEG + (sg * 128 + 2 * dp) * 4) = (f32x2){rsa, rsb};
            __syncthreads();
            float offa = 0.f, offb = 0.f, gla = 0.f, glb = 0.f;
#pragma unroll
            for (int s2 = 0; s2 < 8; ++s2) { const f32x2 sv = *(const LAS f32x2*)(L + G1_SEG + (s2 * 128 + 2 * dp) * 4); gla += sv.x; glb += sv.y; if (s2 < sg) { offa += sv.x; offb += sv.y; } }
            const float eca = __expf(cuma), ecb = __expf(cumb), edga = __expf(gla), edgb = __expf(glb);
#pragma unroll
            for (int ii = 0; ii < 8; ++ii) { const int i = 8 * sg + ii;
                const unsigned qw = *(const LAS unsigned*)(L + G1_QRAW + i * QROW + dp * 4), kw = *(const LAS unsigned*)(L + G1_KRAW + i * QROW + dp * 4);
                const float Gxa = Ga[ii] + offa, Gxb = Gb[ii] + offb;
                const float qia = bf_lo(qw) * 0.08838834764831845f * __expf(Gxa), qib = bf_hi(qw) * 0.08838834764831845f * __expf(Gxb);
                const float ka = bf_lo(kw), kb = bf_hi(kw);
                *(LAS unsigned*)(L + G1_QIN + i * QROW + dp * 4) = cvtpk(qia, qib);
                const float kia = ka * __expf(-Gxa), kib = kb * __expf(-Gxb);
                *(LAS unsigned*)(L + G1_KIN + i * QROW + dp * 4) = cvtpk(kia, kib);
                *(LAS unsigned*)(L + G1_KST + i * KSTROW + dp * 4) = cvtpk(kia * edga, kib * edgb);
                *(LAS unsigned*)(L + G1_QRAW + i * QROW + dp * 4) = cvtpk(qia * eca, qib * ecb); }
            if (sg == 0) *(LAS f32x2*)(L + G1_DEC + 2 * dp * 4) = (f32x2){edga, edgb};
            cuma += gla; cumb += glb;
            __syncthreads();
#pragma unroll
            for (int q_ = 0; q_ < 2; ++q_) { const int idx = tid + NTHR * q_, row = idx >> 4, ch = idx & 15; *(v4u*)(QDEC + (r0 + row) * 512 + h * 128 + ch * 8) = *(const LAS v4u*)(L + G1_QRAW + row * QROW + ch * 16); }
            if (c + 1 < GLA_RUN) G1_FETCH(r0 + GLA_C);
            f32x16 X00 = f32x16{}, X01 = f32x16{}, X11 = f32x16{};
#pragma unroll
            for (int s = 0; s < 8; ++s) { const int ko = (16 * s + 8 * hh) * 2;
                const bf16x8 aK0 = *(const LAS bf16x8*)(L + G1_KIN + r * QROW + ko), aK1 = *(const LAS bf16x8*)(L + G1_KIN + (32 + r) * QROW + ko);
                const bf16x8 bQ0 = *(const LAS bf16x8*)(L + G1_QIN + r * QROW + ko), bQ1 = *(const LAS bf16x8*)(L + G1_QIN + (32 + r) * QROW + ko);
                X00 = MFMA32(aK0, bQ0, X00); X01 = MFMA32(aK0, bQ1, X01); X11 = MFMA32(aK1, bQ1, X11);
                if (s & 1) asm volatile("" ::: "memory"); }
#pragma unroll
            for (int q = 0; q < 16; ++q) { const bool keep = crow(q, hh) <= r; X00[q] = keep ? X00[q] : 0.f; X11[q] = keep ? X11[q] : 0.f; }
            f32x16 o0 = f32x16{}, o1 = f32x16{};
#pragma unroll
            for (int s = 0; s < 2; ++s) { const bf16x8 v0 = tr_frag(vtp + (16 * s) * VROW, vtp + (16 * s + 8) * VROW), v1 = tr_frag(vtp + (32 + 16 * s) * VROW, vtp + (32 + 16 * s + 8) * VROW);
                o0 = MFMA32(pack_step(X00, s), v0, o0); o1 = MFMA32(pack_step(X01, s), v0, o1); o1 = MFMA32(pack_step(X11, s), v1, o1); }
            asm volatile("" ::: "memory");
#pragma unroll
            for (int t = 0; t < 4; ++t) {
#pragma unroll
                for (int s = 0; s < 2; ++s) { const bf16x8 xs = pack_step(S[t], s); const int doff = (32 * t + 16 * s + 4 * hh) * 2;
                    o0 = MFMA32(lds_frag2(L + G1_QIN + r * QROW + doff), xs, o0); o1 = MFMA32(lds_frag2(L + G1_QIN + (32 + r) * QROW + doff), xs, o1); }
                asm volatile("" ::: "memory"); }
            {   bf16* op = OLOC + (r0 + 4 * hh) * D + h * 256 + 32 * w + r;
#pragma unroll
                for (int q = 0; q < 16; ++q) { const int rr = (q & 3) + 8 * (q >> 2); op[(size_t)rr * D] = (bf16)cvtpk(o0[q], 0.f); op[(size_t)(32 + rr) * D] = (bf16)cvtpk(o1[q], 0.f); } }
#pragma unroll
            for (int t = 0; t < 4; ++t) {
#pragma unroll
                for (int g = 0; g < 4; ++g) { const f32x4 dv = *(const LAS f32x4*)(L + G1_DEC + (32 * t + 8 * g + 4 * hh) * 4);
                    S[t][4 * g] *= dv.x; S[t][4 * g + 1] *= dv.y; S[t][4 * g + 2] *= dv.z; S[t][4 * g + 3] *= dv.w; }
#pragma unroll
                for (int s = 0; s < 4; ++s)
                    S[t] = MFMA32(tr_frag(ksn + (16 * s) * KSTROW + 64 * t, ksn + (16 * s + 4) * KSTROW + 64 * t), tr_frag(vtn + (16 * s) * VROW, vtn + (16 * s + 4) * VROW), S[t]);
                asm volatile("" ::: "memory");
            }
            __syncthreads();
        }
#undef G1_FETCH
#undef G1_COMMIT
        {   float* sp = SEND + ((size_t)u * 256 + 32 * w + r) * 128 + 4 * hh;
#pragma unroll
            for (int t = 0; t < 4; ++t)
#pragma unroll
                for (int g = 0; g < 4; ++g) *(f32x4*)(sp + 32 * t + 8 * g) = (f32x4){S[t][4 * g], S[t][4 * g + 1], S[t][4 * g + 2], S[t][4 * g + 3]}; }
        if (sg == 0) *(f32x2*)(GSUM + u * 128 + 2 * dp) = (f32x2){cuma, cumb};
    }
}
__device__ __forceinline__ void gla_stage2(Frame& F) {
    const float* SEND = WSP(float, WS_SEND); const float* GSUM = WSP(float, WS_GSUM); bf16* SINIT = WSP(bf16, WS_SINIT);
    for (int gid = F.vcu * NTHR + FTID; gid < NB * GLA_H * 8192; gid += F.G * NTHR) {
        const int bh = gid >> 13, e4 = gid & 8191, d4 = (e4 & 31) * 4; const size_t eo = (size_t)(e4 >> 5) * 128 + d4;
        f32x4 S = {0.f, 0.f, 0.f, 0.f};
        f32x4 gq[GLA_NRUN], eq[GLA_NRUN];
#pragma unroll
        for (int run = 0; run < GLA_NRUN; ++run) { const int u = bh * GLA_NRUN + run; gq[run] = *(const f32x4*)(GSUM + u * 128 + d4); eq[run] = *(const f32x4*)(SEND + (size_t)u * 32768 + eo); }
#pragma unroll
        for (int run = 0; run < GLA_NRUN; ++run) { const int u = bh * GLA_NRUN + run;
            *(u32x2*)(SINIT + (size_t)u * 32768 + eo) = (u32x2){cvtpk(S.x, S.y), cvtpk(S.z, S.w)};
            const f32x4 g = gq[run], e = eq[run];
            S.x = S.x * __expf(g.x) + e.x; S.y = S.y * __expf(g.y) + e.y; S.z = S.z * __expf(g.z) + e.z; S.w = S.w * __expf(g.w) + e.w; }
    }
}
constexpr int G3_SL = 0, G3_QD = 69632, G3_OT = 87040, OTROW = 260, G3_NW = 153600;
__device__ __forceinline__ void gla_stage3(Frame& F) {
    const float* norm_w = (const float*)F.in[5];
    const bf16* QKVR = WSP(bf16, WS_QKVR); const bf16* OLOC = WSP(bf16, WS_OLOC); const bf16* QDEC = WSP(bf16, WS_QDEC); const bf16* SINIT = WSP(bf16, WS_SINIT); bf16* OG = WSP(bf16, WS_OG);
    LAS unsigned char* L = F.lds;
    const int tid = FTID, lane = FLANE, w = F.wave, r = lane & 31, hh = lane >> 5;
    const int nrow = tid >> 3, part = tid & 7;
    if (tid < 256) ((LAS float*)(L + G3_NW))[tid] = norm_w[tid];
    for (int u = blockIdx.x; u < GLA_UNITS; u += F.G) {
        const int b = u >> 6, h = (u >> 4) & 3, run = u & 15; const size_t t0 = (size_t)b * SEQ + (size_t)run * (GLA_C * GLA_RUN);
        __syncthreads();
#pragma unroll
        for (int q = 0; q < 8; ++q) { const int idx = tid + NTHR * q, row = idx >> 4, ch = idx & 15;
            *(LAS v4u*)(L + G3_SL + row * QROW + ch * 16) = *(const v4u*)(SINIT + (size_t)u * 32768 + row * 128 + ch * 8); }
        v4u qd[2];
#define G3_QFETCH(C) do { const size_t r0_ = t0 + (size_t)(C) * GLA_C; _Pragma("unroll") for (int q = 0; q < 2; ++q) { const int idx = tid + NTHR * q, row = idx >> 4, ch = idx & 15; \
            qd[q] = *(const v4u*)(QDEC + (r0_ + row) * 512 + h * 128 + ch * 8); } } while (0)
        G3_QFETCH(0);
#pragma unroll
        for (int q = 0; q < 2; ++q) asm volatile("" : "+v"(qd[q]));
#pragma unroll 1
        for (int c = 0; c < GLA_RUN; ++c) {
            const size_t r0 = t0 + (size_t)c * GLA_C;
#pragma unroll
            for (int q = 0; q < 2; ++q) { const int idx = tid + NTHR * q, row = idx >> 4, ch = idx & 15; *(LAS v4u*)(L + G3_QD + row * QROW + ch * 16) = qd[q]; }
            v4u ol[4], rgv[4];
            {   const v4u* op = (const v4u*)(OLOC + (r0 + nrow) * D + h * 256 + part * 32); const v4u* rp = (const v4u*)(QKVR + (r0 + nrow) * NQKVR + 2048 + h * 256 + part * 32);
#pragma unroll
                for (int q = 0; q < 4; ++q) { ol[q] = op[q]; rgv[q] = rp[q]; } }
            G3_QFETCH(c + 1 < GLA_RUN ? c + 1 : c);
            __syncthreads();
            f32x16 o0 = f32x16{}, o1 = f32x16{};
#pragma unroll
            for (int s = 0; s < 8; ++s) { const int ko = (16 * s + 8 * hh) * 2;
                const bf16x8 bS = *(const LAS bf16x8*)(L + G3_SL + (32 * w + r) * QROW + ko);
                o0 = MFMA32(*(const LAS bf16x8*)(L + G3_QD + r * QROW + ko), bS, o0); o1 = MFMA32(*(const LAS bf16x8*)(L + G3_QD + (32 + r) * QROW + ko), bS, o1); }
            {   LAS float* ot = (LAS float*)(L + G3_OT) + (4 * hh) * OTROW + 32 * w + r;
#pragma unroll
                for (int q = 0; q < 16; ++q) { const int rr = (q & 3) + 8 * (q >> 2); ot[rr * OTROW] = o0[q]; ot[(32 + rr) * OTROW] = o1[q]; } }
            __syncthreads();
            {   const LAS f32x4* orow = (const LAS f32x4*)((LAS float*)(L + G3_OT) + nrow * OTROW + part * 32);
                f32x4 x[8]; float ss = 0.f;
#pragma unroll
                for (int q = 0; q < 4; ++q) { const v4u ov_ = ol[q];
                    x[2 * q] = orow[2 * q] + (f32x4){bf_lo(ov_.x), bf_hi(ov_.x), bf_lo(ov_.y), bf_hi(ov_.y)}; x[2 * q + 1] = orow[2 * q + 1] + (f32x4){bf_lo(ov_.z), bf_hi(ov_.z), bf_lo(ov_.w), bf_hi(ov_.w)}; }
#pragma unroll
                for (int q = 0; q < 8; ++q) ss += (x[q].x * x[q].x + x[q].y * x[q].y) + (x[q].z * x[q].z + x[q].w * x[q].w);
                ss = sum8(ss);
                const float rstd = 1.0f / sqrtf(ss * (1.0f / 256.0f) + RMS_EPS);
                v4u* gp = (v4u*)((signed char*)OG + (r0 + nrow) * D + h * 256 + part * 32);
                unsigned qw[8]; const LAS f32x4* nwp = (const LAS f32x4*)(L + G3_NW) + part * 8;
#pragma unroll
                for (int q = 0; q < 4; ++q) { const v4u rv = rgv[q]; const f32x4 nwa = nwp[2 * q], nwb = nwp[2 * q + 1]; float rg[8] = {bf_lo(rv.x), bf_hi(rv.x), bf_lo(rv.y), bf_hi(rv.y), bf_lo(rv.z), bf_hi(rv.z), bf_lo(rv.w), bf_hi(rv.w)}; float ov[8];
#pragma unroll
                    for (int e = 0; e < 8; ++e) { const float xv = x[2 * q + (e >> 2)][e & 3], nv = (e >> 2) ? nwb[e & 3] : nwa[e & 3]; ov[e] = xv * rstd * nv * (rg[e] * __builtin_amdgcn_rcpf(1.0f + __expf(-rg[e]))); }
                    qw[2 * q] = pack4_i8(ov[0] * (1.0f / OG_QS), ov[1] * (1.0f / OG_QS), ov[2] * (1.0f / OG_QS), ov[3] * (1.0f / OG_QS)); qw[2 * q + 1] = pack4_i8(ov[4] * (1.0f / OG_QS), ov[5] * (1.0f / OG_QS), ov[6] * (1.0f / OG_QS), ov[7] * (1.0f / OG_QS)); }
                gp[0] = (v4u){qw[0], qw[1], qw[2], qw[3]}; gp[1] = (v4u){qw[4], qw[5], qw[6], qw[7]};
            }
            __syncthreads();
#pragma unroll
            for (int q = 0; q < 2; ++q) asm volatile("" : "+v"(qd[q]));
        }
#undef G3_QFETCH
    }
}

constexpr int RT_RS = 2064;
constexpr int RT_TILE = 2 * 16 * RT_RS;
constexpr int RT_PP = 2 * RT_TILE;
constexpr int RT_LCNT = RT_PP + 2 * 4 * 16 * 32 * 4, RT_STG = RT_LCNT + 128;
static_assert(RT_STG + 128 * 4 + 3 * 512 * 4 <= PHASE_LDS, "router LDS");
__device__ __forceinline__ void moe_router(Frame& F, int layer) {
    const bf16* Y = WSP(bf16, WS_Y); bf16* X1B = WSP(bf16, WS_X1B); signed char* X1Q = (signed char*)WSP(unsigned char, WS_X1Q); float* SX = WSP(float, WS_SX);
    const float* lg = (const float*)F.in[12] + layer * D; const float* lb = (const float*)F.in[13] + layer * D;
    const float* Wr = (const float*)F.in[16] + (size_t)layer * D * NE; const float* br = (const float*)F.in[17] + layer * NE;
    int* TOPI = WSP(int, WS_TOPI); float* TOPG = WSP(float, WS_TOPG); int* LRANK = WSP(int, WS_LRANK); int* CNT = WSP(int, WS_CNT);
    LAS unsigned char* L = F.lds; LAS int* lcnt = (LAS int*)(F.lds + RT_LCNT);
    const int lane = FLANE, w = F.wave, ks = w >> 1, nt = w & 1, kg = lane >> 4, i16 = lane & 15;
    if (FTID < NE) lcnt[FTID] = 0;
    bf16x8 Bh[8], Bl[8];
#pragma unroll
    for (int s_ = 0; s_ < 8; ++s_) { const float* wp = Wr + (size_t)(256 * ks + 32 * s_ + 8 * kg) * NE + 16 * nt + i16; float wv[8];
#pragma unroll
        for (int t = 0; t < 8; ++t) wv[t] = wp[t * NE];
        unsigned h[4], l[4];
#pragma unroll
        for (int p = 0; p < 4; ++p) { h[p] = cvtpk(wv[2 * p], wv[2 * p + 1]); l[p] = cvtpk(wv[2 * p] - bf_lo(h[p]), wv[2 * p + 1] - bf_hi(h[p])); }
        Bh[s_] = __builtin_bit_cast(bf16x8, (v4u){h[0], h[1], h[2], h[3]}); Bl[s_] = __builtin_bit_cast(bf16x8, (v4u){l[0], l[1], l[2], l[3]}); }
    __syncthreads();
    const int TPW = (T + F.G - 1) / F.G, wg = blockIdx.x;
    const float brl = br[lane & 31];
    f32x4 lgv[4], lbv[4];
#pragma unroll
    for (int j = 0; j < 4; ++j) { lgv[j] = *((const f32x4*)lg + lane + 64 * j); lbv[j] = *((const f32x4*)lb + lane + 64 * j); }
    LAS float* SXl = (LAS float*)(F.lds + RT_STG); LAS int* TIl = (LAS int*)(SXl + 128); LAS float* TGl = (LAS float*)(TIl + 512); LAS int* LRl = (LAS int*)(TGl + 512);
    for (int c0 = 0; c0 < TPW; c0 += 128) {
        const int base = wg * TPW + c0, ntok = imin(128, TPW - c0), nbt = (ntok + 15) / 16;
        u32x2 ra[4], rb[4];
#define ROUTER_FETCH(B_) do { const int m0_ = imin(base + 16 * (B_) + 2 * w, T - 1), m1_ = imin(m0_ + 1, T - 1); \
        const GAS u32x2* ya = (const GAS u32x2*)(Y + (size_t)m0_ * D) + lane; const GAS u32x2* yb = (const GAS u32x2*)(Y + (size_t)m1_ * D) + lane; \
        _Pragma("unroll") for (int j = 0; j < 4; ++j) { ra[j] = ya[64 * j]; rb[j] = yb[64 * j]; } } while (0)
#define ROUTER_TAIL2(BB_) do { const int e = lane & 31, tk_ = 16 * (BB_) + 2 * w + (lane >> 5); const bool ok_ = tk_ < ntok && base + tk_ < T;          \
            const LAS float* pq = (const LAS float*)(L + RT_PP) + ((((BB_) & 1) * 4) * 16 + 2 * w + (lane >> 5)) * 32 + e; \
            const float val = ((pq[0] + pq[16 * 32]) + (pq[2 * 16 * 32] + pq[3 * 16 * 32])) + brl; \
            unsigned u_ = f2u(val); u_ = (u_ & 0x80000000u) ? ~u_ : (u_ | 0x80000000u); unsigned key = (u_ & ~31u) | (unsigned)(31 - e);        \
            float sv[4]; int si[4]; \
            _Pragma("unroll") for (int k = 0; k < 4; ++k) { const unsigned km = half_max_u(key); si[k] = 31 - (int)(km & 31u); const unsigned uu = km & ~31u; sv[k] = u2f((uu & 0x80000000u) ? (uu ^ 0x80000000u) : ~uu); if (e == si[k]) key = 0u; } \
            float ex[4], den = 0.f; \
            _Pragma("unroll") for (int k = 0; k < 4; ++k) { ex[k] = __expf(sv[k] - sv[0]); den += ex[k]; } \
            if (e == 0 && ok_) { \
                _Pragma("unroll") for (int k = 0; k < 4; ++k) { const int rk = __hip_atomic_fetch_add(&lcnt[si[k]], 1, __ATOMIC_RELAXED, __HIP_MEMORY_SCOPE_WORKGROUP); TIl[tk_ * 4 + k] = si[k]; TGl[tk_ * 4 + k] = ex[k] / den; LRl[tk_ * 4 + k] = rk; } } } while (0)
        f32x4 va[4], vb[4];
#define ROUTER_UNPACK() do { _Pragma("unroll") for (int j = 0; j < 4; ++j) { asm volatile("" : "+v"(ra[j]), "+v"(rb[j])); \
            va[j] = (f32x4){bf_lo(ra[j].x), bf_hi(ra[j].x), bf_lo(ra[j].y), bf_hi(ra[j].y)}; vb[j] = (f32x4){bf_lo(rb[j].x), bf_hi(rb[j].x), bf_lo(rb[j].y), bf_hi(rb[j].y)}; } } while (0)
        ROUTER_FETCH(0); ROUTER_UNPACK();
#pragma unroll 1
        for (int b = 0; b < nbt; ++b) {
            asm volatile("" ::: "memory");
            ROUTER_FETCH(imin(b + 1, nbt - 1));
            LAS unsigned char* tw = L + (b & 1) * RT_TILE + 8 * lane;
#define ROUTER_LN(V, R_) do { const int tk_ = 16 * b + 2 * w + (R_), m = imin(base + tk_, T - 1); float s = 0.f; \
            _Pragma("unroll") for (int j = 0; j < 4; ++j) s += (V[j].x + V[j].y) + (V[j].z + V[j].w); \
            const float mean = wave_sum(s) * (1.f / D); float s2 = 0.f; \
            _Pragma("unroll") for (int j = 0; j < 4; ++j) { V[j] = V[j] - mean; s2 += (V[j].x * V[j].x + V[j].y * V[j].y) + (V[j].z * V[j].z + V[j].w * V[j].w); } \
            const float rstd = 1.f / sqrtf(wave_sum(s2) * (1.f / D) + LN_EPS); \
            GAS unsigned long long* o8 = (GAS unsigned long long*)(X1B + (size_t)m * D) + lane; \
            float am = 0.f; \
            _Pragma("unroll") for (int j = 0; j < 4; ++j) { V[j] = V[j] * rstd * lgv[j] + lbv[j]; \
                const unsigned h0 = cvtpk(V[j].x, V[j].y), h1 = cvtpk(V[j].z, V[j].w), l0 = cvtpk(V[j].x - bf_lo(h0), V[j].y - bf_hi(h0)), l1 = cvtpk(V[j].z - bf_lo(h1), V[j].w - bf_hi(h1)); \
                o8[64 * j] = (unsigned long long)h0 | ((unsigned long long)h1 << 32); \
                *(LAS u32x2*)(tw + (2 * w + (R_)) * RT_RS + 512 * j) = (u32x2){h0, h1}; *(LAS u32x2*)(tw + (16 + 2 * w + (R_)) * RT_RS + 512 * j) = (u32x2){l0, l1}; \
                am = fmaxf(fmaxf(am, fmaxf(fabsf(V[j].x), fabsf(V[j].y))), fmaxf(fabsf(V[j].z), fabsf(V[j].w))); } \
            am = fmaxf(wave_max(am), 1e-20f); const float qi = 127.0f / am; GAS unsigned* q8 = (GAS unsigned*)(X1Q + (size_t)m * D) + lane;        \
            _Pragma("unroll") for (int j = 0; j < 4; ++j) q8[64 * j] = pack4_i8(V[j].x * qi, V[j].y * qi, V[j].z * qi, V[j].w * qi); \
            if (lane == 0) SXl[tk_ & 127] = am * (1.0f / 127.0f); } while (0)
            ROUTER_LN(va, 0); ROUTER_LN(vb, 1);
#undef ROUTER_LN
            __syncthreads();
            if (b > 0) ROUTER_TAIL2(b - 1);
            f32x4 acc = {0.f, 0.f, 0.f, 0.f};
            const LAS unsigned char* th = L + (b & 1) * RT_TILE + i16 * RT_RS + 512 * ks + 16 * kg;
#pragma unroll
            for (int s_ = 0; s_ < 8; ++s_) { const bf16x8 ah = *(const LAS bf16x8*)(th + 64 * s_), al = *(const LAS bf16x8*)(th + 16 * RT_RS + 64 * s_);
                acc = __builtin_amdgcn_mfma_f32_16x16x32_bf16(ah, Bh[s_], acc, 0, 0, 0); acc = __builtin_amdgcn_mfma_f32_16x16x32_bf16(al, Bh[s_], acc, 0, 0, 0); acc = __builtin_amdgcn_mfma_f32_16x16x32_bf16(ah, Bl[s_], acc, 0, 0, 0); }
            LAS float* pp = (LAS float*)(L + RT_PP) + (((b & 1) * 4 + ks) * 16 + 4 * kg) * 32 + 16 * nt + i16;
#pragma unroll
            for (int r = 0; r < 4; ++r) pp[r * 32] = acc[r];
            asm volatile("" ::: "memory");
            ROUTER_UNPACK();
        }
        __syncthreads();
        ROUTER_TAIL2(nbt - 1);
        __syncthreads();
        for (int t = FTID; t < 4 * ntok; t += NTHR) if (base + (t >> 2) < T) { TOPI[(size_t)base * 4 + t] = TIl[t]; TOPG[(size_t)base * 4 + t] = TGl[t]; LRANK[(size_t)base * 4 + t] = LRl[t]; }
        if (FTID < ntok && base + FTID < T) SX[base + FTID] = SXl[FTID];
        __syncthreads();
#undef ROUTER_FETCH
#undef ROUTER_TAIL2
#undef ROUTER_UNPACK
    }
    if (FTID < NE) CNT[wg * NE + FTID] = lcnt[FTID];
}
__device__ __forceinline__ void moe_scatter(Frame& F) {
    const int* TOPI = WSP(int, WS_TOPI); const int* LRANK = WSP(int, WS_LRANK); const int* CNT = WSP(int, WS_CNT); int* SLOT = WSP(int, WS_SLOT); int* PEXP = WSP(int, WS_PEXP); int* SROW = WSP(int, WS_SROW); const float* SX = WSP(float, WS_SX); float* SXS = WSP(float, WS_SXS);
    LAS int* red = (LAS int*)F.lds;
    LAS int* basev = red + 1024;
    const int wg = blockIdx.x, G = F.G, TPW = (T + G - 1) / G;
    __syncthreads();
    {   const int e = FTID & 31, part = FTID >> 5, per = (G + 15) / 16; int tot = 0, pre = 0;
        if (per <= 16) {
            int cv[16];
#pragma unroll
            for (int j = 0; j < 16; ++j) { const int w2 = part * per + j; cv[j] = (j < per && w2 < G) ? CNT[w2 * NE + e] : 0; }
#pragma unroll
            for (int j = 0; j < 16; ++j) { tot += cv[j]; if (part * per + j < wg) pre += cv[j]; } }
        else for (int w2 = part * per; w2 < (part + 1) * per && w2 < G; ++w2) { const int c = CNT[w2 * NE + e]; tot += c; if (w2 < wg) pre += c; }
        red[part * 32 + e] = tot; red[512 + part * 32 + e] = pre; }
    __syncthreads();
    if (FTID < NE) { int tot = 0, pre = 0;
        for (int p = 0; p < 16; ++p) { tot += red[p * 32 + FTID]; pre += red[512 + p * 32 + FTID]; }
        red[FTID] = (tot + 255) & ~255; red[512 + FTID] = pre; }
    __syncthreads();
    if (FTID < NE) { int ps = 0; for (int e2 = 0; e2 < FTID; ++e2) ps += red[e2]; basev[FTID] = ps + red[512 + FTID];
        if (wg == 0) { const int p0 = ps >> 8, p1 = (ps + red[FTID]) >> 8; for (int p = p0; p < p1; ++p) PEXP[16 + p] = FTID; if (FTID == NE - 1) PEXP[0] = p1; } }
    __syncthreads();
    for (int a = FTID; a < TPW * 4; a += NTHR) { const int m = wg * TPW + (a >> 2); if (m < T) { const int sl = basev[TOPI[m * 4 + (a & 3)]] + LRANK[m * 4 + (a & 3)]; SLOT[m * 4 + (a & 3)] = sl; SROW[sl] = m; SXS[sl] = SX[m]; } }
}
constexpr int UTAB_OFF = 131072, GIDX_OFF = UTAB_OFF + 512, GIDX_UNITS = 17;
static_assert(GIDX_OFF + GIDX_UNITS * 1024 <= PHASE_LDS && pg8::MOE_MAX_UNITS * 16 <= 512, "MoE tables above the GEMM ring");
__device__ __forceinline__ void moe_setup(Frame& F, int NT, bool gather) {
    const int* PEXP = WSP(int, WS_PEXP); const int* SROW = WSP(int, WS_SROW);
    LAS int* utab = (LAS int*)(F.lds + UTAB_OFF); LAS int* gidx = (LAS int*)(F.lds + GIDX_OFF);
    __syncthreads();
    const int npan = PEXP[0], G = F.G, c = blockIdx.x;
    if (FTID < pg8::MOE_MAX_UNITS) { const int i = FTID; int pm, pn;
        if ((G & 7) == 0) { const int x = c & 7, j = c >> 3, U = i * (G >> 3) + j, q8 = npan >> 3, r8 = npan & 7, px = q8 + (x < r8 ? 1 : 0), st = x * q8 + (x < r8 ? x : r8);
            pn = U % NT; const int k = U / NT; pm = k < px ? st + k : npan; }
        else { const int L = i * G + c; pn = L % NT; pm = L / NT; }
        const int valid = pm < npan && (!gather || i < GIDX_UNITS); const int e = valid ? PEXP[16 + pm] : 0;
        utab[4 * i] = pm; utab[4 * i + 1] = pn; utab[4 * i + 2] = e * NT + pn; utab[4 * i + 3] = valid; }
    __syncthreads();
    if (gather) {
        const int half = FTID >> 8, row = FTID & 255; int tk[(GIDX_UNITS + 1) / 2];
#pragma unroll
        for (int k = 0; k < (GIDX_UNITS + 1) / 2; ++k) { const int i = 2 * k + half; const bool v = i < GIDX_UNITS && utab[4 * (i < GIDX_UNITS ? i : 0) + 3] != 0; const int pm_ = v ? utab[4 * (i < GIDX_UNITS ? i : 0)] : 0; const int t_ = SROW[pm_ * 256 + row]; tk[k] = v ? t_ : -1; }
#pragma unroll
        for (int k = 0; k < (GIDX_UNITS + 1) / 2; ++k) { const int i = 2 * k + half; if (i < GIDX_UNITS) { int t_ = tk[k]; t_ = t_ < 0 ? 0 : (t_ >= T ? T - 1 : t_); gidx[i * 256 + row] = t_; } }
        __syncthreads(); }
}
__device__ __forceinline__ void moe_combine(Frame& F, int layer, float* OUT, bf16* OB, signed char* OQ, float* OQS) {
    const bf16* X1B = WSP(bf16, WS_X1B); const bf16* YB = WSP(bf16, WS_YB); const int* SLOT = WSP(int, WS_SLOT); const float* TOPG = WSP(float, WS_TOPG);
    const float* lg = (const float*)F.in[14] + layer * D; const float* lb = (const float*)F.in[15] + layer * D;
    const int lane = FLANE, gw = F.vcu * NWAVES + F.wave, NGW = F.G * NWAVES;
    f32x4 gv[4], bv[4];
#pragma unroll
    for (int q = 0; q < 4; ++q) { const int col = (q >> 1) * 512 + 8 * lane + (q & 1) * 4; gv[q] = *(const f32x4*)(lg + col); bv[q] = *(const f32x4*)(lb + col); }
    const int nrows = gw < T ? (T - gw + NGW - 1) / NGW : 0;
    for (int r0 = 0; r0 < nrows; r0 += 16) {
        const int nr = imin(16, nrows - r0);
        int slv; float gtv;
        { const size_t ri = (size_t)(gw + (r0 + imin(lane >> 2, nr - 1)) * NGW) * 4 + (lane & 3); slv = SLOT[ri]; gtv = TOPG[ri]; }
        float amv = 0.f;
        v4u da[6], db[6], dc[6];
#define CMB_LOAD(BUF, IT) do { const int itc_ = imin((IT), nr - 1), m_ = gw + (r0 + itc_) * NGW; const GAS v4u* xp_ = (const GAS v4u*)(X1B + (size_t)m_ * D) + lane; BUF[0] = xp_[0]; BUF[1] = xp_[64]; \
        _Pragma("unroll") for (int k = 0; k < 4; ++k) { const int sl_ = __builtin_amdgcn_readlane(slv, itc_ * 4 + k); const GAS u32x2* yp_ = (const GAS u32x2*)((const unsigned char*)YB + (size_t)sl_ * D) + lane; \
            const u32x2 ya_ = yp_[0], yb_ = yp_[64]; BUF[2 + k] = (v4u){ya_.x, ya_.y, yb_.x, yb_.y}; } } while (0)
#define CMB_TAKE(BUF) do { _Pragma("unroll") for (int i = 0; i < 6; ++i) { asm volatile("" : "+v"(BUF[i])); dc[i] = BUF[i]; } } while (0)
#define CMB_ROW(IT) do { const int itc_ = imin((IT), nr - 1), m = gw + (r0 + itc_) * NGW; \
        f32x4 v[4]; \
        v[0] = (f32x4){bf_lo(dc[0].x), bf_hi(dc[0].x), bf_lo(dc[0].y), bf_hi(dc[0].y)} * DN_ALPHA; v[1] = (f32x4){bf_lo(dc[0].z), bf_hi(dc[0].z), bf_lo(dc[0].w), bf_hi(dc[0].w)} * DN_ALPHA; \
        v[2] = (f32x4){bf_lo(dc[1].x), bf_hi(dc[1].x), bf_lo(dc[1].y), bf_hi(dc[1].y)} * DN_ALPHA; v[3] = (f32x4){bf_lo(dc[1].z), bf_hi(dc[1].z), bf_lo(dc[1].w), bf_hi(dc[1].w)} * DN_ALPHA; \
        _Pragma("unroll") for (int k = 0; k < 4; ++k) { const float g = __builtin_bit_cast(float, __builtin_amdgcn_readlane(__builtin_bit_cast(int, gtv), itc_ * 4 + k)) * (1.0f / 16.0f); const v4u a = dc[2 + k];          \
            const f32x2 a0 = __builtin_amdgcn_cvt_pk_f32_fp8((int)a.x, false), a1 = __builtin_amdgcn_cvt_pk_f32_fp8((int)a.x, true), a2 = __builtin_amdgcn_cvt_pk_f32_fp8((int)a.y, false), a3 = __builtin_amdgcn_cvt_pk_f32_fp8((int)a.y, true); \
            const f32x2 b0 = __builtin_amdgcn_cvt_pk_f32_fp8((int)a.z, false), b1 = __builtin_amdgcn_cvt_pk_f32_fp8((int)a.z, true), b2 = __builtin_amdgcn_cvt_pk_f32_fp8((int)a.w, false), b3 = __builtin_amdgcn_cvt_pk_f32_fp8((int)a.w, true); \
            v[0] += (f32x4){a0.x, a0.y, a1.x, a1.y} * g; v[1] += (f32x4){a2.x, a2.y, a3.x, a3.y} * g; \
            v[2] += (f32x4){b0.x, b0.y, b1.x, b1.y} * g; v[3] += (f32x4){b2.x, b2.y, b3.x, b3.y} * g; } \
        float s = 0.f; \
        _Pragma("unroll") for (int q = 0; q < 4; ++q) s += (v[q].x + v[q].y) + (v[q].z + v[q].w); \
        const float mean = wave_sum(s) * (1.f / D); float s2 = 0.f; \
        _Pragma("unroll") for (int q = 0; q < 4; ++q) { v[q] = v[q] - mean; s2 += (v[q].x * v[q].x + v[q].y * v[q].y) + (v[q].z * v[q].z + v[q].w * v[q].w); } \
        const float rstd = 1.f / sqrtf(wave_sum(s2) * (1.f / D) + LN_EPS); \
        _Pragma("unroll") for (int q = 0; q < 4; ++q) { const int col = (q >> 1) * 512 + 8 * lane + (q & 1) * 4; v[q] = v[q] * rstd * gv[q] + bv[q]; if (OUT) *(f32x4*)(OUT + (size_t)m * D + col) = v[q]; } \
        if (OQ) { float am = 0.f; \
            _Pragma("unroll") for (int q = 0; q < 4; ++q) am = fmaxf(fmaxf(am, fmaxf(fabsf(v[q].x), fabsf(v[q].y))), fmaxf(fabsf(v[q].z), fabsf(v[q].w))); \
            am = fmaxf(wave_max(am), 1e-20f); const float qi = 127.0f / am; unsigned w4[4]; \
            _Pragma("unroll") for (int q = 0; q < 4; ++q) w4[q] = pack4_i8(v[q].x * qi, v[q].y * qi, v[q].z * qi, v[q].w * qi); \
            GAS u32x2* oq = (GAS u32x2*)(OQ + (size_t)m * D) + lane; oq[0] = (u32x2){w4[0], w4[1]}; oq[64] = (u32x2){w4[2], w4[3]}; \
            amv = lane == itc_ ? am * (1.0f / 127.0f) : amv; } \
        if (OB) { GAS v4u* ob = (GAS v4u*)(OB + (size_t)m * D) + lane; \
            ob[0] = (v4u){cvtpk(v[0].x, v[0].y), cvtpk(v[0].z, v[0].w), cvtpk(v[1].x, v[1].y), cvtpk(v[1].z, v[1].w)}; ob[64] = (v4u){cvtpk(v[2].x, v[2].y), cvtpk(v[2].z, v[2].w), cvtpk(v[3].x, v[3].y), cvtpk(v[3].z, v[3].w)}; } } while (0)
        CMB_LOAD(da, 0); CMB_LOAD(db, 1); CMB_TAKE(da);
#pragma unroll 1
        for (int it = 0; it < nr; it += 2) {
            CMB_LOAD(da, it + 2); CMB_ROW(it); CMB_TAKE(db);
            CMB_LOAD(db, it + 3); CMB_ROW(it + 1); CMB_TAKE(da);
        }
        if (OQ && lane < nr) OQS[gw + (r0 + lane) * NGW] = amv;
#undef CMB_LOAD
#undef CMB_TAKE
#undef CMB_ROW
    }
}
__device__ __forceinline__ void diff_subln(Frame& F) {
    const bf16* O0 = WSP(bf16, WS_O0); const bf16* O1 = WSP(bf16, WS_O1); bf16* OB = WSP(bf16, WS_OB);
    const float* lam = (const float*)F.in[9]; const float* sw = (const float*)F.in[10];
    const int lane = FLANE, gw = F.vcu * NWAVES + F.wave, NGW = F.G * NWAVES;
    const float l1 = wave_sum(lam[lane] * lam[64 + lane]), l2 = wave_sum(lam[128 + lane] * lam[192 + lane]);
    const float lam_full = expf(l1) - expf(l2) + LAMBDA_INIT;
    f32x4 wv[2];
#pragma unroll
    for (int q = 0; q < 2; ++q) wv[q] = *(const f32x4*)(sw + ((8 * lane) & 127) + 4 * q) * (1.0f - LAMBDA_INIT);
    for (int m = gw; m < T; m += NGW) {
        const GAS v4u* p0 = (const GAS v4u*)(O0 + (size_t)m * D) + lane; const GAS v4u* p1 = (const GAS v4u*)(O1 + (size_t)m * D) + lane; GAS v4u* po = (GAS v4u*)(OB + (size_t)m * D) + lane;
#pragma unroll
        for (int hf = 0; hf < 2; ++hf) { const v4u a = p0[64 * hf], b = p1[64 * hf];
            float o[8] = {bf_lo(a.x) - lam_full * bf_lo(b.x), bf_hi(a.x) - lam_full * bf_hi(b.x), bf_lo(a.y) - lam_full * bf_lo(b.y), bf_hi(a.y) - lam_full * bf_hi(b.y),
                          bf_lo(a.z) - lam_full * bf_lo(b.z), bf_hi(a.z) - lam_full * bf_hi(b.z), bf_lo(a.w) - lam_full * bf_lo(b.w), bf_hi(a.w) - lam_full * bf_hi(b.w)};
            float ss = 0.f;
#pragma unroll
            for (int e = 0; e < 8; ++e) ss += o[e] * o[e];
            ss = sum16(ss);
            const float rstd = 1.0f / sqrtf(ss * (1.0f / 128.0f) + RMS_EPS);
            po[64 * hf] = (v4u){pk2(o[0] * rstd * wv[0].x, o[1] * rstd * wv[0].y), pk2(o[2] * rstd * wv[0].z, o[3] * rstd * wv[0].w), pk2(o[4] * rstd * wv[1].x, o[5] * rstd * wv[1].y), pk2(o[6] * rstd * wv[1].z, o[7] * rstd * wv[1].w)}; }
    }
}

struct Args { const void* in[22]; float* out; unsigned char* ws; int ph_lo, ph_hi; };
__global__ void __launch_bounds__(NTHR, 2) yoco_fwd(Args args) {
    extern __shared__ __attribute__((aligned(16))) unsigned char lds[];
    Frame F;
    F.lds = (LAS unsigned char*)lds;
    F.MISC = (volatile LAS unsigned*)(F.lds + MISC_OFF);
    F.wave = __builtin_amdgcn_readfirstlane((int)threadIdx.x >> 6);
    F.G = gridDim.x; { const int bx = blockIdx.x; F.vcu = (F.G % 8 == 0) ? (bx % 8) * (F.G / 8) + bx / 8 : bx; }
    F.ws = args.ws; F.ctl = (gu32*)(args.ws + WS_CTL); F.in = args.in; F.out = args.out;
    for (int u = FTID; u < (LDS_BYTES - MISC_OFF) / 4; u += NTHR) ((LAS unsigned*)(F.lds + MISC_OFF))[u] = 0u;
    __syncthreads();
    XcdBarrier bar; bar.bar = (unsigned*)(F.ctl + CW_BAR); bar.x = 0; bar.st = nullptr;
    if (N_LAUNCHES == 1) bar = xcd_barrier_post((unsigned*)(F.ctl + CW_BAR), F.MISC + 8);
    const int lo = args.ph_lo, hi = args.ph_hi;
#ifndef DBG_MASK
#define DBG_MASK 0xFFFFFu
#endif
#define IN(k) (lo <= (k) && (k) < hi && ((DBG_MASK >> (k)) & 1u))
#define SEAM(k) do { if ((k) != 13 && IN(k) && IN((k) + 1)) xcd_barrier(bar); } while (0)
#ifndef DBG_REPEAT
#define DBG_REPEAT 0u
#endif
#define PHASE(k, ...) do { if (IN(k)) { { __VA_ARGS__ } if ((DBG_REPEAT >> (k)) & 1u) { if (N_LAUNCHES == 1) xcd_barrier(bar); { __VA_ARGS__ } } } SEAM(k); } while (0);
    LAS unsigned char* ring = F.lds;

    PHASE(0,  p0_prologue(F); )
    PHASE(1,  pg8::Gemm g{WSP(bf16, WS_X1Q), WSP(bf16, WS_WIN), T, NQKVR, D / 2}; pg8::StaticOrder S; S.init(T, NQKVR, F.G, (int)blockIdx.x);
        pg8::EpiStoreI8 E{WSP(bf16, WS_QKVR), NQKVR, WSP(float, WS_SX), WSP(float, WS_SWIN)};
        pg8::gemm_phase<pg8::EpiStoreI8, pg8::StaticOrder, true, true, false, true>(ring, g, S, E); )
    PHASE(2,  gla_stage1(F); )
    PHASE(3,  gla_stage2(F); )
    PHASE(4,  gla_stage3(F); )
    PHASE(5,  pg8::Gemm g{WSP(bf16, WS_OG), WSP(bf16, WS_WAO), T, D, D / 2}; pg8::StaticOrder S; S.init(T, D, F.G, (int)blockIdx.x);
        pg8::EpiResI8 E{WSP(bf16, WS_XB), WSP(bf16, WS_Y), D, DN_ALPHA, OG_QS, WSP(float, WS_SWAO)};
        pg8::gemm_phase<pg8::EpiResI8, pg8::StaticOrder, true, true, false, true>(ring, g, S, E); )
    PHASE(6,  moe_router(F, 0); )
    PHASE(7,  moe_scatter(F); )
    PHASE(8,  moe_setup(F, 8, true);
        pg8::Gemm g{WSP(bf16, WS_X1Q), WSP(bf16, WS_WGU) + (size_t)0 * NE * 2048 * 512, NPAD_MAX, 2048, D / 2}; pg8::MoeOrder S{(const LAS int*)(F.lds + UTAB_OFF)};
        pg8::EpiSwigluI8 E{(const float*)F.in[19], WSP(bf16, WS_ACT), WSP(float, WS_SXS), WSP(float, WS_SWQ) + 0 * NE, WSP(float, WS_SACT) + 0 * NE};
        pg8::gemm_phase<pg8::EpiSwigluI8, pg8::MoeOrder, true, true, true, true>(ring, g, S, E, (const LAS int*)(F.lds + GIDX_OFF)); )
    PHASE(9,  moe_setup(F, 4, false);
        pg8::Gemm g{WSP(bf16, WS_ACT), WSP(bf16, WS_WD) + (size_t)0 * NE * 1024 * 512, NPAD_MAX, D, D / 2}; pg8::MoeOrder S{(const LAS int*)(F.lds + UTAB_OFF)};
        pg8::EpiDownI8 E{(const float*)F.in[21], WSP(bf16, WS_YB), WSP(float, WS_SACT) + 0 * NE, WSP(float, WS_SWD) + 0 * NE};
        pg8::gemm_phase<pg8::EpiDownI8, pg8::MoeOrder, true, true, false, true>(ring, g, S, E); )
    PHASE(10,  moe_combine(F, 0, (float*)nullptr, WSP(bf16, WS_X2B), (signed char*)WSP(unsigned char, WS_X2Q), WSP(float, WS_SX2)); )
    PHASE(11,  pg8::Gemm g{WSP(bf16, WS_X2Q), WSP(bf16, WS_WKVQ), T, 3072, D / 2}; pg8::StaticOrder S; S.init(T, 3072, F.G, (int)blockIdx.x);
        pg8::EpiRopeI8 E{WSP(bf16, WS_KB), (size_t)(WS_VB - WS_KB) / 2, WSP(float, WS_COS), WSP(float, WS_SIN), attn_body::C2, WSP(float, WS_SX2), WSP(float, WS_SWKVQ)};
        static_assert(WS_QB - WS_VB == WS_VB - WS_KB, "K | V | Q equally spaced");
        pg8::gemm_phase<pg8::EpiRopeI8, pg8::StaticOrder, true, true, false, true>(ring, g, S, E); )
    PHASE(12,  const attn_body::DiffTensors AT{(const attn_body::bf16*)WSP(bf16, WS_QB), (const attn_body::bf16*)WSP(bf16, WS_KB), (const attn_body::bf16*)WSP(bf16, WS_VB), (attn_body::bf16*)WSP(bf16, WS_O0), (attn_body::bf16*)WSP(bf16, WS_OB),
            (const float*)F.in[9], WSP(float, WS_SUBW), LAMBDA_INIT};
        static_assert(attn_body::L2_BYTES <= PHASE_LDS, "attention LDS");
        attn_body::diff_attn_phase128<20>((char*)lds, AT, F.vcu, F.G); )
    PHASE(13, )
    PHASE(14,  pg8::Gemm g{WSP(bf16, WS_OB), WSP(bf16, WS_WBO), T, D, D / 2}; pg8::StaticOrder S; S.init(T, D, F.G, (int)blockIdx.x);
        pg8::EpiResI8 E{WSP(bf16, WS_X2B), WSP(bf16, WS_Y), D, DN_ALPHA, OB_QS, WSP(float, WS_SWBO)};
        pg8::gemm_phase<pg8::EpiResI8, pg8::StaticOrder, true, true, false, true>(ring, g, S, E); )
    PHASE(15,  moe_router(F, 1); )
    PHASE(16,  moe_scatter(F); )
    PHASE(17,  moe_setup(F, 8, true);
        pg8::Gemm g{WSP(bf16, WS_X1Q), WSP(bf16, WS_WGU) + (size_t)1 * NE * 2048 * 512, NPAD_MAX, 2048, D / 2}; pg8::MoeOrder S{(const LAS int*)(F.lds + UTAB_OFF)};
        pg8::EpiSwigluI8 E{(const float*)F.in[19] + NE * 2048, WSP(bf16, WS_ACT), WSP(float, WS_SXS), WSP(float, WS_SWQ) + 1 * NE, WSP(float, WS_SACT) + 1 * NE};
        pg8::gemm_phase<pg8::EpiSwigluI8, pg8::MoeOrder, true, true, true, true>(ring, g, S, E, (const LAS int*)(F.lds + GIDX_OFF)); )
    PHASE(18,  moe_setup(F, 4, false);
        pg8::Gemm g{WSP(bf16, WS_ACT), WSP(bf16, WS_WD) + (size_t)1 * NE * 1024 * 512, NPAD_MAX, D, D / 2}; pg8::MoeOrder S{(const LAS int*)(F.lds + UTAB_OFF)};
        pg8::EpiDownI8 E{(const float*)F.in[21] + NE * 1024, WSP(bf16, WS_YB), WSP(float, WS_SACT) + 1 * NE, WSP(float, WS_SWD) + 1 * NE};
        pg8::gemm_phase<pg8::EpiDownI8, pg8::MoeOrder, true, true, false, true>(ring, g, S, E); )
    PHASE(19,  moe_combine(F, 1, F.out, (bf16*)nullptr, (signed char*)nullptr, (float*)nullptr); )
#undef IN
#undef SEAM
#undef PHASE
}

extern "C" void kernel_launch(void* const* d_in, const int* in_sizes, int n_in, void* d_out, int out_size, void* d_ws, size_t ws_size, hipStream_t stream) {
    static int grid = 0;
    if (grid == 0) {
        if (n_in != 22 || in_sizes[0] != T * D || out_size != T * D || ws_size < WS_END) { fprintf(stderr, "kernel_launch: unexpected problem (n_in %d, in0 %d, out %d, ws %zu); nothing launched\n", n_in, n_in > 0 ? in_sizes[0] : -1, out_size, ws_size); grid = -1; return; }
        int dev = 0, cus = 0, per_cu = 0;
        if (hipGetDevice(&dev) != hipSuccess || hipDeviceGetAttribute(&cus, hipDeviceAttributeMultiprocessorCount, dev) != hipSuccess) { grid = -1; return; }
        if (hipFuncSetAttribute((const void*)yoco_fwd, hipFuncAttributeMaxDynamicSharedMemorySize, LDS_BYTES) != hipSuccess) { fprintf(stderr, "kernel_launch: hipFuncSetAttribute failed\n"); grid = -1; return; }
        if (hipOccupancyMaxActiveBlocksPerMultiprocessor(&per_cu, (const void*)yoco_fwd, NTHR, LDS_BYTES) != hipSuccess || per_cu < 1) fprintf(stderr, "kernel_launch: note: occupancy query reports %d workgroups per CU\n", per_cu);
        (void)hipGetLastError();
        grid = cus < 256 ? (cus & ~7) : 256;
        if (grid < 8) grid = 8;
    }
    if (grid < 0) return;
    if (hipMemsetAsync((char*)d_ws + WS_CTL, 0, CTL_ZERO_BYTES, stream) != hipSuccess) return;
    Args a{};
    for (int i = 0; i < 22; ++i) a.in[i] = d_in[i];
    a.out = (float*)d_out; a.ws = (unsigned char*)d_ws;
    for (int li = 0; li < N_LAUNCHES; ++li) {
        a.ph_lo = (N_LAUNCHES == 1) ? 0 : li; a.ph_hi = (N_LAUNCHES == 1) ? NPHASE : li + 1;
        hipLaunchKernelGGL(yoco_fwd, dim3(grid), dim3(NTHR), LDS_BYTES, stream, a);
        if (hipPeekAtLastError() != hipSuccess) { fprintf(stderr, "kernel_launch: launch %d failed\n", li); break; }
    }
}
```
